# Optimizing an MI355X kernel written in HIP

```python
import jax, jax.numpy as jnp
from jax import lax
import numpy as np

D_MODEL = 2048
BATCH = 1
SEQ = 8192
DEPTH = 1

CONV_WIDTH = 1024
CONV_KERNEL = 3
ATTN_HEADS = 16
ATTN_HEAD_DIM = 64
ATTN_WIDTH = ATTN_HEADS * ATTN_HEAD_DIM
Q_BLOCK = 128
IN_WIDTH = 3 * CONV_WIDTH + 3 * ATTN_WIDTH + 2 * D_MODEL
PEER_HEADS = 8
PEER_KEYS = 128
PEER_EXPERTS = PEER_KEYS * PEER_KEYS
PEER_QUERY_DIM = 256
PEER_HALF = PEER_QUERY_DIM // 2
PEER_TOPK = 16
PEER_TOKEN_BLOCK = 128
RMS_EPS = 1e-6

kernel_name = "hybrid_conv_stickbreak_peer"


def rmsnorm(x, gain):
    xf = x.astype(jnp.float32)
    inv = lax.rsqrt(jnp.mean(xf * xf, axis=-1, keepdims=True) + RMS_EPS)
    return (xf * inv * gain.astype(jnp.float32)).astype(x.dtype)


def short_conv_mixer(b_gate, c_gate, h, conv_w):
    z = c_gate * h
    y = lax.conv_general_dilated(
        z, conv_w[:, None, :], window_strides=(1,),
        padding=[(CONV_KERNEL - 1, 0)],
        dimension_numbers=("NWC", "WIO", "NWC"),
        feature_group_count=z.shape[-1])
    return b_gate * y


def stick_breaking_attention(q, k, v):
    b, t, h, dh = q.shape
    nb = t // Q_BLOCK
    scale = dh ** -0.5
    kf = k.astype(jnp.float32)
    vf = v.astype(jnp.float32)
    q_blocks = jnp.moveaxis(q.reshape(b, nb, Q_BLOCK, h, dh), 1, 0)
    key_pos = jnp.arange(t)

    def one_block(args):
        qb, blk = args
        q_pos = blk * Q_BLOCK + jnp.arange(Q_BLOCK)
        mask = key_pos[None, :] < q_pos[:, None]
        z = jnp.einsum("bqhd,bkhd->bhqk", qb.astype(jnp.float32), kf) * scale
        log_keep = jnp.where(mask, jax.nn.log_sigmoid(-z), 0.0)
        suffix = lax.cumsum(log_keep, axis=3, reverse=True)
        suffix_excl = jnp.concatenate(
            [suffix[..., 1:], jnp.zeros_like(suffix[..., :1])], axis=-1)
        weights = jnp.where(mask, jnp.exp(jax.nn.log_sigmoid(z) + suffix_excl), 0.0)
        return jnp.einsum("bhqk,bkhd->bqhd", weights, vf)

    out = lax.map(one_block, (q_blocks, jnp.arange(nb)))
    return jnp.moveaxis(out, 0, 1).reshape(b, t, h, dh).astype(q.dtype)


def peer_ffn(x, wq, subkeys, u_table, v_table):
    b, t, d = x.shape
    q = jnp.einsum("btd,dq->btq", x, wq).reshape(b, t, PEER_HEADS, 2, PEER_HALF)
    scores = jnp.einsum("bthsc,snc->bthsn", q, subkeys)
    top_s, top_i = lax.top_k(scores, PEER_TOPK)
    cand_s = top_s[..., 0, :, None] + top_s[..., 1, None, :]
    cand_i = top_i[..., 0, :, None] * PEER_KEYS + top_i[..., 1, None, :]
    cand_s = cand_s.reshape(b, t, PEER_HEADS, PEER_TOPK * PEER_TOPK)
    cand_i = cand_i.reshape(b, t, PEER_HEADS, PEER_TOPK * PEER_TOPK)
    sel_s, sel_pos = lax.top_k(cand_s, PEER_TOPK)
    sel_i = jnp.take_along_axis(cand_i, sel_pos, axis=-1)
    gate = jax.nn.softmax(sel_s.astype(jnp.float32), axis=-1)

    n = b * t
    nb = n // PEER_TOKEN_BLOCK
    xs = x.reshape(nb, PEER_TOKEN_BLOCK, d)
    idx = sel_i.reshape(nb, PEER_TOKEN_BLOCK, PEER_HEADS, PEER_TOPK)
    gs = gate.reshape(nb, PEER_TOKEN_BLOCK, PEER_HEADS, PEER_TOPK)

    def one_block(args):
        xb, ib, gb = args
        u = u_table[ib]
        hidden = jnp.einsum("td,thkd->thk", xb, u)
        act = jax.nn.gelu(hidden.astype(jnp.float32), approximate=False) * gb
        v = v_table[ib]
        return jnp.einsum("thk,thkd->td", act.astype(xb.dtype), v)

    out = lax.map(one_block, (xs, idx, gs))
    return out.reshape(b, t, d)


def setup_inputs(seed: int = 0) -> dict:
    key = jax.random.key(seed)
    ks = jax.random.split(key, 14)
    f32 = jnp.float32
    x = jax.random.normal(ks[0], (BATCH, SEQ, D_MODEL), f32)
    norm_mix = 1.0 + 0.02 * jax.random.normal(ks[1], (DEPTH, D_MODEL), f32)
    w_in = jax.random.normal(ks[2], (DEPTH, D_MODEL, IN_WIDTH), f32) * D_MODEL ** -0.5
    conv_w = jax.random.normal(ks[3], (DEPTH, CONV_KERNEL, CONV_WIDTH), f32) * CONV_KERNEL ** -0.5
    w_conv_out = jax.random.normal(ks[4], (DEPTH, CONV_WIDTH, D_MODEL), f32) * CONV_WIDTH ** -0.5
    w_attn_out = jax.random.normal(ks[5], (DEPTH, ATTN_WIDTH, D_MODEL), f32) * ATTN_WIDTH ** -0.5
    w_out = jax.random.normal(ks[6], (DEPTH, D_MODEL, D_MODEL), f32) * D_MODEL ** -0.5
    norm_ffn = 1.0 + 0.02 * jax.random.normal(ks[7], (DEPTH, D_MODEL), f32)
    peer_wq = jax.random.normal(ks[8], (DEPTH, D_MODEL, PEER_HEADS * PEER_QUERY_DIM), f32) * D_MODEL ** -0.5
    peer_subkeys = jax.random.normal(ks[9], (DEPTH, 2, PEER_KEYS, PEER_HALF), f32) * PEER_HALF ** -0.5
    peer_u = jax.random.normal(ks[10], (DEPTH, PEER_EXPERTS, D_MODEL), f32) * D_MODEL ** -0.5
    peer_v = jax.random.normal(ks[11], (DEPTH, PEER_EXPERTS, D_MODEL), f32) * PEER_HEADS ** -0.5
    norm_final = 1.0 + 0.02 * jax.random.normal(ks[12], (D_MODEL,), f32)
    return {"x": x, "norm_mix": norm_mix, "w_in": w_in, "conv_w": conv_w,
            "w_conv_out": w_conv_out, "w_attn_out": w_attn_out, "w_out": w_out,
            "norm_ffn": norm_ffn, "peer_wq": peer_wq, "peer_subkeys": peer_subkeys,
            "peer_u": peer_u, "peer_v": peer_v, "norm_final": norm_final}


def reference(x, norm_mix, w_in, conv_w, w_conv_out, w_attn_out, w_out,
              norm_ffn, peer_wq, peer_subkeys, peer_u, peer_v, norm_final):
    b, t, d = x.shape
    splits = [CONV_WIDTH, 2 * CONV_WIDTH, 3 * CONV_WIDTH,
              3 * CONV_WIDTH + ATTN_WIDTH, 3 * CONV_WIDTH + 2 * ATTN_WIDTH,
              3 * CONV_WIDTH + 3 * ATTN_WIDTH, 3 * CONV_WIDTH + 3 * ATTN_WIDTH + D_MODEL]
    for layer in range(DEPTH):
        xn = rmsnorm(x, norm_mix[layer])
        proj = jnp.einsum("btd,de->bte", xn, w_in[layer])
        cb, cc, ch, q, k, v, g_conv, g_attn = jnp.split(proj, splits, axis=-1)
        y_conv = short_conv_mixer(cb, cc, ch, conv_w[layer])
        y_conv = jnp.einsum("btc,cd->btd", y_conv, w_conv_out[layer])
        y_attn = stick_breaking_attention(
            q.reshape(b, t, ATTN_HEADS, ATTN_HEAD_DIM),
            k.reshape(b, t, ATTN_HEADS, ATTN_HEAD_DIM),
            v.reshape(b, t, ATTN_HEADS, ATTN_HEAD_DIM)).reshape(b, t, ATTN_WIDTH)
        y_attn = jnp.einsum("bta,ad->btd", y_attn, w_attn_out[layer])
        merged = jax.nn.sigmoid(g_conv) * y_conv + jax.nn.sigmoid(g_attn) * y_attn
        x = x + jnp.einsum("btd,de->bte", merged, w_out[layer])
        xn = rmsnorm(x, norm_ffn[layer])
        x = x + peer_ffn(xn, peer_wq[layer], peer_subkeys[layer], peer_u[layer], peer_v[layer])
    return rmsnorm(x, norm_final)
```

```cpp
#include <hip/hip_runtime.h>
#include <cstdio>
#include <cstdint>
namespace pg8 {
#define PG8_LAS __attribute__((address_space(3)))
typedef unsigned short bf16_t;
typedef short bf16x8 __attribute__((ext_vector_type(8)));
typedef float f32x4 __attribute__((ext_vector_type(4)));
typedef unsigned u32x4 __attribute__((ext_vector_type(4)));
constexpr int BM = 256, BK = 64, HALF = 128, HTB = HALF * BK * 2  , STAGE_BYTES = 8 * HTB, NXCD = 8, WGM = 8;

__host__ __device__ __forceinline__ int lds_byte(int r, int c) { const int st = (r >> 4) * 2 + (c >> 5), rr = r & 15, cc = c & 31, ob = rr * 64 + cc * 2; return st * 1024 + (ob ^ (((ob >> 9) & 1) << 5)); }
__host__ __device__ __forceinline__ void stage_rc(int b, int& R, int& C) { const int st = b / 1024, sb = b % 1024, swz = sb ^ (((sb >> 9) & 1) << 5); R = (st >> 1) * 16 + swz / 64; C = (st & 1) * 32 + (swz % 64) / 2; }
__host__ __device__ __forceinline__ int perm32(int rho) { const int n = rho >> 4, i = rho & 15; return 8 * (i >> 2) + 4 * n + (i & 3); }

struct Unit { int pm, pn; };
struct Gemm { const bf16_t* A; const bf16_t* Bt; int M, N, K; };

struct StaticOrder {
    int nM, nN, nwg, G, c;
    __host__ __device__ void init(int M, int N, int G_, int c_) { nM = M / BM; nN = N / BM; nwg = nM * nN; G = G_; c = c_; }
    __host__ __device__ bool next(int i, Unit& u) const {
        const long L = (long)i * G + c; if (L >= nwg) return false;
        int wgid = (int)L; { const int q = nwg / NXCD, r = nwg % NXCD, xcd = wgid % NXCD, off = wgid / NXCD; wgid = (xcd < r ? xcd * (q + 1) : r * (q + 1) + (xcd - r) * q) + off; }
        const int nig = WGM * nN, gid = wgid / nig, fm = gid * WGM, gsz = (nM - fm) < WGM ? (nM - fm) : WGM;
        u.pm = fm + ((wgid % nig) % gsz); u.pn = (wgid % nig) / gsz; return true;
    }
    __device__ __forceinline__ void a_ready(const Unit&) const {}
    __device__ __forceinline__ void done(const Unit&) const {}
};


__device__ __forceinline__ unsigned cvt_pk_bf16(float lo, float hi) { unsigned r; asm volatile("v_cvt_pk_bf16_f32 %0, %1, %2" : "=v"(r) : "v"(lo), "v"(hi)); return r; }
__device__ __forceinline__ float bf_lo(unsigned w) { return __uint_as_float(w << 16); }
__device__ __forceinline__ float bf_hi(unsigned w) { return __uint_as_float(w & 0xffff0000u); }
__device__ __forceinline__ float sigmoidf_fast(float x) { return __builtin_amdgcn_rcpf(1.0f + __builtin_amdgcn_exp2f(-1.4426950408889634f * x)); }

struct EpiStore {
    static constexpr bool PERM = true, AFTER_DRAIN = false;
    bf16_t* O; int ldc;
    __device__ __forceinline__ void operator()(const f32x4 (&acc)[2][2][4][2], const Unit& u, int wr, int wc, int fr, int fq) const {
        const int row0 = u.pm * BM + wr * 64 + fr, col0 = u.pn * BM + wc * 32 + 8 * fq;
#pragma unroll
        for (int ai = 0; ai < 2; ++ai)
#pragma unroll
            for (int m = 0; m < 4; ++m) { bf16_t* rowp = O + (size_t)(row0 + ai * HALF + m * 16) * ldc + col0;
#pragma unroll
                for (int bj = 0; bj < 2; ++bj) { const f32x4 v0 = acc[ai][bj][m][0], v1 = acc[ai][bj][m][1];
                    u32x4 w; w.x = cvt_pk_bf16(v0[0], v0[1]); w.y = cvt_pk_bf16(v0[2], v0[3]); w.z = cvt_pk_bf16(v1[0], v1[1]); w.w = cvt_pk_bf16(v1[2], v1[3]);
                    *(u32x4*)(rowp + bj * HALF) = w; } }
    }
};
template <int PASS> struct EpiGate {
    static constexpr bool PERM = true, AFTER_DRAIN = false;
    const bf16_t* G; int ldg; bf16_t* O; int ldc;
    __device__ __forceinline__ void operator()(const f32x4 (&acc)[2][2][4][2], const Unit& u, int wr, int wc, int fr, int fq) const {
        const int row0 = u.pm * BM + wr * 64 + fr, col0 = u.pn * BM + wc * 32 + 8 * fq;
#pragma unroll
        for (int ai = 0; ai < 2; ++ai)
#pragma unroll
            for (int m = 0; m < 4; ++m) { const size_t row = (size_t)(row0 + ai * HALF + m * 16);
#pragma unroll
                for (int bj = 0; bj < 2; ++bj) { const f32x4 v0 = acc[ai][bj][m][0], v1 = acc[ai][bj][m][1];
                    const u32x4 g = *(const u32x4*)(G + row * ldg + col0 + bj * HALF);
                    float r[8];
                    r[0] = v0[0] * sigmoidf_fast(bf_lo(g.x)); r[1] = v0[1] * sigmoidf_fast(bf_hi(g.x)); r[2] = v0[2] * sigmoidf_fast(bf_lo(g.y)); r[3] = v0[3] * sigmoidf_fast(bf_hi(g.y));
                    r[4] = v1[0] * sigmoidf_fast(bf_lo(g.z)); r[5] = v1[1] * sigmoidf_fast(bf_hi(g.z)); r[6] = v1[2] * sigmoidf_fast(bf_lo(g.w)); r[7] = v1[3] * sigmoidf_fast(bf_hi(g.w));
                    bf16_t* op = O + row * ldc + col0 + bj * HALF;
                    if (PASS == 1) { const u32x4 p = *(const u32x4*)op;
                        r[0] += bf_lo(p.x); r[1] += bf_hi(p.x); r[2] += bf_lo(p.y); r[3] += bf_hi(p.y); r[4] += bf_lo(p.z); r[5] += bf_hi(p.z); r[6] += bf_lo(p.w); r[7] += bf_hi(p.w); }
                    u32x4 w; w.x = cvt_pk_bf16(r[0], r[1]); w.y = cvt_pk_bf16(r[2], r[3]); w.z = cvt_pk_bf16(r[4], r[5]); w.w = cvt_pk_bf16(r[6], r[7]);
                    *(u32x4*)op = w; }
                asm volatile("" ::: "memory"); }
    }
};
struct EpiX1 {
    static constexpr bool PERM = true, AFTER_DRAIN = false;
    const float* X; float* X1; bf16_t* X1B; float* SSQ; int ldc;
    __device__ __forceinline__ void operator()(const f32x4 (&acc)[2][2][4][2], const Unit& u, int wr, int wc, int fr, int fq) const {
        const int row0 = u.pm * BM + wr * 64 + fr, col0 = u.pn * BM + wc * 32 + 8 * fq;
#pragma unroll
        for (int ai = 0; ai < 2; ++ai)
#pragma unroll
            for (int m = 0; m < 4; ++m) { const size_t row = (size_t)(row0 + ai * HALF + m * 16); float ss = 0.f;
#pragma unroll
                for (int bj = 0; bj < 2; ++bj) { const size_t off = row * ldc + col0 + bj * HALF;
                    const f32x4 x0 = *(const f32x4*)(X + off), x1 = *(const f32x4*)(X + off + 4);
                    const f32x4 v0 = acc[ai][bj][m][0] + x0, v1 = acc[ai][bj][m][1] + x1;
                    *(f32x4*)(X1 + off) = v0; *(f32x4*)(X1 + off + 4) = v1;
                    u32x4 w; w.x = cvt_pk_bf16(v0[0], v0[1]); w.y = cvt_pk_bf16(v0[2], v0[3]); w.z = cvt_pk_bf16(v1[0], v1[1]); w.w = cvt_pk_bf16(v1[2], v1[3]);
                    *(u32x4*)(X1B + off) = w;
                    ss += (v0[0] * v0[0] + v0[1] * v0[1]) + (v0[2] * v0[2] + v0[3] * v0[3]) + (v1[0] * v1[0] + v1[1] * v1[1]) + (v1[2] * v1[2] + v1[3] * v1[3]); }
                ss += __shfl_xor(ss, 16); ss += __shfl_xor(ss, 32);
                if (fq == 0) atomicAdd(SSQ + row, ss);
                asm volatile("" ::: "memory"); }
    }
};
struct EpiQP {
    static constexpr bool PERM = true, AFTER_DRAIN = false;
    const float* SSQ; bf16_t* O; int ldc; float inv_n, eps;
    __device__ __forceinline__ void operator()(const f32x4 (&acc)[2][2][4][2], const Unit& u, int wr, int wc, int fr, int fq) const {
        const int row0 = u.pm * BM + wr * 64 + fr, col0 = u.pn * BM + wc * 32 + 8 * fq;
#pragma unroll
        for (int ai = 0; ai < 2; ++ai)
#pragma unroll
            for (int m = 0; m < 4; ++m) { const size_t row = (size_t)(row0 + ai * HALF + m * 16); const float inv = 1.0f / sqrtf(SSQ[row] * inv_n + eps);
                bf16_t* rowp = O + row * ldc + col0;
#pragma unroll
                for (int bj = 0; bj < 2; ++bj) { const f32x4 v0 = acc[ai][bj][m][0] * inv, v1 = acc[ai][bj][m][1] * inv;
                    u32x4 w; w.x = cvt_pk_bf16(v0[0], v0[1]); w.y = cvt_pk_bf16(v0[2], v0[3]); w.z = cvt_pk_bf16(v1[0], v1[1]); w.w = cvt_pk_bf16(v1[2], v1[3]);
                    *(u32x4*)(rowp + bj * HALF) = w; } }
    }
};


template <class Epi, class Sched, bool ALIGN_EPI = false, bool SP2 = false>
__device__ __forceinline__ void gemm_phase(PG8_LAS unsigned char* lds, const Gemm g, const Sched& S, const Epi& E) {
    const int tid = threadIdx.x, wid = __builtin_amdgcn_readfirstlane(tid >> 6), lane = tid & 63, wr = wid >> 2, wc = wid & 3, fr = lane & 15, fq = lane >> 4;
    const int K = g.K, nt = K / BK;
    unsigned voffA[2], voffB[2];
#pragma unroll
    for (int i = 0; i < 2; ++i) { int R, C; stage_rc(tid * 16 + i * 8192, R, C); const int Rb = Epi::PERM ? ((R & ~31) + perm32(R & 31)) : R;
        voffA[i] = (unsigned)(R * K + C) * 2u; voffB[i] = (unsigned)(Rb * K + C) * 2u; }
    const size_t kstep = (size_t)(BK * 2);
    const size_t hstep = (size_t)HALF * K * 2;
    const size_t tstep = 2 * hstep;
    const unsigned ldsw = (unsigned)wid * 1024u;
    const int aoff = lds_byte(wr * 64 + fr, fq * 8), boff = lds_byte(wc * 32 + fr, fq * 8);
#define PG8_SA(b, h) (((b) * 2 + (h)) * HTB)
#define PG8_SB(b, h) ((4 + (b) * 2 + (h)) * HTB)
#define PG8_STAGE(bufoff, gbase, voff) do { _Pragma("unroll") for (int _i = 0; _i < 2; ++_i) \
        __builtin_amdgcn_global_load_lds((const unsigned*)((const char*)(gbase) + (voff)[_i]), (PG8_LAS unsigned*)(lds + (bufoff) + ldsw + _i * 8192), 16, 0, 0); } while (0)
#define PG8_LDA(dst, b, h) do { _Pragma("unroll") for (int m = 0; m < 4; ++m) _Pragma("unroll") for (int k = 0; k < 2; ++k) dst[m][k] = *(const PG8_LAS bf16x8*)(lds + PG8_SA(b, h) + aoff + m * 2048 + k * 1024); } while (0)
#define PG8_LDB(dst, b, h) do { _Pragma("unroll") for (int n = 0; n < 2; ++n) _Pragma("unroll") for (int k = 0; k < 2; ++k) dst[n][k] = *(const PG8_LAS bf16x8*)(lds + PG8_SB(b, h) + boff + n * 2048 + k * 1024); } while (0)
#define PG8_MMA(ai, bj, At, Bt) do { __builtin_amdgcn_s_setprio(1); _Pragma("unroll") for (int m = 0; m < 4; ++m) _Pragma("unroll") for (int n = 0; n < 2; ++n) _Pragma("unroll") for (int k = 0; k < 2; ++k) \
        acc[ai][bj][m][n] = __builtin_amdgcn_mfma_f32_16x16x32_bf16(Bt[n][k], At[m][k], acc[ai][bj][m][n], 0, 0, 0); __builtin_amdgcn_s_setprio(0); } while (0)
#define PG8_WAIT_V(n) asm volatile("s_waitcnt vmcnt(" #n ")" ::: "memory")
#define PG8_WAIT_L(n) asm volatile("s_waitcnt lgkmcnt(" #n ")" ::: "memory")
#define PG8_BAR __builtin_amdgcn_s_barrier()
#define PG8_SCHED __builtin_amdgcn_sched_barrier(0)
    Unit cur, nxt; int ui = 0;
    if (!S.next(0, cur)) return;
    f32x4 acc[2][2][4][2];
#pragma unroll
    for (int a = 0; a < 2; ++a)
#pragma unroll
        for (int b = 0; b < 2; ++b)
#pragma unroll
            for (int m = 0; m < 4; ++m)
#pragma unroll
                for (int n = 0; n < 2; ++n) acc[a][b][m][n] = (f32x4){0.f, 0.f, 0.f, 0.f};
    bf16x8 At[4][2], B0[2][2], B1[2][2];
    const char* cA = (const char*)g.A + (size_t)cur.pm * tstep; const char* cB = (const char*)g.Bt + (size_t)cur.pn * tstep;
    S.a_ready(cur);
    if constexpr (SP2) {
        PG8_STAGE(PG8_SB(0, 0), cB, voffB); PG8_STAGE(PG8_SB(0, 1), cB + hstep, voffB); PG8_STAGE(PG8_SA(0, 0), cA, voffA); PG8_STAGE(PG8_SA(0, 1), cA + hstep, voffA);
        if (wr == 1) PG8_BAR;
        PG8_WAIT_V(2); PG8_BAR;
        PG8_STAGE(PG8_SB(1, 0), cB + kstep, voffB); PG8_STAGE(PG8_SA(1, 0), cA + kstep, voffA); PG8_STAGE(PG8_SB(1, 1), cB + hstep + kstep, voffB);
        PG8_WAIT_V(6); PG8_BAR;
    } else {
        PG8_STAGE(PG8_SB(0, 0), cB, voffB); PG8_STAGE(PG8_SA(0, 0), cA, voffA); PG8_STAGE(PG8_SB(0, 1), cB + hstep, voffB); PG8_STAGE(PG8_SA(0, 1), cA + hstep, voffA);
        if (wr == 1) PG8_BAR;
        PG8_WAIT_V(4); PG8_BAR;
        PG8_STAGE(PG8_SB(1, 0), cB + kstep, voffB); PG8_STAGE(PG8_SA(1, 0), cA + kstep, voffA); PG8_STAGE(PG8_SB(1, 1), cB + hstep + kstep, voffB);
        PG8_WAIT_V(6); PG8_BAR;
    }
    for (;;) {
        const bool has_next = S.next(ui + 1, nxt);
        const char* nA = has_next ? (const char*)g.A + (size_t)nxt.pm * tstep : cA; const char* nB = has_next ? (const char*)g.Bt + (size_t)nxt.pn * tstep : cB;
        for (int t = 0; t < nt; t += 2) {
            const bool last = (t == nt - 2);
            const char* a1 = cA + (size_t)(t + 1) * kstep;
            const char* a2 = last ? nA : cA + (size_t)(t + 2) * kstep; const char* b2 = last ? nB : cB + (size_t)(t + 2) * kstep;
            const char* a3 = a2 + kstep; const char* b3 = b2 + kstep;
            if (last && has_next) S.a_ready(nxt);
            if constexpr (SP2) {
            PG8_LDB(B0, 0, 0); PG8_LDB(B1, 0, 1); PG8_SCHED; PG8_LDA(At, 0, 0); PG8_STAGE(PG8_SA(1, 1), a1 + hstep, voffA);
            PG8_WAIT_V(8); PG8_WAIT_L(0); PG8_BAR; PG8_MMA(0, 0, At, B0); PG8_MMA(0, 1, At, B1); PG8_BAR; PG8_SCHED;
            PG8_LDA(At, 0, 1); PG8_STAGE(PG8_SB(0, 0), b2, voffB); PG8_STAGE(PG8_SB(0, 1), b2 + hstep, voffB); PG8_STAGE(PG8_SA(0, 0), a2, voffA);
            PG8_WAIT_V(8); PG8_WAIT_L(0); PG8_BAR; PG8_MMA(1, 0, At, B0); PG8_MMA(1, 1, At, B1); PG8_BAR; PG8_SCHED;
            PG8_LDB(B0, 1, 0); PG8_LDB(B1, 1, 1); PG8_SCHED; PG8_LDA(At, 1, 0); PG8_STAGE(PG8_SA(0, 1), a2 + hstep, voffA);
            PG8_WAIT_V(8); PG8_WAIT_L(0); PG8_BAR; PG8_MMA(0, 0, At, B0); PG8_MMA(0, 1, At, B1); PG8_BAR; PG8_SCHED;
            PG8_LDA(At, 1, 1); PG8_STAGE(PG8_SB(1, 0), b3, voffB); PG8_STAGE(PG8_SB(1, 1), b3 + hstep, voffB); PG8_STAGE(PG8_SA(1, 0), a3, voffA);
            PG8_WAIT_V(8); PG8_WAIT_L(0); PG8_BAR; PG8_MMA(1, 0, At, B0); PG8_MMA(1, 1, At, B1); PG8_BAR; PG8_SCHED;
            } else {
            PG8_LDB(B0, 0, 0); PG8_SCHED; PG8_LDA(At, 0, 0); PG8_STAGE(PG8_SA(1, 1), a1 + hstep, voffA);
            PG8_WAIT_L(8); PG8_BAR; PG8_WAIT_L(0); PG8_MMA(0, 0, At, B0); PG8_BAR; PG8_SCHED;
            PG8_LDB(B1, 0, 1); PG8_STAGE(PG8_SB(0, 0), b2, voffB);
            PG8_BAR; PG8_WAIT_L(0); PG8_MMA(0, 1, At, B1); PG8_BAR;
            PG8_LDA(At, 0, 1); PG8_STAGE(PG8_SA(0, 0), a2, voffA);
            PG8_BAR; PG8_WAIT_L(0); PG8_MMA(1, 0, At, B0); PG8_BAR; PG8_SCHED;
            PG8_STAGE(PG8_SB(0, 1), b2 + hstep, voffB);
            PG8_WAIT_V(6); PG8_BAR; PG8_MMA(1, 1, At, B1); PG8_BAR;
            PG8_LDB(B0, 1, 0); PG8_SCHED; PG8_LDA(At, 1, 0); PG8_STAGE(PG8_SA(0, 1), a2 + hstep, voffA);
            PG8_WAIT_L(8); PG8_BAR; PG8_WAIT_L(0); PG8_MMA(0, 0, At, B0); PG8_BAR; PG8_SCHED;
            PG8_LDB(B1, 1, 1); PG8_STAGE(PG8_SB(1, 0), b3, voffB);
            PG8_BAR; PG8_WAIT_L(0); PG8_MMA(0, 1, At, B1); PG8_BAR;
            PG8_LDA(At, 1, 1); PG8_STAGE(PG8_SA(1, 0), a3, voffA);
            PG8_BAR; PG8_WAIT_L(0); PG8_MMA(1, 0, At, B0); PG8_BAR; PG8_SCHED;
            PG8_STAGE(PG8_SB(1, 1), b3 + hstep, voffB);
            PG8_WAIT_V(6); PG8_BAR; PG8_MMA(1, 1, At, B1); PG8_BAR;
            }
        }
        if constexpr (ALIGN_EPI) { if (wr == 0) PG8_BAR; }
        if constexpr (!Epi::AFTER_DRAIN) { E(acc, cur, wr, wc, fr, fq); S.done(cur); }
        if (!has_next) break;
#pragma unroll
        for (int a = 0; a < 2; ++a)
#pragma unroll
            for (int b = 0; b < 2; ++b)
#pragma unroll
                for (int m = 0; m < 4; ++m)
#pragma unroll
                    for (int n = 0; n < 2; ++n) acc[a][b][m][n] = (f32x4){0.f, 0.f, 0.f, 0.f};
        cur = nxt; cA = nA; cB = nB; ++ui;
        if constexpr (ALIGN_EPI) { if (wr == 1) PG8_BAR; }
    }
    PG8_WAIT_V(0);
    if constexpr (!ALIGN_EPI) { if (wr == 0) PG8_BAR; }
    PG8_BAR;
    if constexpr (Epi::AFTER_DRAIN) { E.fused(acc, cur, wr, wc, fr, fq, lds, wid, lane); S.done(cur); }
#undef PG8_SA
#undef PG8_SB
#undef PG8_STAGE
#undef PG8_LDA
#undef PG8_LDB
#undef PG8_MMA
#undef PG8_WAIT_V
#undef PG8_WAIT_L
#undef PG8_BAR
#undef PG8_SCHED
}
}


constexpr int NWAVES = 8;
constexpr int T = 8192, D = 2048, CW = 1024, AW = 1024, NH = 16, HD = 64, INW = 10240;
constexpr int C_CB = 0, C_CC = 1024, C_CH = 2048, C_Q = 3072, C_K = 4096, C_V = 5120, C_GC = 6144, C_GA = 8192;
constexpr int PH = 8, PKEYS = 128, PHALF = 128, PQD = 256, PTOPK = 16, NEXP = 16384, NPAIR = PH * PTOPK;
constexpr float RMS_EPS = 1e-6f;

constexpr size_t MiB = 1u << 20;
constexpr size_t WS_CTL = 0, CTL_ZERO_BYTES = 1 * MiB;
constexpr size_t WS_WIN = 1 * MiB;
constexpr size_t WS_WCO = 41 * MiB;
constexpr size_t WS_WAO = 45 * MiB;
constexpr size_t WS_WO = 49 * MiB;
constexpr size_t WS_WQ = 57 * MiB;
constexpr size_t WS_SK = 65 * MiB;
constexpr size_t WS_XN = 66 * MiB;
constexpr size_t WS_YC = 98 * MiB;
constexpr size_t WS_YA = 114 * MiB;
constexpr size_t WS_UT = 130 * MiB;
constexpr size_t WS_VT = 194 * MiB;
constexpr size_t WS_PROJ = 258 * MiB;
constexpr size_t WS_X1B = WS_PROJ;
constexpr size_t WS_QP = WS_PROJ + 32 * MiB;
constexpr size_t WS_IDX = WS_PROJ + 64 * MiB;
constexpr size_t WS_GATE = WS_PROJ + 68 * MiB;
constexpr size_t WS_ACT = WS_PROJ + 72 * MiB;
constexpr size_t WS_END = 418 * MiB;
constexpr int CW_BAR = 4096;
constexpr int CW_SSQ = 65536;
static_assert((CW_SSQ + T) * 4 <= (int)CTL_ZERO_BYTES, "ctl");

constexpr int RING_OFF = 0, RING_BYTES = 131072;
constexpr int LDSCTL_OFF = RING_BYTES, MISC_OFF = LDSCTL_OFF + 320;
constexpr int LDS_BYTES = 147456;

#define GAS __attribute__((address_space(1)))
#define LAS __attribute__((address_space(3)))
typedef unsigned short bf16;
typedef unsigned v4u __attribute__((ext_vector_type(4)));
typedef float f32x4 __attribute__((ext_vector_type(4)));
typedef short bf16x8 __attribute__((ext_vector_type(8)));
typedef GAS unsigned gu32;
typedef GAS unsigned long long gu64;
#define RLX_AGENT __ATOMIC_RELAXED, __HIP_MEMORY_SCOPE_AGENT
#define LDS_WAIT() asm volatile("s_waitcnt lgkmcnt(0)" ::: "memory")
#define VM_WAIT() asm volatile("s_waitcnt vmcnt(0)" ::: "memory")
__device__ __forceinline__ unsigned long long rt() { return __builtin_amdgcn_s_memrealtime(); }
__device__ __forceinline__ unsigned f2bf(float f) { unsigned u = __builtin_bit_cast(unsigned, f); return (u + 0x7fffu + ((u >> 16) & 1u)) >> 16; }
__device__ __forceinline__ unsigned pk2(float lo, float hi) { return f2bf(lo) | (f2bf(hi) << 16); }

#define XB_TMO      128
#define XB_XCNT(j)  (256  + 64 * (j))
#define XB_XSUB(j)  (1280 + 64 * (j))
#define XB_XGEN(j)  (2304 + 64 * (j))
#define XB_TOP      3328
#define XB_TOPGEN   3392
#define XCD_BAR_WORDS 3456
#define XB_SPIN_CAP (1u << 18)

__device__ __forceinline__ unsigned xb_ld(unsigned* p)              { return __hip_atomic_load(p, __ATOMIC_RELAXED, __HIP_MEMORY_SCOPE_AGENT); }
__device__ __forceinline__ unsigned xb_add(unsigned* p, unsigned v) { return __hip_atomic_fetch_add(p, v, __ATOMIC_RELAXED, __HIP_MEMORY_SCOPE_AGENT); }
__device__ __forceinline__ unsigned xb_xcc_id() { return (unsigned)__builtin_amdgcn_s_getreg((3 << 11) | 20) & 0xFu; }
#define XB_SPIN(cond, bar) do { unsigned _sp = 0; while (cond) { __builtin_amdgcn_s_sleep(1); \
    if ((++_sp & 255u) == 0u) { if (xb_ld(&(bar)[XB_TMO])) break; if (_sp > XB_SPIN_CAP) { atomicAdd(&(bar)[XB_TMO], 1u); break; } } } } while (0)

struct XcdBarrier {
    unsigned* bar; unsigned x;
    volatile LAS unsigned* st;
};

__device__ __forceinline__ XcdBarrier xcd_barrier_post(unsigned* bar, volatile LAS unsigned* st) {
    XcdBarrier b; b.bar = bar; b.x = xb_xcc_id(); b.st = st;
    if (threadIdx.x == 0) (void)xb_add(&bar[XB_XCNT(b.x)], 1u);
    return b;
}
__device__ __forceinline__ void xcd_barrier_complete(unsigned* bar, unsigned x, unsigned& nloc, unsigned& nx) {
    const unsigned G = gridDim.x * gridDim.y * gridDim.z;
    unsigned sum, cnt, mine, sp = 0u;
    for (;;) {
        sum = 0u; cnt = 0u; mine = 0u;
#pragma unroll
        for (unsigned j = 0; j < 16; ++j) { const unsigned c = xb_ld(&bar[XB_XCNT(j)]); sum += c; cnt += (c > 0u) ? 1u : 0u; mine = (j == x) ? c : mine; }
        if (sum == G) break;
        __builtin_amdgcn_s_sleep(1);
        if ((++sp & 255u) == 0u) { if (xb_ld(&bar[XB_TMO])) break; if (sp > XB_SPIN_CAP) { atomicAdd(&bar[XB_TMO], 1u); break; } }
    }
    nloc = mine > 0u ? mine : 1u; nx = cnt > 0u ? cnt : 1u;
}

__device__ __forceinline__ void xcd_barrier(const XcdBarrier& b) {
    asm volatile("s_waitcnt vmcnt(0)" ::: "memory");
    __syncthreads();
    if (threadIdx.x == 0) {
        unsigned* bar = b.bar;
        __builtin_amdgcn_s_waitcnt(0);
        unsigned nloc = b.st[0], nx = b.st[1];
        if (nloc == 0u) { xcd_barrier_complete(bar, b.x, nloc, nx); b.st[0] = nloc; b.st[1] = nx; }
        const unsigned old = xb_add(&bar[XB_XSUB(b.x)], 1u);
        const unsigned gen = old / nloc;
        if (old + 1u == (gen + 1u) * nloc) {
            __builtin_amdgcn_fence(__ATOMIC_RELEASE, "agent");
            asm volatile("s_waitcnt vmcnt(0)" ::: "memory");
            const unsigned og = xb_add(&bar[XB_TOP], 1u);
            const unsigned tg = og / nx;
            if (og + 1u == (tg + 1u) * nx) xb_add(&bar[XB_TOPGEN], 1u);
            else XB_SPIN(xb_ld(&bar[XB_TOPGEN]) == tg, bar);
            __builtin_amdgcn_fence(__ATOMIC_ACQUIRE, "agent");
            xb_add(&bar[XB_XGEN(b.x)], 1u);
            asm volatile("s_waitcnt vmcnt(0)" ::: "memory");
        } else {
            XB_SPIN(xb_ld(&bar[XB_XGEN(b.x)]) == gen, bar);
            __builtin_amdgcn_fence(__ATOMIC_ACQUIRE, "agent");
            asm volatile("s_waitcnt vmcnt(0)" ::: "memory");
        }
    }
    __syncthreads();
}


typedef float f32x16 __attribute__((ext_vector_type(16)));
typedef short s16x4 __attribute__((ext_vector_type(4)));
typedef unsigned u32x2 __attribute__((ext_vector_type(2)));
__device__ __forceinline__ float wave_sum(float v) {
#pragma unroll
    for (int o = 1; o < 64; o <<= 1) v += __shfl_xor(v, o);
    return v;
}
__device__ __forceinline__ float partner32(float v) { return __shfl_xor(v, 32); }
__device__ __forceinline__ int partner32i(int v) { return __shfl_xor(v, 32); }
__device__ __forceinline__ int crow(int r, int hi) { return (r & 3) + 8 * (r >> 2) + 4 * hi; }
__device__ __forceinline__ float bflo(unsigned w) { return __uint_as_float(w << 16); }
__device__ __forceinline__ float bfhi(unsigned w) { return __uint_as_float(w & 0xffff0000u); }
__device__ __forceinline__ unsigned cvtpk(float lo, float hi) { unsigned r; asm volatile("v_cvt_pk_bf16_f32 %0, %1, %2" : "=v"(r) : "v"(lo), "v"(hi)); return r; }

__device__ __forceinline__ void p0_transpose_item(const float* W, int K, int N, bf16* WT, const float* kscale, LAS float* scr, int item, int lane) {
    const int nblk = N / 32, kb = item / nblk, nb = item % nblk, k0 = 64 * kb, n0 = 32 * nb;
#pragma unroll 8
    for (int i = 0; i < 32; ++i) { const int kk = 2 * i + (lane >> 5); float v = W[(size_t)(k0 + kk) * N + n0 + (lane & 31)]; if (kscale) v *= kscale[k0 + kk]; scr[kk * 33 + (lane & 31)] = v; }
    LDS_WAIT(); asm volatile("" ::: "memory");
    const int c = lane & 7;
#pragma unroll
    for (int j = 0; j < 4; ++j) { const int n = (lane >> 3) + 8 * j; const LAS float* s = scr + (8 * c) * 33 + n;
        v4u o; o.x = pk2(s[0 * 33], s[1 * 33]); o.y = pk2(s[2 * 33], s[3 * 33]); o.z = pk2(s[4 * 33], s[5 * 33]); o.w = pk2(s[6 * 33], s[7 * 33]);
        *(v4u*)(WT + (size_t)(n0 + n) * K + k0 + 8 * c) = o; }
    LDS_WAIT(); asm volatile("" ::: "memory");
}
__device__ __forceinline__ void rms_row_to_bf16(const float* xrow, const float* gain, bf16* orow, int lane) {
    const f32x4* xr = (const f32x4*)xrow + lane; const f32x4* gr = (const f32x4*)gain + lane;
    f32x4 v[8]; float s = 0.f;
#pragma unroll
    for (int j = 0; j < 8; ++j) { v[j] = xr[64 * j]; s += (v[j].x * v[j].x + v[j].y * v[j].y) + (v[j].z * v[j].z + v[j].w * v[j].w); }
    const float inv = 1.f / sqrtf(wave_sum(s) * (1.f / D) + RMS_EPS);
    u32x2* o8 = (u32x2*)orow + lane;
#pragma unroll
    for (int j = 0; j < 8; ++j) { const f32x4 g = gr[64 * j]; u32x2 w; w.x = pk2(v[j].x * inv * g.x, v[j].y * inv * g.y); w.y = pk2(v[j].z * inv * g.z, v[j].w * inv * g.w); o8[64 * j] = w; }
}

struct Ptrs {
    const float *x, *norm_mix, *w_in, *conv_w, *w_conv_out, *w_attn_out, *w_out, *norm_ffn, *peer_wq, *peer_sk, *peer_u, *peer_v, *norm_final;
    float* out; unsigned char* ws;
};

__device__ __forceinline__ void p0_prologue(const Ptrs& P, LAS unsigned char* lds, int vcu, int G, int wave, int lane, int tid) {
    LAS float* scr = (LAS float*)(lds + RING_OFF + wave * 16384);
    const int gw = vcu * NWAVES + wave, NGW = G * NWAVES;
    bf16* WIN = (bf16*)(P.ws + WS_WIN); bf16* WCO = (bf16*)(P.ws + WS_WCO); bf16* WAO = (bf16*)(P.ws + WS_WAO); bf16* WO = (bf16*)(P.ws + WS_WO); bf16* WQ = (bf16*)(P.ws + WS_WQ);
    constexpr int I_IN = (D / 64) * (INW / 32), I_CO = (CW / 64) * (D / 32), I_AO = (AW / 64) * (D / 32), I_O = (D / 64) * (D / 32), I_Q = I_O;
    constexpr int NITEMS = I_IN + I_CO + I_AO + I_O + I_Q;
    for (int it = gw; it < NITEMS; it += NGW) {
        int r = it;
        if (r < I_IN) { p0_transpose_item(P.w_in, D, INW, WIN, nullptr, scr, r, lane); continue; } r -= I_IN;
        if (r < I_CO) { p0_transpose_item(P.w_conv_out, CW, D, WCO, nullptr, scr, r, lane); continue; } r -= I_CO;
        if (r < I_AO) { p0_transpose_item(P.w_attn_out, AW, D, WAO, nullptr, scr, r, lane); continue; } r -= I_AO;
        if (r < I_O) { p0_transpose_item(P.w_out, D, D, WO, nullptr, scr, r, lane); continue; } r -= I_O;
        p0_transpose_item(P.peer_wq, D, D, WQ, P.norm_ffn, scr, r, lane);
    }
    bf16* XN = (bf16*)(P.ws + WS_XN);
    for (int m = gw; m < T; m += NGW) rms_row_to_bf16(P.x + (size_t)m * D, P.norm_mix, XN + (size_t)m * D, lane);
    {
        const int gt = (vcu * NWAVES + wave) * 64 + lane, NGT = G * NWAVES * 64;
        constexpr int NIT = NEXP * D / 8;
        v4u* UT = (v4u*)(P.ws + WS_UT); v4u* VT = (v4u*)(P.ws + WS_VT);
        for (int it = gt; it < NIT; it += NGT) {
            const size_t e0 = (size_t)it * 8; const int col = (int)(e0 & (D - 1));
            const f32x4 u0 = *(const f32x4*)(P.peer_u + e0), u1 = *(const f32x4*)(P.peer_u + e0 + 4);
            const f32x4 v0 = *(const f32x4*)(P.peer_v + e0), v1 = *(const f32x4*)(P.peer_v + e0 + 4);
            const f32x4 g0 = *(const f32x4*)(P.norm_ffn + col), g1 = *(const f32x4*)(P.norm_ffn + col + 4);
            v4u a, b;
            a.x = pk2(u0.x * g0.x, u0.y * g0.y); a.y = pk2(u0.z * g0.z, u0.w * g0.w); a.z = pk2(u1.x * g1.x, u1.y * g1.y); a.w = pk2(u1.z * g1.z, u1.w * g1.w);
            b.x = pk2(v0.x, v0.y); b.y = pk2(v0.z, v0.w); b.z = pk2(v1.x, v1.y); b.w = pk2(v1.z, v1.w);
            UT[it] = a; VT[it] = b;
        }
        bf16* SK = (bf16*)(P.ws + WS_SK);
        for (int it = gt; it < 2 * PKEYS * PHALF; it += NGT) SK[it] = (bf16)f2bf(P.peer_sk[it]);
    }
}

__device__ __forceinline__ void p2_conv(const Ptrs& P, int gt, int NGT) {
    const bf16* PROJ = (const bf16*)(P.ws + WS_PROJ); bf16* YC = (bf16*)(P.ws + WS_YC);
    constexpr int NIT = (T / 8) * (CW / 8);
    for (int it = gt; it < NIT; it += NGT) {
        const int ch = it % (CW / 8), tb = it / (CW / 8), c0 = ch * 8, t0 = tb * 8;
        float w0[8], w1[8], w2[8];
#pragma unroll
        for (int i = 0; i < 8; ++i) { w0[i] = P.conv_w[c0 + i]; w1[i] = P.conv_w[CW + c0 + i]; w2[i] = P.conv_w[2 * CW + c0 + i]; }
        float zm2[8], zm1[8];
#pragma unroll
        for (int i = 0; i < 8; ++i) { zm2[i] = 0.f; zm1[i] = 0.f; }
#pragma unroll
        for (int dt = -2; dt < 8; ++dt) {
            const int t = t0 + dt; if (t < 0) continue;
            const v4u cc = *(const v4u*)(PROJ + (size_t)t * INW + C_CC + c0), hh = *(const v4u*)(PROJ + (size_t)t * INW + C_CH + c0);
            float z[8];
            z[0] = bflo(cc.x) * bflo(hh.x); z[1] = bfhi(cc.x) * bfhi(hh.x); z[2] = bflo(cc.y) * bflo(hh.y); z[3] = bfhi(cc.y) * bfhi(hh.y);
            z[4] = bflo(cc.z) * bflo(hh.z); z[5] = bfhi(cc.z) * bfhi(hh.z); z[6] = bflo(cc.w) * bflo(hh.w); z[7] = bfhi(cc.w) * bfhi(hh.w);
            if (dt >= 0) {
                const v4u cb = *(const v4u*)(PROJ + (size_t)t * INW + C_CB + c0);
                float b[8] = {bflo(cb.x), bfhi(cb.x), bflo(cb.y), bfhi(cb.y), bflo(cb.z), bfhi(cb.z), bflo(cb.w), bfhi(cb.w)};
                float y[8];
#pragma unroll
                for (int i = 0; i < 8; ++i) y[i] = b[i] * (w0[i] * zm2[i] + w1[i] * zm1[i] + w2[i] * z[i]);
                v4u o; o.x = pk2(y[0], y[1]); o.y = pk2(y[2], y[3]); o.z = pk2(y[4], y[5]); o.w = pk2(y[6], y[7]);
                *(v4u*)(YC + (size_t)t * CW + c0) = o;
            }
#pragma unroll
            for (int i = 0; i < 8; ++i) { zm2[i] = zm1[i]; zm1[i] = z[i]; }
        }
    }
}

__device__ __forceinline__ s16x4 vtr(LAS const unsigned char* p) { typedef short v4i16_t __attribute__((ext_vector_type(4))); return __builtin_bit_cast(s16x4, __builtin_amdgcn_ds_read_tr16_b64_v4i16((LAS v4i16_t*)p)); }

__device__ __forceinline__ void attn_task(const bf16* PROJ, bf16* YA, LAS unsigned char* vl  , int qt, int h, int lane) {
    const int r32 = lane & 31, hi = lane >> 5, q0 = qt * 32;
    const bf16* Qp = PROJ + (size_t)(q0 + r32) * INW + C_Q + h * HD + 8 * hi;
    bf16x8 qf[4];
#pragma unroll
    for (int s = 0; s < 4; ++s) qf[s] = *(const bf16x8*)(Qp + 16 * s);
    float carry = 1.f;
    f32x16 o0, o1;
#pragma unroll
    for (int r = 0; r < 16; ++r) { o0[r] = 0.f; o1[r] = 0.f; }
    const int g1 = (lane >> 4) & 1, qq = (lane & 15) >> 2, pp = lane & 3;
    LAS const unsigned char* vrd = vl + (4 * hi + qq) * 128 + g1 * 32 + pp * 8;
    for (int kt = qt; kt >= 0; --kt) {
        const int k0 = kt * 32;
        const bf16* Kp = PROJ + (size_t)(k0 + r32) * INW + C_K + h * HD + 8 * hi;
        bf16x8 kf[4];
#pragma unroll
        for (int s = 0; s < 4; ++s) kf[s] = *(const bf16x8*)(Kp + 16 * s);
        v4u vv[4];
#pragma unroll
        for (int i = 0; i < 4; ++i) { const int c = lane + 64 * i, row = c >> 3, chn = c & 7; vv[i] = *(const v4u*)(PROJ + (size_t)(k0 + row) * INW + C_V + h * HD + chn * 8); }
        f32x16 S;
#pragma unroll
        for (int r = 0; r < 16; ++r) S[r] = 0.f;
#pragma unroll
        for (int s = 0; s < 4; ++s) S = __builtin_amdgcn_mfma_f32_32x32x16_bf16(kf[s], qf[s], S, 0, 0, 0);
#pragma unroll
        for (int i = 0; i < 4; ++i) { const int c = lane + 64 * i, row = c >> 3, chn = c & 7; *(LAS v4u*)(vl + row * 128 + chn * 16) = vv[i]; }
        float kp[16], bt[16];
        const float cs = 0.125f * 1.4426950408889634f;
#pragma unroll
        for (int r = 0; r < 16; ++r) { const float a = fminf(S[r] * cs, 126.f); const float e = __builtin_amdgcn_exp2f(a); const float ri = __builtin_amdgcn_rcpf(1.f + e); kp[r] = ri; bt[r] = e * ri; }
        if (kt == qt) {
#pragma unroll
            for (int r = 0; r < 16; ++r) { if (crow(r, hi) >= r32) { kp[r] = 1.f; bt[r] = 0.f; } }
        }
        float Pm[4], Qm[4], Tt[4];
#pragma unroll
        for (int i = 0; i < 4; ++i) { Pm[i] = (kp[4 * i] * kp[4 * i + 1]) * (kp[4 * i + 2] * kp[4 * i + 3]); Qm[i] = partner32(Pm[i]); Tt[i] = Pm[i] * Qm[i]; }
        float R[4]; R[3] = 1.f; R[2] = Tt[3]; R[1] = Tt[3] * Tt[2]; R[0] = R[1] * Tt[1];
        const float total = R[0] * Tt[0];
        float w[16];
#pragma unroll
        for (int i = 0; i < 4; ++i) {
            const float base = carry * R[i] * (hi ? 1.f : Qm[i]);
            const float x3 = base, x2 = x3 * kp[4 * i + 3], x1 = x2 * kp[4 * i + 2], x0 = x1 * kp[4 * i + 1];
            w[4 * i + 3] = bt[4 * i + 3] * x3; w[4 * i + 2] = bt[4 * i + 2] * x2; w[4 * i + 1] = bt[4 * i + 1] * x1; w[4 * i] = bt[4 * i] * x0;
        }
        carry *= total;
        v4u wa0, wa1;
        wa0.x = cvtpk(w[0], w[1]); wa0.y = cvtpk(w[2], w[3]); wa0.z = cvtpk(w[4], w[5]); wa0.w = cvtpk(w[6], w[7]);
        wa1.x = cvtpk(w[8], w[9]); wa1.y = cvtpk(w[10], w[11]); wa1.z = cvtpk(w[12], w[13]); wa1.w = cvtpk(w[14], w[15]);
        asm volatile("s_waitcnt lgkmcnt(0)" ::: "memory");
        s16x4 l00 = vtr(vrd + 0 * 64 + 0 * 2048), h00 = vtr(vrd + 0 * 64 + 0 * 2048 + 1024);
        s16x4 l01 = vtr(vrd + 0 * 64 + 1 * 2048), h01 = vtr(vrd + 0 * 64 + 1 * 2048 + 1024);
        s16x4 l10 = vtr(vrd + 1 * 64 + 0 * 2048), h10 = vtr(vrd + 1 * 64 + 0 * 2048 + 1024);
        s16x4 l11 = vtr(vrd + 1 * 64 + 1 * 2048), h11 = vtr(vrd + 1 * 64 + 1 * 2048 + 1024);
        asm volatile("s_waitcnt lgkmcnt(0)" ::: "memory");
#define PKV(l, hh) (bf16x8){l[0], l[1], l[2], l[3], hh[0], hh[1], hh[2], hh[3]}
        o0 = __builtin_amdgcn_mfma_f32_32x32x16_bf16(__builtin_bit_cast(bf16x8, wa0), PKV(l00, h00), o0, 0, 0, 0);
        o0 = __builtin_amdgcn_mfma_f32_32x32x16_bf16(__builtin_bit_cast(bf16x8, wa1), PKV(l01, h01), o0, 0, 0, 0);
        o1 = __builtin_amdgcn_mfma_f32_32x32x16_bf16(__builtin_bit_cast(bf16x8, wa0), PKV(l10, h10), o1, 0, 0, 0);
        o1 = __builtin_amdgcn_mfma_f32_32x32x16_bf16(__builtin_bit_cast(bf16x8, wa1), PKV(l11, h11), o1, 0, 0, 0);
#undef PKV
        if (__all(carry < 1e-30f)) break;
    }
    bf16* Op = YA + (size_t)q0 * AW + h * HD + r32;
#pragma unroll
    for (int r = 0; r < 16; ++r) { const int qr = crow(r, hi); Op[(size_t)qr * AW] = (bf16)f2bf(o0[r]); Op[(size_t)qr * AW + 32] = (bf16)f2bf(o1[r]); }
}

template <int N> __device__ __forceinline__ float take_max(float (&v)[N]) {
    float m = v[0];
#pragma unroll
    for (int i = 1; i < N; ++i) m = fmaxf(m, v[i]);
    const float g = fmaxf(m, partner32(m));
#pragma unroll
    for (int i = 0; i < N; ++i) v[i] = (v[i] == g) ? -INFINITY : v[i];
    return g;
}
struct constexpr_ij { int i, j; };
__host__ __device__ constexpr constexpr_ij cand_ij(int k) {
    int n = 0;
    for (int i = 0; i < 16; ++i) for (int j = 0; j < 16; ++j) if ((i + 1) * (j + 1) <= 16) { if (n == k) return constexpr_ij{i, j}; ++n; }
    return constexpr_ij{0, 0};
}
__device__ __forceinline__ void topk_task(const bf16* QP, const bf16* SK, int* IDX, float* GATE, int tt, int h, int lane) {
    const int r32 = lane & 31, hi = lane >> 5, t = tt * 32 + r32;
    float top[2][16];
#pragma unroll
    for (int side = 0; side < 2; ++side) {
        const bf16* Qp = QP + (size_t)t * D + h * PQD + side * PHALF + 8 * hi;
        bf16x8 qf[8];
#pragma unroll
        for (int s = 0; s < 8; ++s) qf[s] = *(const bf16x8*)(Qp + 16 * s);
        float sc[64];
#pragma unroll
        for (int kb = 0; kb < 4; ++kb) {
            const bf16* Kp = SK + (size_t)(side * PKEYS + kb * 32 + r32) * PHALF + 8 * hi;
            asm volatile("" : "+v"(Kp));
            f32x16 S;
#pragma unroll
            for (int r = 0; r < 16; ++r) S[r] = 0.f;
#pragma unroll
            for (int s = 0; s < 8; ++s) { const bf16x8 kf = *(const bf16x8*)(Kp + 16 * s); S = __builtin_amdgcn_mfma_f32_32x32x16_bf16(kf, qf[s], S, 0, 0, 0); }
#pragma unroll
            for (int r = 0; r < 16; ++r) { const unsigned key = (unsigned)(kb * 32 + crow(r, hi)); sc[kb * 16 + r] = __uint_as_float((__float_as_uint(S[r]) & ~127u) | (127u - key)); }
            asm volatile("" ::: "memory");
        }
#pragma unroll
        for (int k = 0; k < 16; ++k) top[side][k] = take_max<64>(sc);
        asm volatile("" ::: "memory");
    }
    asm volatile("" ::: "memory");
    float cv[25]; int ci[25];
#pragma unroll
    for (int k = 0; k < 25; ++k) {
        constexpr_ij c0 = cand_ij(k), c1 = cand_ij(k + 25);
        const float a = hi ? top[0][c1.i] : top[0][c0.i], b = hi ? top[1][c1.j] : top[1][c0.j];
        const float s = a + b;
        cv[k] = __uint_as_float((__float_as_uint(s) & ~63u) | (unsigned)(hi ? 63 - (k + 25) : 63 - k));
        ci[k] = (int)(127u - (__float_as_uint(a) & 127u)) * PKEYS + (int)(127u - (__float_as_uint(b) & 127u));
    }
    float sv[16]; int si[16];
#pragma unroll
    for (int k = 0; k < 16; ++k) {
        float m = cv[0];
#pragma unroll
        for (int i = 1; i < 25; ++i) m = fmaxf(m, cv[i]);
        const float g = fmaxf(m, partner32(m));
        int id = 0;
#pragma unroll
        for (int i = 0; i < 25; ++i) { const bool hit = (cv[i] == g); id = hit ? ci[i] : id; cv[i] = hit ? -INFINITY : cv[i]; }
        const int pid = partner32i(id);
        sv[k] = g; si[k] = id > pid ? id : pid;
    }
    float ex[16], sum = 0.f;
#pragma unroll
    for (int k = 0; k < 16; ++k) { ex[k] = __expf(sv[k] - sv[0]); sum += ex[k]; }
    const float rs = 1.f / sum;
    if (!hi) {
        int* ip = IDX + (size_t)t * NPAIR + h * PTOPK;
#pragma unroll
        for (int k = 0; k < 16; k += 4) *(int4*)(ip + k) = make_int4(si[k], si[k + 1], si[k + 2], si[k + 3]);
    } else {
        float* gp = GATE + (size_t)t * NPAIR + h * PTOPK;
#pragma unroll
        for (int k = 0; k < 16; k += 4) *(f32x4*)(gp + k) = (f32x4){ex[k] * rs, ex[k + 1] * rs, ex[k + 2] * rs, ex[k + 3] * rs};
    }
}

__device__ __forceinline__ float dot8(const v4u& a, const v4u& b, float acc) {
    acc += bflo(a.x) * bflo(b.x); acc += bfhi(a.x) * bfhi(b.x); acc += bflo(a.y) * bflo(b.y); acc += bfhi(a.y) * bfhi(b.y);
    acc += bflo(a.z) * bflo(b.z); acc += bfhi(a.z) * bfhi(b.z); acc += bflo(a.w) * bflo(b.w); acc += bfhi(a.w) * bfhi(b.w);
    return acc;
}
__device__ __forceinline__ void peer_u_token(const bf16* X1B, const bf16* UT, const float* SSQ, const int* IDX, const float* GATE, float* ACT, int t, int lane) {
    const v4u* xr = (const v4u*)(X1B + (size_t)t * D) + lane;
    v4u xv[4];
#pragma unroll
    for (int j = 0; j < 4; ++j) xv[j] = xr[64 * j];
    const float inv = 1.0f / sqrtf(SSQ[t] * (1.f / D) + RMS_EPS);
    const int id0 = IDX[(size_t)t * NPAIR + lane], id1 = IDX[(size_t)t * NPAIR + 64 + lane];
    const float g0 = GATE[(size_t)t * NPAIR + lane], g1 = GATE[(size_t)t * NPAIR + 64 + lane];
    float res0 = 0.f, res1 = 0.f;
#pragma unroll 1
    for (int pb = 0; pb < 128; pb += 4) {
        float a[4];
        v4u uv[4][4];
#pragma unroll
        for (int k = 0; k < 4; ++k) {
            const int p = pb + k;
            const int e = (p < 64) ? __builtin_amdgcn_readlane(id0, p & 63) : __builtin_amdgcn_readlane(id1, p & 63);
            const v4u* ur = (const v4u*)(UT + (size_t)e * D) + lane;
#pragma unroll
            for (int j = 0; j < 4; ++j) uv[k][j] = ur[64 * j];
        }
#pragma unroll
        for (int k = 0; k < 4; ++k) {
            float s = 0.f;
#pragma unroll
            for (int j = 0; j < 4; ++j) s = dot8(xv[j], uv[k][j], s);
            a[k] = wave_sum(s);
        }
#pragma unroll
        for (int k = 0; k < 4; ++k) { const int p = pb + k; if (p < 64) { if (lane == p) res0 = a[k]; } else { if (lane == p - 64) res1 = a[k]; } }
    }
    const float h0 = res0 * inv, h1 = res1 * inv;
    ACT[(size_t)t * NPAIR + lane] = 0.5f * h0 * (1.f + erff(h0 * 0.70710678118654752f)) * g0;
    ACT[(size_t)t * NPAIR + 64 + lane] = 0.5f * h1 * (1.f + erff(h1 * 0.70710678118654752f)) * g1;
}

__device__ __forceinline__ void peer_v_token(const bf16* VT, const float* X1, const int* IDX, const float* ACT, const float* gfin, float* OUT, int t, int lane) {
    float acc[32];
#pragma unroll
    for (int i = 0; i < 32; ++i) acc[i] = 0.f;
    const int id0 = IDX[(size_t)t * NPAIR + lane], id1 = IDX[(size_t)t * NPAIR + 64 + lane];
    const float a0 = ACT[(size_t)t * NPAIR + lane], a1 = ACT[(size_t)t * NPAIR + 64 + lane];
#pragma unroll 1
    for (int pb = 0; pb < 128; pb += 2) {
        v4u vv[2][4]; int aa[2];
#pragma unroll
        for (int k = 0; k < 2; ++k) {
            const int p = pb + k;
            const int e = (p < 64) ? __builtin_amdgcn_readlane(id0, p & 63) : __builtin_amdgcn_readlane(id1, p & 63);
            aa[k] = (p < 64) ? __builtin_amdgcn_readlane(__float_as_int(a0), p & 63) : __builtin_amdgcn_readlane(__float_as_int(a1), p & 63);
            const v4u* vr = (const v4u*)(VT + (size_t)e * D) + lane;
#pragma unroll
            for (int j = 0; j < 4; ++j) vv[k][j] = vr[64 * j];
        }
#pragma unroll
        for (int k = 0; k < 2; ++k) { const float a = __int_as_float(aa[k]);
#pragma unroll
            for (int j = 0; j < 4; ++j) {
                acc[8 * j + 0] += a * bflo(vv[k][j].x); acc[8 * j + 1] += a * bfhi(vv[k][j].x); acc[8 * j + 2] += a * bflo(vv[k][j].y); acc[8 * j + 3] += a * bfhi(vv[k][j].y);
                acc[8 * j + 4] += a * bflo(vv[k][j].z); acc[8 * j + 5] += a * bfhi(vv[k][j].z); acc[8 * j + 6] += a * bflo(vv[k][j].w); acc[8 * j + 7] += a * bfhi(vv[k][j].w);
            } }
    }
    float ss = 0.f;
#pragma unroll
    for (int j = 0; j < 4; ++j) {
        const f32x4 x0 = *(const f32x4*)(X1 + (size_t)t * D + 512 * j + 8 * lane), x1 = *(const f32x4*)(X1 + (size_t)t * D + 512 * j + 8 * lane + 4);
        acc[8 * j + 0] += x0.x; acc[8 * j + 1] += x0.y; acc[8 * j + 2] += x0.z; acc[8 * j + 3] += x0.w; acc[8 * j + 4] += x1.x; acc[8 * j + 5] += x1.y; acc[8 * j + 6] += x1.z; acc[8 * j + 7] += x1.w;
#pragma unroll
        for (int i = 0; i < 8; ++i) ss += acc[8 * j + i] * acc[8 * j + i];
    }
    const float inv = 1.0f / sqrtf(wave_sum(ss) * (1.f / D) + RMS_EPS);
#pragma unroll
    for (int j = 0; j < 4; ++j) {
        const f32x4 g0 = *(const f32x4*)(gfin + 512 * j + 8 * lane), g1 = *(const f32x4*)(gfin + 512 * j + 8 * lane + 4);
        *(f32x4*)(OUT + (size_t)t * D + 512 * j + 8 * lane) = (f32x4){acc[8 * j] * inv * g0.x, acc[8 * j + 1] * inv * g0.y, acc[8 * j + 2] * inv * g0.z, acc[8 * j + 3] * inv * g0.w};
        *(f32x4*)(OUT + (size_t)t * D + 512 * j + 8 * lane + 4) = (f32x4){acc[8 * j + 4] * inv * g1.x, acc[8 * j + 5] * inv * g1.y, acc[8 * j + 6] * inv * g1.z, acc[8 * j + 7] * inv * g1.w};
    }
}

#ifndef PHASE_MASK
#define PHASE_MASK 0x1ff
#endif
#define PH_ON(k) ((PHASE_MASK >> (k)) & 1)
__global__ void __launch_bounds__(NWAVES * 64, 2) hyb_fwd(Ptrs P) {
    extern __shared__ __attribute__((aligned(16))) unsigned char lds_raw[];
    LAS unsigned char* lds = (LAS unsigned char*)lds_raw;
    volatile LAS unsigned* MISC = (volatile LAS unsigned*)(lds + MISC_OFF);
    const int tid = threadIdx.x, lane = tid & 63, wave = __builtin_amdgcn_readfirstlane(tid >> 6);
    const int G = gridDim.x; const int bx = blockIdx.x; const int vcu = (G % 8 == 0) ? (bx % 8) * (G / 8) + bx / 8 : bx;
    unsigned* ctl = (unsigned*)(P.ws + WS_CTL);
    for (int u = tid; u < (LDS_BYTES - LDSCTL_OFF) / 4; u += NWAVES * 64) ((LAS unsigned*)(lds + LDSCTL_OFF))[u] = 0u;
    __syncthreads();
    XcdBarrier bar = xcd_barrier_post(ctl + CW_BAR, MISC + 8);
    const int gw = vcu * NWAVES + wave, NGW = G * NWAVES;
    float* SSQ = (float*)(ctl + CW_SSQ);
    bf16* PROJ = (bf16*)(P.ws + WS_PROJ);

    if (PH_ON(0)) p0_prologue(P, lds, vcu, G, wave, lane, tid);
    xcd_barrier(bar);

    if (PH_ON(1)) {
        pg8::Gemm g{(const pg8::bf16_t*)(P.ws + WS_XN), (const pg8::bf16_t*)(P.ws + WS_WIN), T, INW, D}; pg8::StaticOrder S; S.init(T, INW, G, bx);
        pg8::EpiStore E{(pg8::bf16_t*)PROJ, INW};
        pg8::gemm_phase<pg8::EpiStore, pg8::StaticOrder, true, true>(lds + RING_OFF, g, S, E);
    }
    xcd_barrier(bar);

    if (PH_ON(2)) {
        p2_conv(P, gw * 64 + lane, NGW * 64);
        bf16* YA = (bf16*)(P.ws + WS_YA);
        LAS unsigned char* vl = lds + RING_OFF + wave * 4096;
        constexpr int NTASK = (T / 32) * NH;
        for (int it = gw; it < NTASK; it += NGW) { const int task = NTASK - 1 - it; attn_task(PROJ, YA, vl, task / NH, task % NH, lane); }
    }
    xcd_barrier(bar);

    if (PH_ON(3)) {
        pg8::StaticOrder S; S.init(T, D, G, bx);
        pg8::bf16_t* MERGED = (pg8::bf16_t*)(P.ws + WS_XN);
        { pg8::Gemm g{(const pg8::bf16_t*)(P.ws + WS_YC), (const pg8::bf16_t*)(P.ws + WS_WCO), T, D, CW};
          pg8::EpiGate<0> E{(const pg8::bf16_t*)PROJ + C_GC, INW, MERGED, D};
          pg8::gemm_phase<pg8::EpiGate<0>, pg8::StaticOrder, true, true>(lds + RING_OFF, g, S, E); }
        { pg8::Gemm g{(const pg8::bf16_t*)(P.ws + WS_YA), (const pg8::bf16_t*)(P.ws + WS_WAO), T, D, AW};
          pg8::EpiGate<1> E{(const pg8::bf16_t*)PROJ + C_GA, INW, MERGED, D};
          pg8::gemm_phase<pg8::EpiGate<1>, pg8::StaticOrder, true, true>(lds + RING_OFF, g, S, E); }
    }
    xcd_barrier(bar);

    if (PH_ON(4)) {
        pg8::Gemm g{(const pg8::bf16_t*)(P.ws + WS_XN), (const pg8::bf16_t*)(P.ws + WS_WO), T, D, D}; pg8::StaticOrder S; S.init(T, D, G, bx);
        pg8::EpiX1 E{P.x, P.out, (pg8::bf16_t*)(P.ws + WS_X1B), SSQ, D};
        pg8::gemm_phase<pg8::EpiX1, pg8::StaticOrder, true, true>(lds + RING_OFF, g, S, E);
    }
    xcd_barrier(bar);

    if (PH_ON(5)) {
        pg8::Gemm g{(const pg8::bf16_t*)(P.ws + WS_X1B), (const pg8::bf16_t*)(P.ws + WS_WQ), T, D, D}; pg8::StaticOrder S; S.init(T, D, G, bx);
        pg8::EpiQP E{SSQ, (pg8::bf16_t*)(P.ws + WS_QP), D, 1.f / D, RMS_EPS};
        pg8::gemm_phase<pg8::EpiQP, pg8::StaticOrder, true, true>(lds + RING_OFF, g, S, E);
    }
    xcd_barrier(bar);

    if (PH_ON(6)) {
        constexpr int NTASK = (T / 32) * PH;
        for (int it = gw; it < NTASK; it += NGW) topk_task((const bf16*)(P.ws + WS_QP), (const bf16*)(P.ws + WS_SK), (int*)(P.ws + WS_IDX), (float*)(P.ws + WS_GATE), it / PH, it % PH, lane);
    }
    xcd_barrier(bar);

    if (PH_ON(7)) for (int t = gw; t < T; t += NGW) peer_u_token((const bf16*)(P.ws + WS_X1B), (const bf16*)(P.ws + WS_UT), SSQ, (const int*)(P.ws + WS_IDX), (const float*)(P.ws + WS_GATE), (float*)(P.ws + WS_ACT), t, lane);
    xcd_barrier(bar);

    if (PH_ON(8)) for (int t = gw; t < T; t += NGW) peer_v_token((const bf16*)(P.ws + WS_VT), P.out, (const int*)(P.ws + WS_IDX), (const float*)(P.ws + WS_ACT), P.norm_final, P.out, t, lane);
}

extern "C" void kernel_launch(void* const* d_in, const int* in_sizes, int n_in, void* d_out, int out_size, void* d_ws, size_t ws_size, hipStream_t stream) {
    static int grid = 0;
    if (grid == 0) {
        if (n_in != 13 || out_size != T * D || ws_size < WS_END) { fprintf(stderr, "kernel_launch: unexpected shapes (n_in %d out %d ws %zu)\n", n_in, out_size, ws_size); grid = -1; return; }
        int dev = 0, cus = 0, per_cu = 0;
        if (hipGetDevice(&dev) != hipSuccess || hipDeviceGetAttribute(&cus, hipDeviceAttributeMultiprocessorCount, dev) != hipSuccess) { grid = -1; return; }
        if (hipFuncSetAttribute((const void*)hyb_fwd, hipFuncAttributeMaxDynamicSharedMemorySize, LDS_BYTES) != hipSuccess) { fprintf(stderr, "kernel_launch: hipFuncSetAttribute failed\n"); grid = -1; return; }
        if (hipOccupancyMaxActiveBlocksPerMultiprocessor(&per_cu, (const void*)hyb_fwd, NWAVES * 64, LDS_BYTES) != hipSuccess || per_cu < 1) { fprintf(stderr, "kernel_launch: occupancy query says %d\n", per_cu); per_cu = 1; }
        (void)hipGetLastError();
        grid = cus;
    }
    if (grid < 0) return;
    (void)hipMemsetAsync((char*)d_ws + WS_CTL, 0, CTL_ZERO_BYTES, stream);
    Ptrs p{};
    p.x = (const float*)d_in[0]; p.norm_mix = (const float*)d_in[1]; p.w_in = (const float*)d_in[2]; p.conv_w = (const float*)d_in[3];
    p.w_conv_out = (const float*)d_in[4]; p.w_attn_out = (const float*)d_in[5]; p.w_out = (const float*)d_in[6]; p.norm_ffn = (const float*)d_in[7];
    p.peer_wq = (const float*)d_in[8]; p.peer_sk = (const float*)d_in[9]; p.peer_u = (const float*)d_in[10]; p.peer_v = (const float*)d_in[11]; p.norm_final = (const float*)d_in[12];
    p.out = (float*)d_out; p.ws = (unsigned char*)d_ws;
    void* args[] = {&p};
    hipError_t e = hipLaunchCooperativeKernel((const void*)hyb_fwd, dim3(grid), dim3(NWAVES * 64), args, LDS_BYTES, stream);
    if (e != hipSuccess) fprintf(stderr, "kernel_launch: cooperative launch failed: %s (grid %d)\n", hipGetErrorString(e), grid);
}
```

```cpp
#include <hip/hip_runtime.h>
#include <cstdio>
#include <cstdint>
namespace pg8 {
#define PG8_LAS __attribute__((address_space(3)))
typedef unsigned short bf16_t;
typedef short bf16x8 __attribute__((ext_vector_type(8)));
typedef float f32x4 __attribute__((ext_vector_type(4)));
typedef unsigned u32x4 __attribute__((ext_vector_type(4)));
constexpr int BM = 256, BK = 64, HALF = 128, HTB = HALF * BK * 2  , STAGE_BYTES = 8 * HTB, NXCD = 8, WGM = 8;

__host__ __device__ __forceinline__ int lds_byte(int r, int c) { const int st = (r >> 4) * 2 + (c >> 5), rr = r & 15, cc = c & 31, ob = rr * 64 + cc * 2; return st * 1024 + (ob ^ (((ob >> 9) & 1) << 5)); }
__host__ __device__ __forceinline__ void stage_rc(int b, int& R, int& C) { const int st = b / 1024, sb = b % 1024, swz = sb ^ (((sb >> 9) & 1) << 5); R = (st >> 1) * 16 + swz / 64; C = (st & 1) * 32 + (swz % 64) / 2; }
__host__ __device__ __forceinline__ int perm32(int rho) { const int n = rho >> 4, i = rho & 15; return 8 * (i >> 2) + 4 * n + (i & 3); }

struct Unit { int pm, pn; };
struct Gemm { const bf16_t* A; const bf16_t* Bt; int M, N, K; };

struct StaticOrder {
    int nM, nN, nwg, G, c;
    __host__ __device__ void init(int M, int N, int G_, int c_) { nM = M / BM; nN = N / BM; nwg = nM * nN; G = G_; c = c_; }
    __host__ __device__ bool next(int i, Unit& u) const {
        const long L = (long)i * G + c; if (L >= nwg) return false;
        int wgid = (int)L; { const int q = nwg / NXCD, r = nwg % NXCD, xcd = wgid % NXCD, off = wgid / NXCD; wgid = (xcd < r ? xcd * (q + 1) : r * (q + 1) + (xcd - r) * q) + off; }
        const int nig = WGM * nN, gid = wgid / nig, fm = gid * WGM, gsz = (nM - fm) < WGM ? (nM - fm) : WGM;
        u.pm = fm + ((wgid % nig) % gsz); u.pn = (wgid % nig) / gsz; return true;
    }
    __device__ __forceinline__ void a_ready(const Unit&) const {}
    __device__ __forceinline__ void done(const Unit&) const {}
};


__device__ __forceinline__ unsigned cvt_pk_bf16(float lo, float hi) { unsigned r; asm volatile("v_cvt_pk_bf16_f32 %0, %1, %2" : "=v"(r) : "v"(lo), "v"(hi)); return r; }
__device__ __forceinline__ float bf_lo(unsigned w) { return __uint_as_float(w << 16); }
__device__ __forceinline__ float bf_hi(unsigned w) { return __uint_as_float(w & 0xffff0000u); }
__device__ __forceinline__ float sigmoidf_fast(float x) { return __builtin_amdgcn_rcpf(1.0f + __builtin_amdgcn_exp2f(-1.4426950408889634f * x)); }

struct EpiStore {
    static constexpr bool PERM = true, AFTER_DRAIN = false;
    bf16_t* O; int ldc;
    __device__ __forceinline__ void operator()(const f32x4 (&acc)[2][2][4][2], const Unit& u, int wr, int wc, int fr, int fq) const {
        const int row0 = u.pm * BM + wr * 64 + fr, col0 = u.pn * BM + wc * 32 + 8 * fq;
#pragma unroll
        for (int ai = 0; ai < 2; ++ai)
#pragma unroll
            for (int m = 0; m < 4; ++m) { bf16_t* rowp = O + (size_t)(row0 + ai * HALF + m * 16) * ldc + col0;
#pragma unroll
                for (int bj = 0; bj < 2; ++bj) { const f32x4 v0 = acc[ai][bj][m][0], v1 = acc[ai][bj][m][1];
                    u32x4 w; w.x = cvt_pk_bf16(v0[0], v0[1]); w.y = cvt_pk_bf16(v0[2], v0[3]); w.z = cvt_pk_bf16(v1[0], v1[1]); w.w = cvt_pk_bf16(v1[2], v1[3]);
                    *(u32x4*)(rowp + bj * HALF) = w; } }
    }
};
template <int PASS> struct EpiGate {
    static constexpr bool PERM = true, AFTER_DRAIN = false;
    const bf16_t* G; int ldg; bf16_t* O; int ldc;
    __device__ __forceinline__ void operator()(const f32x4 (&acc)[2][2][4][2], const Unit& u, int wr, int wc, int fr, int fq) const {
        const int row0 = u.pm * BM + wr * 64 + fr, col0 = u.pn * BM + wc * 32 + 8 * fq;
#pragma unroll
        for (int ai = 0; ai < 2; ++ai)
#pragma unroll
            for (int m = 0; m < 4; ++m) { const size_t row = (size_t)(row0 + ai * HALF + m * 16);
#pragma unroll
                for (int bj = 0; bj < 2; ++bj) { const f32x4 v0 = acc[ai][bj][m][0], v1 = acc[ai][bj][m][1];
                    const u32x4 g = *(const u32x4*)(G + row * ldg + col0 + bj * HALF);
                    float r[8];
                    r[0] = v0[0] * sigmoidf_fast(bf_lo(g.x)); r[1] = v0[1] * sigmoidf_fast(bf_hi(g.x)); r[2] = v0[2] * sigmoidf_fast(bf_lo(g.y)); r[3] = v0[3] * sigmoidf_fast(bf_hi(g.y));
                    r[4] = v1[0] * sigmoidf_fast(bf_lo(g.z)); r[5] = v1[1] * sigmoidf_fast(bf_hi(g.z)); r[6] = v1[2] * sigmoidf_fast(bf_lo(g.w)); r[7] = v1[3] * sigmoidf_fast(bf_hi(g.w));
                    bf16_t* op = O + row * ldc + col0 + bj * HALF;
                    if (PASS == 1) { const u32x4 p = *(const u32x4*)op;
                        r[0] += bf_lo(p.x); r[1] += bf_hi(p.x); r[2] += bf_lo(p.y); r[3] += bf_hi(p.y); r[4] += bf_lo(p.z); r[5] += bf_hi(p.z); r[6] += bf_lo(p.w); r[7] += bf_hi(p.w); }
                    u32x4 w; w.x = cvt_pk_bf16(r[0], r[1]); w.y = cvt_pk_bf16(r[2], r[3]); w.z = cvt_pk_bf16(r[4], r[5]); w.w = cvt_pk_bf16(r[6], r[7]);
                    *(u32x4*)op = w; }
                asm volatile("" ::: "memory"); }
    }
};
struct EpiX1 {
    static constexpr bool PERM = true, AFTER_DRAIN = false;
    const float* X; float* X1; bf16_t* X1B; float* SSQ; int ldc;
    __device__ __forceinline__ void operator()(const f32x4 (&acc)[2][2][4][2], const Unit& u, int wr, int wc, int fr, int fq) const {
        const int row0 = u.pm * BM + wr * 64 + fr, col0 = u.pn * BM + wc * 32 + 8 * fq;
#pragma unroll
        for (int ai = 0; ai < 2; ++ai)
#pragma unroll
            for (int m = 0; m < 4; ++m) { const size_t row = (size_t)(row0 + ai * HALF + m * 16); float ss = 0.f;
#pragma unroll
                for (int bj = 0; bj < 2; ++bj) { const size_t off = row * ldc + col0 + bj * HALF;
                    const f32x4 x0 = *(const f32x4*)(X + off), x1 = *(const f32x4*)(X + off + 4);
                    const f32x4 v0 = acc[ai][bj][m][0] + x0, v1 = acc[ai][bj][m][1] + x1;
                    *(f32x4*)(X1 + off) = v0; *(f32x4*)(X1 + off + 4) = v1;
                    u32x4 w; w.x = cvt_pk_bf16(v0[0], v0[1]); w.y = cvt_pk_bf16(v0[2], v0[3]); w.z = cvt_pk_bf16(v1[0], v1[1]); w.w = cvt_pk_bf16(v1[2], v1[3]);
                    *(u32x4*)(X1B + off) = w;
                    ss += (v0[0] * v0[0] + v0[1] * v0[1]) + (v0[2] * v0[2] + v0[3] * v0[3]) + (v1[0] * v1[0] + v1[1] * v1[1]) + (v1[2] * v1[2] + v1[3] * v1[3]); }
                ss += __shfl_xor(ss, 16); ss += __shfl_xor(ss, 32);
                if (fq == 0) atomicAdd(SSQ + row, ss);
                asm volatile("" ::: "memory"); }
    }
};
struct EpiQP {
    static constexpr bool PERM = true, AFTER_DRAIN = false;
    const float* SSQ; bf16_t* O; int ldc; float inv_n, eps;
    __device__ __forceinline__ void operator()(const f32x4 (&acc)[2][2][4][2], const Unit& u, int wr, int wc, int fr, int fq) const {
        const int row0 = u.pm * BM + wr * 64 + fr, col0 = u.pn * BM + wc * 32 + 8 * fq;
#pragma unroll
        for (int ai = 0; ai < 2; ++ai)
#pragma unroll
            for (int m = 0; m < 4; ++m) { const size_t row = (size_t)(row0 + ai * HALF + m * 16); const float inv = 1.0f / sqrtf(SSQ[row] * inv_n + eps);
                bf16_t* rowp = O + row * ldc + col0;
#pragma unroll
                for (int bj = 0; bj < 2; ++bj) { const f32x4 v0 = acc[ai][bj][m][0] * inv, v1 = acc[ai][bj][m][1] * inv;
                    u32x4 w; w.x = cvt_pk_bf16(v0[0], v0[1]); w.y = cvt_pk_bf16(v0[2], v0[3]); w.z = cvt_pk_bf16(v1[0], v1[1]); w.w = cvt_pk_bf16(v1[2], v1[3]);
                    *(u32x4*)(rowp + bj * HALF) = w; } }
    }
};


template <class Epi, class Sched, bool ALIGN_EPI = false, bool SP2 = false>
__device__ __forceinline__ void gemm_phase(PG8_LAS unsigned char* lds, const Gemm g, const Sched& S, const Epi& E) {
    const int tid = threadIdx.x, wid = __builtin_amdgcn_readfirstlane(tid >> 6), lane = tid & 63, wr = wid >> 2, wc = wid & 3, fr = lane & 15, fq = lane >> 4;
    const int K = g.K, nt = K / BK;
    unsigned voffA[2], voffB[2];
#pragma unroll
    for (int i = 0; i < 2; ++i) { int R, C; stage_rc(tid * 16 + i * 8192, R, C); const int Rb = Epi::PERM ? ((R & ~31) + perm32(R & 31)) : R;
        voffA[i] = (unsigned)(R * K + C) * 2u; voffB[i] = (unsigned)(Rb * K + C) * 2u; }
    const size_t kstep = (size_t)(BK * 2);
    const size_t hstep = (size_t)HALF * K * 2;
    const size_t tstep = 2 * hstep;
    const unsigned ldsw = (unsigned)wid * 1024u;
    const int aoff = lds_byte(wr * 64 + fr, fq * 8), boff = lds_byte(wc * 32 + fr, fq * 8);
#define PG8_SA(b, h) (((b) * 2 + (h)) * HTB)
#define PG8_SB(b, h) ((4 + (b) * 2 + (h)) * HTB)
#define PG8_STAGE(bufoff, gbase, voff) do { _Pragma("unroll") for (int _i = 0; _i < 2; ++_i) \
        __builtin_amdgcn_global_load_lds((const unsigned*)((const char*)(gbase) + (voff)[_i]), (PG8_LAS unsigned*)(lds + (bufoff) + ldsw + _i * 8192), 16, 0, 0); } while (0)
#define PG8_LDA(dst, b, h) do { _Pragma("unroll") for (int m = 0; m < 4; ++m) _Pragma("unroll") for (int k = 0; k < 2; ++k) dst[m][k] = *(const PG8_LAS bf16x8*)(lds + PG8_SA(b, h) + aoff + m * 2048 + k * 1024); } while (0)
#define PG8_LDB(dst, b, h) do { _Pragma("unroll") for (int n = 0; n < 2; ++n) _Pragma("unroll") for (int k = 0; k < 2; ++k) dst[n][k] = *(const PG8_LAS bf16x8*)(lds + PG8_SB(b, h) + boff + n * 2048 + k * 1024); } while (0)
#define PG8_MMA(ai, bj, At, Bt) do { __builtin_amdgcn_s_setprio(1); _Pragma("unroll") for (int m = 0; m < 4; ++m) _Pragma("unroll") for (int n = 0; n < 2; ++n) _Pragma("unroll") for (int k = 0; k < 2; ++k) \
        acc[ai][bj][m][n] = __builtin_amdgcn_mfma_f32_16x16x32_bf16(Bt[n][k], At[m][k], acc[ai][bj][m][n], 0, 0, 0); __builtin_amdgcn_s_setprio(0); } while (0)
#define PG8_WAIT_V(n) asm volatile("s_waitcnt vmcnt(" #n ")" ::: "memory")
#define PG8_WAIT_L(n) asm volatile("s_waitcnt lgkmcnt(" #n ")" ::: "memory")
#define PG8_BAR __builtin_amdgcn_s_barrier()
#define PG8_SCHED __builtin_amdgcn_sched_barrier(0)
    Unit cur, nxt; int ui = 0;
    if (!S.next(0, cur)) return;
    f32x4 acc[2][2][4][2];
#pragma unroll
    for (int a = 0; a < 2; ++a)
#pragma unroll
        for (int b = 0; b < 2; ++b)
#pragma unroll
            for (int m = 0; m < 4; ++m)
#pragma unroll
                for (int n = 0; n < 2; ++n) acc[a][b][m][n] = (f32x4){0.f, 0.f, 0.f, 0.f};
    bf16x8 At[4][2], B0[2][2], B1[2][2];
    const char* cA = (const char*)g.A + (size_t)cur.pm * tstep; const char* cB = (const char*)g.Bt + (size_t)cur.pn * tstep;
    S.a_ready(cur);
    if constexpr (SP2) {
        PG8_STAGE(PG8_SB(0, 0), cB, voffB); PG8_STAGE(PG8_SB(0, 1), cB + hstep, voffB); PG8_STAGE(PG8_SA(0, 0), cA, voffA); PG8_STAGE(PG8_SA(0, 1), cA + hstep, voffA);
        if (wr == 1) PG8_BAR;
        PG8_WAIT_V(2); PG8_BAR;
        PG8_STAGE(PG8_SB(1, 0), cB + kstep, voffB); PG8_STAGE(PG8_SA(1, 0), cA + kstep, voffA); PG8_STAGE(PG8_SB(1, 1), cB + hstep + kstep, voffB);
        PG8_WAIT_V(6); PG8_BAR;
    } else {
        PG8_STAGE(PG8_SB(0, 0), cB, voffB); PG8_STAGE(PG8_SA(0, 0), cA, voffA); PG8_STAGE(PG8_SB(0, 1), cB + hstep, voffB); PG8_STAGE(PG8_SA(0, 1), cA + hstep, voffA);
        if (wr == 1) PG8_BAR;
        PG8_WAIT_V(4); PG8_BAR;
        PG8_STAGE(PG8_SB(1, 0), cB + kstep, voffB); PG8_STAGE(PG8_SA(1, 0), cA + kstep, voffA); PG8_STAGE(PG8_SB(1, 1), cB + hstep + kstep, voffB);
        PG8_WAIT_V(6); PG8_BAR;
    }
    for (;;) {
        const bool has_next = S.next(ui + 1, nxt);
        const char* nA = has_next ? (const char*)g.A + (size_t)nxt.pm * tstep : cA; const char* nB = has_next ? (const char*)g.Bt + (size_t)nxt.pn * tstep : cB;
        for (int t = 0; t < nt; t += 2) {
            const bool last = (t == nt - 2);
            const char* a1 = cA + (size_t)(t + 1) * kstep;
            const char* a2 = last ? nA : cA + (size_t)(t + 2) * kstep; const char* b2 = last ? nB : cB + (size_t)(t + 2) * kstep;
            const char* a3 = a2 + kstep; const char* b3 = b2 + kstep;
            if (last && has_next) S.a_ready(nxt);
            if constexpr (SP2) {
            PG8_LDB(B0, 0, 0); PG8_LDB(B1, 0, 1); PG8_SCHED; PG8_LDA(At, 0, 0); PG8_STAGE(PG8_SA(1, 1), a1 + hstep, voffA);
            PG8_WAIT_V(8); PG8_WAIT_L(0); PG8_BAR; PG8_MMA(0, 0, At, B0); PG8_MMA(0, 1, At, B1); PG8_BAR; PG8_SCHED;
            PG8_LDA(At, 0, 1); PG8_STAGE(PG8_SB(0, 0), b2, voffB); PG8_STAGE(PG8_SB(0, 1), b2 + hstep, voffB); PG8_STAGE(PG8_SA(0, 0), a2, voffA);
            PG8_WAIT_V(8); PG8_WAIT_L(0); PG8_BAR; PG8_MMA(1, 0, At, B0); PG8_MMA(1, 1, At, B1); PG8_BAR; PG8_SCHED;
            PG8_LDB(B0, 1, 0); PG8_LDB(B1, 1, 1); PG8_SCHED; PG8_LDA(At, 1, 0); PG8_STAGE(PG8_SA(0, 1), a2 + hstep, voffA);
            PG8_WAIT_V(8); PG8_WAIT_L(0); PG8_BAR; PG8_MMA(0, 0, At, B0); PG8_MMA(0, 1, At, B1); PG8_BAR; PG8_SCHED;
            PG8_LDA(At, 1, 1); PG8_STAGE(PG8_SB(1, 0), b3, voffB); PG8_STAGE(PG8_SB(1, 1), b3 + hstep, voffB); PG8_STAGE(PG8_SA(1, 0), a3, voffA);
            PG8_WAIT_V(8); PG8_WAIT_L(0); PG8_BAR; PG8_MMA(1, 0, At, B0); PG8_MMA(1, 1, At, B1); PG8_BAR; PG8_SCHED;
            } else {
            PG8_LDB(B0, 0, 0); PG8_SCHED; PG8_LDA(At, 0, 0); PG8_STAGE(PG8_SA(1, 1), a1 + hstep, voffA);
            PG8_WAIT_L(8); PG8_BAR; PG8_WAIT_L(0); PG8_MMA(0, 0, At, B0); PG8_BAR; PG8_SCHED;
            PG8_LDB(B1, 0, 1); PG8_STAGE(PG8_SB(0, 0), b2, voffB);
            PG8_BAR; PG8_WAIT_L(0); PG8_MMA(0, 1, At, B1); PG8_BAR;
            PG8_LDA(At, 0, 1); PG8_STAGE(PG8_SA(0, 0), a2, voffA);
            PG8_BAR; PG8_WAIT_L(0); PG8_MMA(1, 0, At, B0); PG8_BAR; PG8_SCHED;
            PG8_STAGE(PG8_SB(0, 1), b2 + hstep, voffB);
            PG8_WAIT_V(6); PG8_BAR; PG8_MMA(1, 1, At, B1); PG8_BAR;
            PG8_LDB(B0, 1, 0); PG8_SCHED; PG8_LDA(At, 1, 0); PG8_STAGE(PG8_SA(0, 1), a2 + hstep, voffA);
            PG8_WAIT_L(8); PG8_BAR; PG8_WAIT_L(0); PG8_MMA(0, 0, At, B0); PG8_BAR; PG8_SCHED;
            PG8_LDB(B1, 1, 1); PG8_STAGE(PG8_SB(1, 0), b3, voffB);
            PG8_BAR; PG8_WAIT_L(0); PG8_MMA(0, 1, At, B1); PG8_BAR;
            PG8_LDA(At, 1, 1); PG8_STAGE(PG8_SA(1, 0), a3, voffA);
            PG8_BAR; PG8_WAIT_L(0); PG8_MMA(1, 0, At, B0); PG8_BAR; PG8_SCHED;
            PG8_STAGE(PG8_SB(1, 1), b3 + hstep, voffB);
            PG8_WAIT_V(6); PG8_BAR; PG8_MMA(1, 1, At, B1); PG8_BAR;
            }
        }
        if constexpr (ALIGN_EPI) { if (wr == 0) PG8_BAR; }
        if constexpr (!Epi::AFTER_DRAIN) { E(acc, cur, wr, wc, fr, fq); S.done(cur); }
        if (!has_next) break;
#pragma unroll
        for (int a = 0; a < 2; ++a)
#pragma unroll
            for (int b = 0; b < 2; ++b)
#pragma unroll
                for (int m = 0; m < 4; ++m)
#pragma unroll
                    for (int n = 0; n < 2; ++n) acc[a][b][m][n] = (f32x4){0.f, 0.f, 0.f, 0.f};
        cur = nxt; cA = nA; cB = nB; ++ui;
        if constexpr (ALIGN_EPI) { if (wr == 1) PG8_BAR; }
    }
    PG8_WAIT_V(0);
    if constexpr (!ALIGN_EPI) { if (wr == 0) PG8_BAR; }
    PG8_BAR;
    if constexpr (Epi::AFTER_DRAIN) { E.fused(acc, cur, wr, wc, fr, fq, lds, wid, lane); S.done(cur); }
#undef PG8_SA
#undef PG8_SB
#undef PG8_STAGE
#undef PG8_LDA
#undef PG8_LDB
#undef PG8_MMA
#undef PG8_WAIT_V
#undef PG8_WAIT_L
#undef PG8_BAR
#undef PG8_SCHED
}
}


constexpr int NWAVES = 8;
constexpr int T = 8192, D = 2048, CW = 1024, AW = 1024, NH = 16, HD = 64, INW = 10240;
constexpr int C_CB = 0, C_CC = 1024, C_CH = 2048, C_Q = 3072, C_K = 4096, C_V = 5120, C_GC = 6144, C_GA = 8192;
constexpr int PH = 8, PKEYS = 128, PHALF = 128, PQD = 256, PTOPK = 16, NEXP = 16384, NPAIR = PH * PTOPK;
constexpr float RMS_EPS = 1e-6f;

constexpr size_t MiB = 1u << 20;
constexpr size_t WS_CTL = 0, CTL_ZERO_BYTES = 1 * MiB;
constexpr size_t WS_WIN = 1 * MiB;
constexpr size_t WS_WCO = 41 * MiB;
constexpr size_t WS_WAO = 45 * MiB;
constexpr size_t WS_WO = 49 * MiB;
constexpr size_t WS_WQ = 57 * MiB;
constexpr size_t WS_SK = 65 * MiB;
constexpr size_t WS_XN = 66 * MiB;
constexpr size_t WS_YC = 98 * MiB;
constexpr size_t WS_YA = 114 * MiB;
constexpr size_t WS_UT = 130 * MiB;
constexpr size_t WS_VQ = 194 * MiB;
constexpr size_t WS_PROJ = 258 * MiB;
constexpr size_t WS_X1B = WS_PROJ;
constexpr size_t WS_QP = WS_PROJ + 32 * MiB;
constexpr size_t WS_IDX = WS_PROJ + 64 * MiB;
constexpr size_t WS_GATE = WS_PROJ + 68 * MiB;
constexpr size_t WS_ACT = WS_PROJ + 72 * MiB;
constexpr size_t WS_LIST = WS_PROJ + 76 * MiB;
constexpr size_t WS_END = 418 * MiB;
constexpr int CW_BAR = 4096;
constexpr int CW_SSQ = 65536;
constexpr int CW_SSQ2 = CW_SSQ + 8192;
static_assert((CW_SSQ2 + T) * 4 <= (int)CTL_ZERO_BYTES, "ctl");

constexpr int RING_OFF = 0, RING_BYTES = 131072;
constexpr int LDSCTL_OFF = RING_BYTES, MISC_OFF = LDSCTL_OFF + 320;
constexpr int LDS_BYTES = 147456;

#define GAS __attribute__((address_space(1)))
#define LAS __attribute__((address_space(3)))
typedef unsigned short bf16;
typedef unsigned v4u __attribute__((ext_vector_type(4)));
typedef float f32x4 __attribute__((ext_vector_type(4)));
typedef short bf16x8 __attribute__((ext_vector_type(8)));
typedef GAS unsigned gu32;
typedef GAS unsigned long long gu64;
#define RLX_AGENT __ATOMIC_RELAXED, __HIP_MEMORY_SCOPE_AGENT
#define LDS_WAIT() asm volatile("s_waitcnt lgkmcnt(0)" ::: "memory")
#define VM_WAIT() asm volatile("s_waitcnt vmcnt(0)" ::: "memory")
__device__ __forceinline__ unsigned long long rt() { return __builtin_amdgcn_s_memrealtime(); }
__device__ __forceinline__ unsigned f2bf(float f) { unsigned u = __builtin_bit_cast(unsigned, f); return (u + 0x7fffu + ((u >> 16) & 1u)) >> 16; }
__device__ __forceinline__ unsigned pk2(float lo, float hi) { return f2bf(lo) | (f2bf(hi) << 16); }

#define XB_TMO      128
#define XB_XCNT(j)  (256  + 64 * (j))
#define XB_XSUB(j)  (1280 + 64 * (j))
#define XB_XGEN(j)  (2304 + 64 * (j))
#define XB_TOP      3328
#define XB_TOPGEN   3392
#define XCD_BAR_WORDS 3456
#define XB_SPIN_CAP (1u << 18)

__device__ __forceinline__ unsigned xb_ld(unsigned* p)              { return __hip_atomic_load(p, __ATOMIC_RELAXED, __HIP_MEMORY_SCOPE_AGENT); }
__device__ __forceinline__ unsigned xb_add(unsigned* p, unsigned v) { return __hip_atomic_fetch_add(p, v, __ATOMIC_RELAXED, __HIP_MEMORY_SCOPE_AGENT); }
__device__ __forceinline__ unsigned xb_xcc_id() { return (unsigned)__builtin_amdgcn_s_getreg((3 << 11) | 20) & 0xFu; }
#define XB_SPIN(cond, bar) do { unsigned _sp = 0; while (cond) { __builtin_amdgcn_s_sleep(1); \
    if ((++_sp & 255u) == 0u) { if (xb_ld(&(bar)[XB_TMO])) break; if (_sp > XB_SPIN_CAP) { atomicAdd(&(bar)[XB_TMO], 1u); break; } } } } while (0)

struct XcdBarrier {
    unsigned* bar; unsigned x;
    volatile LAS unsigned* st;
};

__device__ __forceinline__ XcdBarrier xcd_barrier_post(unsigned* bar, volatile LAS unsigned* st) {
    XcdBarrier b; b.bar = bar; b.x = xb_xcc_id(); b.st = st;
    if (threadIdx.x == 0) (void)xb_add(&bar[XB_XCNT(b.x)], 1u);
    return b;
}
__device__ __forceinline__ void xcd_barrier_complete(unsigned* bar, unsigned x, unsigned& nloc, unsigned& nx) {
    const unsigned G = gridDim.x * gridDim.y * gridDim.z;
    unsigned sum, cnt, mine, sp = 0u;
    for (;;) {
        sum = 0u; cnt = 0u; mine = 0u;
#pragma unroll
        for (unsigned j = 0; j < 16; ++j) { const unsigned c = xb_ld(&bar[XB_XCNT(j)]); sum += c; cnt += (c > 0u) ? 1u : 0u; mine = (j == x) ? c : mine; }
        if (sum == G) break;
        __builtin_amdgcn_s_sleep(1);
        if ((++sp & 255u) == 0u) { if (xb_ld(&bar[XB_TMO])) break; if (sp > XB_SPIN_CAP) { atomicAdd(&bar[XB_TMO], 1u); break; } }
    }
    nloc = mine > 0u ? mine : 1u; nx = cnt > 0u ? cnt : 1u;
}

__device__ __forceinline__ void xcd_barrier(const XcdBarrier& b) {
    asm volatile("s_waitcnt vmcnt(0)" ::: "memory");
    __syncthreads();
    if (threadIdx.x == 0) {
        unsigned* bar = b.bar;
        __builtin_amdgcn_s_waitcnt(0);
        unsigned nloc = b.st[0], nx = b.st[1];
        if (nloc == 0u) { xcd_barrier_complete(bar, b.x, nloc, nx); b.st[0] = nloc; b.st[1] = nx; }
        const unsigned old = xb_add(&bar[XB_XSUB(b.x)], 1u);
        const unsigned gen = old / nloc;
        if (old + 1u == (gen + 1u) * nloc) {
            __builtin_amdgcn_fence(__ATOMIC_RELEASE, "agent");
            asm volatile("s_waitcnt vmcnt(0)" ::: "memory");
            const unsigned og = xb_add(&bar[XB_TOP], 1u);
            const unsigned tg = og / nx;
            if (og + 1u == (tg + 1u) * nx) xb_add(&bar[XB_TOPGEN], 1u);
            else XB_SPIN(xb_ld(&bar[XB_TOPGEN]) == tg, bar);
            __builtin_amdgcn_fence(__ATOMIC_ACQUIRE, "agent");
            xb_add(&bar[XB_XGEN(b.x)], 1u);
            asm volatile("s_waitcnt vmcnt(0)" ::: "memory");
        } else {
            XB_SPIN(xb_ld(&bar[XB_XGEN(b.x)]) == gen, bar);
            __builtin_amdgcn_fence(__ATOMIC_ACQUIRE, "agent");
            asm volatile("s_waitcnt vmcnt(0)" ::: "memory");
        }
    }
    __syncthreads();
}


typedef float f32x16 __attribute__((ext_vector_type(16)));
typedef short s16x4 __attribute__((ext_vector_type(4)));
typedef unsigned u32x2 __attribute__((ext_vector_type(2)));
typedef float f32x2 __attribute__((ext_vector_type(2)));
__device__ __forceinline__ float wave_sum(float v) {
#pragma unroll
    for (int o = 1; o < 64; o <<= 1) v += __shfl_xor(v, o);
    return v;
}
__device__ __forceinline__ float partner32(float v) { return __shfl_xor(v, 32); }
__device__ __forceinline__ int partner32i(int v) { return __shfl_xor(v, 32); }
__device__ __forceinline__ int crow(int r, int hi) { return (r & 3) + 8 * (r >> 2) + 4 * hi; }
__device__ __forceinline__ float bflo(unsigned w) { return __uint_as_float(w << 16); }
__device__ __forceinline__ float bfhi(unsigned w) { return __uint_as_float(w & 0xffff0000u); }
__device__ __forceinline__ unsigned cvtpk(float lo, float hi) { unsigned r; asm volatile("v_cvt_pk_bf16_f32 %0, %1, %2" : "=v"(r) : "v"(lo), "v"(hi)); return r; }

__device__ __forceinline__ void p0_transpose_item(const float* W, int K, int N, bf16* WT, const float* kscale, LAS float* scr, int item, int lane) {
    const int nblk = N / 32, kb = item / nblk, nb = item % nblk, k0 = 64 * kb, n0 = 32 * nb;
#pragma unroll 8
    for (int i = 0; i < 32; ++i) { const int kk = 2 * i + (lane >> 5); float v = W[(size_t)(k0 + kk) * N + n0 + (lane & 31)]; if (kscale) v *= kscale[k0 + kk]; scr[kk * 33 + (lane & 31)] = v; }
    LDS_WAIT(); asm volatile("" ::: "memory");
    const int c = lane & 7;
#pragma unroll
    for (int j = 0; j < 4; ++j) { const int n = (lane >> 3) + 8 * j; const LAS float* s = scr + (8 * c) * 33 + n;
        v4u o; o.x = pk2(s[0 * 33], s[1 * 33]); o.y = pk2(s[2 * 33], s[3 * 33]); o.z = pk2(s[4 * 33], s[5 * 33]); o.w = pk2(s[6 * 33], s[7 * 33]);
        *(v4u*)(WT + (size_t)(n0 + n) * K + k0 + 8 * c) = o; }
    LDS_WAIT(); asm volatile("" ::: "memory");
}
__device__ __forceinline__ void rms_row_to_bf16(const float* xrow, const float* gain, bf16* orow, int lane) {
    const f32x4* xr = (const f32x4*)xrow + lane; const f32x4* gr = (const f32x4*)gain + lane;
    f32x4 v[8]; float s = 0.f;
#pragma unroll
    for (int j = 0; j < 8; ++j) { v[j] = xr[64 * j]; s += (v[j].x * v[j].x + v[j].y * v[j].y) + (v[j].z * v[j].z + v[j].w * v[j].w); }
    const float inv = 1.f / sqrtf(wave_sum(s) * (1.f / D) + RMS_EPS);
    u32x2* o8 = (u32x2*)orow + lane;
#pragma unroll
    for (int j = 0; j < 8; ++j) { const f32x4 g = gr[64 * j]; u32x2 w; w.x = pk2(v[j].x * inv * g.x, v[j].y * inv * g.y); w.y = pk2(v[j].z * inv * g.z, v[j].w * inv * g.w); o8[64 * j] = w; }
}

struct Ptrs {
    const float *x, *norm_mix, *w_in, *conv_w, *w_conv_out, *w_attn_out, *w_out, *norm_ffn, *peer_wq, *peer_sk, *peer_u, *peer_v, *norm_final;
    float* out; unsigned char* ws;
};

__device__ __forceinline__ void p0_prologue(const Ptrs& P, LAS unsigned char* lds, int vcu, int G, int wave, int lane, int tid) {
    LAS float* scr = (LAS float*)(lds + RING_OFF + wave * 16384);
    const int gw = vcu * NWAVES + wave, NGW = G * NWAVES;
    bf16* WIN = (bf16*)(P.ws + WS_WIN); bf16* WCO = (bf16*)(P.ws + WS_WCO); bf16* WAO = (bf16*)(P.ws + WS_WAO); bf16* WO = (bf16*)(P.ws + WS_WO); bf16* WQ = (bf16*)(P.ws + WS_WQ);
    constexpr int I_IN = (D / 64) * (INW / 32), I_CO = (CW / 64) * (D / 32), I_AO = (AW / 64) * (D / 32), I_O = (D / 64) * (D / 32), I_Q = I_O;
    constexpr int NITEMS = I_IN + I_CO + I_AO + I_O + I_Q;
    for (int it = gw; it < NITEMS; it += NGW) {
        int r = it;
        if (r < I_IN) { p0_transpose_item(P.w_in, D, INW, WIN, nullptr, scr, r, lane); continue; } r -= I_IN;
        if (r < I_CO) { p0_transpose_item(P.w_conv_out, CW, D, WCO, nullptr, scr, r, lane); continue; } r -= I_CO;
        if (r < I_AO) { p0_transpose_item(P.w_attn_out, AW, D, WAO, nullptr, scr, r, lane); continue; } r -= I_AO;
        if (r < I_O) { p0_transpose_item(P.w_out, D, D, WO, nullptr, scr, r, lane); continue; } r -= I_O;
        p0_transpose_item(P.peer_wq, D, D, WQ, P.norm_ffn, scr, r, lane);
    }
    bf16* XN = (bf16*)(P.ws + WS_XN);
    for (int m = gw; m < T; m += NGW) rms_row_to_bf16(P.x + (size_t)m * D, P.norm_mix, XN + (size_t)m * D, lane);
    {
        const int gt = (vcu * NWAVES + wave) * 64 + lane, NGT = G * NWAVES * 64;
        constexpr int NIT = NEXP * D / 8;
        v4u* UT = (v4u*)(P.ws + WS_UT);
        for (int it = gt; it < NIT; it += NGT) {
            const size_t e0 = (size_t)it * 8; const int col = (int)(e0 & (D - 1));
            const f32x4 u0 = *(const f32x4*)(P.peer_u + e0), u1 = *(const f32x4*)(P.peer_u + e0 + 4);
            const f32x4 g0 = *(const f32x4*)(P.norm_ffn + col), g1 = *(const f32x4*)(P.norm_ffn + col + 4);
            v4u a;
            a.x = pk2(u0.x * g0.x, u0.y * g0.y); a.y = pk2(u0.z * g0.z, u0.w * g0.w); a.z = pk2(u1.x * g1.x, u1.y * g1.y); a.w = pk2(u1.z * g1.z, u1.w * g1.w);
            UT[it] = a;
        }
        bf16* SK = (bf16*)(P.ws + WS_SK);
        for (int it = gt; it < 2 * PKEYS * PHALF; it += NGT) SK[it] = (bf16)f2bf(P.peer_sk[it]);
    }
    {
        LAS unsigned char* tile = lds + RING_OFF;
        unsigned char* VQ = P.ws + WS_VQ;
        __syncthreads();
        for (int b = vcu; b < NEXP / 32; b += G) {
            const int e0 = b * 32;
#pragma unroll
            for (int i = 0; i < 4; ++i) {
                const int er = wave * 4 + i; const float* vr = P.peer_v + (size_t)(e0 + er) * D + 4 * lane;
#pragma unroll
                for (int j = 0; j < 8; ++j) {
                    const f32x4 v = *(const f32x4*)(vr + 256 * j);
                    int w = 0; w = __builtin_amdgcn_cvt_pk_fp8_f32(v.x, v.y, w, false); w = __builtin_amdgcn_cvt_pk_fp8_f32(v.z, v.w, w, true);
                    const int c = (lane >> 1) + 32 * j;
                    *(LAS int*)(tile + (c * 33 + er) * 8 + 4 * (lane & 1)) = w;
                }
            }
            __syncthreads();
#pragma unroll 4
            for (int k = 0; k < 16; ++k) {
                const int c = wave * 32 + 2 * k + (lane >> 5), er = lane & 31;
                const u32x2 q = *(const LAS u32x2*)(tile + (c * 33 + er) * 8);
                *(u32x2*)(VQ + ((size_t)c * NEXP + e0 + er) * 8) = q;
            }
            __syncthreads();
        }
    }
}

__device__ __forceinline__ void p2_conv(const Ptrs& P, int gt, int NGT) {
    const bf16* PROJ = (const bf16*)(P.ws + WS_PROJ); bf16* YC = (bf16*)(P.ws + WS_YC);
    constexpr int NIT = (T / 8) * (CW / 8);
    for (int it = gt; it < NIT; it += NGT) {
        const int ch = it % (CW / 8), tb = it / (CW / 8), c0 = ch * 8, t0 = tb * 8;
        float w0[8], w1[8], w2[8];
#pragma unroll
        for (int i = 0; i < 8; ++i) { w0[i] = P.conv_w[c0 + i]; w1[i] = P.conv_w[CW + c0 + i]; w2[i] = P.conv_w[2 * CW + c0 + i]; }
        float zm2[8], zm1[8];
#pragma unroll
        for (int i = 0; i < 8; ++i) { zm2[i] = 0.f; zm1[i] = 0.f; }
#pragma unroll
        for (int dt = -2; dt < 8; ++dt) {
            const int t = t0 + dt; if (t < 0) continue;
            const v4u cc = *(const v4u*)(PROJ + (size_t)t * INW + C_CC + c0), hh = *(const v4u*)(PROJ + (size_t)t * INW + C_CH + c0);
            float z[8];
            z[0] = bflo(cc.x) * bflo(hh.x); z[1] = bfhi(cc.x) * bfhi(hh.x); z[2] = bflo(cc.y) * bflo(hh.y); z[3] = bfhi(cc.y) * bfhi(hh.y);
            z[4] = bflo(cc.z) * bflo(hh.z); z[5] = bfhi(cc.z) * bfhi(hh.z); z[6] = bflo(cc.w) * bflo(hh.w); z[7] = bfhi(cc.w) * bfhi(hh.w);
            if (dt >= 0) {
                const v4u cb = *(const v4u*)(PROJ + (size_t)t * INW + C_CB + c0);
                float b[8] = {bflo(cb.x), bfhi(cb.x), bflo(cb.y), bfhi(cb.y), bflo(cb.z), bfhi(cb.z), bflo(cb.w), bfhi(cb.w)};
                float y[8];
#pragma unroll
                for (int i = 0; i < 8; ++i) y[i] = b[i] * (w0[i] * zm2[i] + w1[i] * zm1[i] + w2[i] * z[i]);
                v4u o; o.x = pk2(y[0], y[1]); o.y = pk2(y[2], y[3]); o.z = pk2(y[4], y[5]); o.w = pk2(y[6], y[7]);
                *(v4u*)(YC + (size_t)t * CW + c0) = o;
            }
#pragma unroll
            for (int i = 0; i < 8; ++i) { zm2[i] = zm1[i]; zm1[i] = z[i]; }
        }
    }
}

__device__ __forceinline__ s16x4 vtr(LAS const unsigned char* p) { typedef short v4i16_t __attribute__((ext_vector_type(4))); return __builtin_bit_cast(s16x4, __builtin_amdgcn_ds_read_tr16_b64_v4i16((LAS v4i16_t*)p)); }

__device__ __forceinline__ void attn_task(const bf16* PROJ, bf16* YA, LAS unsigned char* vl  , int qt, int h, int lane) {
    const int r32 = lane & 31, hi = lane >> 5, q0 = qt * 32;
    const bf16* Qp = PROJ + (size_t)(q0 + r32) * INW + C_Q + h * HD + 8 * hi;
    bf16x8 qf[4];
#pragma unroll
    for (int s = 0; s < 4; ++s) qf[s] = *(const bf16x8*)(Qp + 16 * s);
    float carry = 1.f;
    f32x16 o0, o1;
#pragma unroll
    for (int r = 0; r < 16; ++r) { o0[r] = 0.f; o1[r] = 0.f; }
    const int g1 = (lane >> 4) & 1, qq = (lane & 15) >> 2, pp = lane & 3;
    LAS const unsigned char* vrd = vl + (4 * hi + qq) * 128 + g1 * 32 + pp * 8;
    for (int kt = qt; kt >= 0; --kt) {
        const int k0 = kt * 32;
        const bf16* Kp = PROJ + (size_t)(k0 + r32) * INW + C_K + h * HD + 8 * hi;
        bf16x8 kf[4];
#pragma unroll
        for (int s = 0; s < 4; ++s) kf[s] = *(const bf16x8*)(Kp + 16 * s);
        v4u vv[4];
#pragma unroll
        for (int i = 0; i < 4; ++i) { const int c = lane + 64 * i, row = c >> 3, chn = c & 7; vv[i] = *(const v4u*)(PROJ + (size_t)(k0 + row) * INW + C_V + h * HD + chn * 8); }
        f32x16 S;
#pragma unroll
        for (int r = 0; r < 16; ++r) S[r] = 0.f;
#pragma unroll
        for (int s = 0; s < 4; ++s) S = __builtin_amdgcn_mfma_f32_32x32x16_bf16(kf[s], qf[s], S, 0, 0, 0);
#pragma unroll
        for (int i = 0; i < 4; ++i) { const int c = lane + 64 * i, row = c >> 3, chn = c & 7; *(LAS v4u*)(vl + row * 128 + chn * 16) = vv[i]; }
        float kp[16], bt[16];
        const float cs = 0.125f * 1.4426950408889634f;
#pragma unroll
        for (int r = 0; r < 16; ++r) { const float a = fminf(S[r] * cs, 126.f); const float e = __builtin_amdgcn_exp2f(a); const float ri = __builtin_amdgcn_rcpf(1.f + e); kp[r] = ri; bt[r] = e * ri; }
        if (kt == qt) {
#pragma unroll
            for (int r = 0; r < 16; ++r) { if (crow(r, hi) >= r32) { kp[r] = 1.f; bt[r] = 0.f; } }
        }
        float Pm[4], Qm[4], Tt[4];
#pragma unroll
        for (int i = 0; i < 4; ++i) { Pm[i] = (kp[4 * i] * kp[4 * i + 1]) * (kp[4 * i + 2] * kp[4 * i + 3]); Qm[i] = partner32(Pm[i]); Tt[i] = Pm[i] * Qm[i]; }
        float R[4]; R[3] = 1.f; R[2] = Tt[3]; R[1] = Tt[3] * Tt[2]; R[0] = R[1] * Tt[1];
        const float total = R[0] * Tt[0];
        float w[16];
#pragma unroll
        for (int i = 0; i < 4; ++i) {
            const float base = carry * R[i] * (hi ? 1.f : Qm[i]);
            const float x3 = base, x2 = x3 * kp[4 * i + 3], x1 = x2 * kp[4 * i + 2], x0 = x1 * kp[4 * i + 1];
            w[4 * i + 3] = bt[4 * i + 3] * x3; w[4 * i + 2] = bt[4 * i + 2] * x2; w[4 * i + 1] = bt[4 * i + 1] * x1; w[4 * i] = bt[4 * i] * x0;
        }
        carry *= total;
        v4u wa0, wa1;
        wa0.x = cvtpk(w[0], w[1]); wa0.y = cvtpk(w[2], w[3]); wa0.z = cvtpk(w[4], w[5]); wa0.w = cvtpk(w[6], w[7]);
        wa1.x = cvtpk(w[8], w[9]); wa1.y = cvtpk(w[10], w[11]); wa1.z = cvtpk(w[12], w[13]); wa1.w = cvtpk(w[14], w[15]);
        asm volatile("s_waitcnt lgkmcnt(0)" ::: "memory");
        s16x4 l00 = vtr(vrd + 0 * 64 + 0 * 2048), h00 = vtr(vrd + 0 * 64 + 0 * 2048 + 1024);
        s16x4 l01 = vtr(vrd + 0 * 64 + 1 * 2048), h01 = vtr(vrd + 0 * 64 + 1 * 2048 + 1024);
        s16x4 l10 = vtr(vrd + 1 * 64 + 0 * 2048), h10 = vtr(vrd + 1 * 64 + 0 * 2048 + 1024);
        s16x4 l11 = vtr(vrd + 1 * 64 + 1 * 2048), h11 = vtr(vrd + 1 * 64 + 1 * 2048 + 1024);
        asm volatile("s_waitcnt lgkmcnt(0)" ::: "memory");
#define PKV(l, hh) (bf16x8){l[0], l[1], l[2], l[3], hh[0], hh[1], hh[2], hh[3]}
        o0 = __builtin_amdgcn_mfma_f32_32x32x16_bf16(__builtin_bit_cast(bf16x8, wa0), PKV(l00, h00), o0, 0, 0, 0);
        o0 = __builtin_amdgcn_mfma_f32_32x32x16_bf16(__builtin_bit_cast(bf16x8, wa1), PKV(l01, h01), o0, 0, 0, 0);
        o1 = __builtin_amdgcn_mfma_f32_32x32x16_bf16(__builtin_bit_cast(bf16x8, wa0), PKV(l10, h10), o1, 0, 0, 0);
        o1 = __builtin_amdgcn_mfma_f32_32x32x16_bf16(__builtin_bit_cast(bf16x8, wa1), PKV(l11, h11), o1, 0, 0, 0);
#undef PKV
        if (__all(carry < 1e-30f)) break;
    }
    bf16* Op = YA + (size_t)q0 * AW + h * HD + r32;
#pragma unroll
    for (int r = 0; r < 16; ++r) { const int qr = crow(r, hi); Op[(size_t)qr * AW] = (bf16)f2bf(o0[r]); Op[(size_t)qr * AW + 32] = (bf16)f2bf(o1[r]); }
}

template <int N> __device__ __forceinline__ float take_max(float (&v)[N]) {
    float m = v[0];
#pragma unroll
    for (int i = 1; i < N; ++i) m = fmaxf(m, v[i]);
    const float g = fmaxf(m, partner32(m));
#pragma unroll
    for (int i = 0; i < N; ++i) v[i] = (v[i] == g) ? -INFINITY : v[i];
    return g;
}
struct constexpr_ij { int i, j; };
__host__ __device__ constexpr constexpr_ij cand_ij(int k) {
    int n = 0;
    for (int i = 0; i < 16; ++i) for (int j = 0; j < 16; ++j) if ((i + 1) * (j + 1) <= 16) { if (n == k) return constexpr_ij{i, j}; ++n; }
    return constexpr_ij{0, 0};
}
__device__ __forceinline__ void topk_task(const bf16* QP, const bf16* SK, int* IDX, float* GATE, int tt, int h, int lane) {
    const int r32 = lane & 31, hi = lane >> 5, t = tt * 32 + r32;
    float top[2][16];
#pragma unroll
    for (int side = 0; side < 2; ++side) {
        const bf16* Qp = QP + (size_t)t * D + h * PQD + side * PHALF + 8 * hi;
        bf16x8 qf[8];
#pragma unroll
        for (int s = 0; s < 8; ++s) qf[s] = *(const bf16x8*)(Qp + 16 * s);
        float sc[64];
#pragma unroll
        for (int kb = 0; kb < 4; ++kb) {
            const bf16* Kp = SK + (size_t)(side * PKEYS + kb * 32 + r32) * PHALF + 8 * hi;
            asm volatile("" : "+v"(Kp));
            f32x16 S;
#pragma unroll
            for (int r = 0; r < 16; ++r) S[r] = 0.f;
#pragma unroll
            for (int s = 0; s < 8; ++s) { const bf16x8 kf = *(const bf16x8*)(Kp + 16 * s); S = __builtin_amdgcn_mfma_f32_32x32x16_bf16(kf, qf[s], S, 0, 0, 0); }
#pragma unroll
            for (int r = 0; r < 16; ++r) { const unsigned key = (unsigned)(kb * 32 + crow(r, hi)); sc[kb * 16 + r] = __uint_as_float((__float_as_uint(S[r]) & ~127u) | (127u - key)); }
            asm volatile("" ::: "memory");
        }
#pragma unroll
        for (int k = 0; k < 16; ++k) top[side][k] = take_max<64>(sc);
        asm volatile("" ::: "memory");
    }
    asm volatile("" ::: "memory");
    float cv[25]; int ci[25];
#pragma unroll
    for (int k = 0; k < 25; ++k) {
        constexpr_ij c0 = cand_ij(k), c1 = cand_ij(k + 25);
        const float a = hi ? top[0][c1.i] : top[0][c0.i], b = hi ? top[1][c1.j] : top[1][c0.j];
        const float s = a + b;
        cv[k] = __uint_as_float((__float_as_uint(s) & ~63u) | (unsigned)(hi ? 63 - (k + 25) : 63 - k));
        ci[k] = (int)(127u - (__float_as_uint(a) & 127u)) * PKEYS + (int)(127u - (__float_as_uint(b) & 127u));
    }
    float sv[16]; int si[16];
#pragma unroll
    for (int k = 0; k < 16; ++k) {
        float m = cv[0];
#pragma unroll
        for (int i = 1; i < 25; ++i) m = fmaxf(m, cv[i]);
        const float g = fmaxf(m, partner32(m));
        int id = 0;
#pragma unroll
        for (int i = 0; i < 25; ++i) { const bool hit = (cv[i] == g); id = hit ? ci[i] : id; cv[i] = hit ? -INFINITY : cv[i]; }
        const int pid = partner32i(id);
        sv[k] = g; si[k] = id > pid ? id : pid;
    }
    float ex[16], sum = 0.f;
#pragma unroll
    for (int k = 0; k < 16; ++k) { ex[k] = __expf(sv[k] - sv[0]); sum += ex[k]; }
    const float rs = 1.f / sum;
    if (!hi) {
        int* ip = IDX + (size_t)t * NPAIR + h * PTOPK;
#pragma unroll
        for (int k = 0; k < 16; k += 4) *(int4*)(ip + k) = make_int4(si[k], si[k + 1], si[k + 2], si[k + 3]);
    } else {
        float* gp = GATE + (size_t)t * NPAIR + h * PTOPK;
#pragma unroll
        for (int k = 0; k < 16; k += 4) *(f32x4*)(gp + k) = (f32x4){ex[k] * rs, ex[k + 1] * rs, ex[k + 2] * rs, ex[k + 3] * rs};
    }
}

__device__ __forceinline__ float dot8(const v4u& a, const v4u& b, float acc) {
    acc += bflo(a.x) * bflo(b.x); acc += bfhi(a.x) * bfhi(b.x); acc += bflo(a.y) * bflo(b.y); acc += bfhi(a.y) * bfhi(b.y);
    acc += bflo(a.z) * bflo(b.z); acc += bfhi(a.z) * bfhi(b.z); acc += bflo(a.w) * bflo(b.w); acc += bfhi(a.w) * bfhi(b.w);
    return acc;
}
__device__ __forceinline__ void peer_u_token(const bf16* X1B, const bf16* UT, const float* SSQ, const int* IDX, const float* GATE, unsigned* LIST, int t, int lane) {
    const v4u* xr = (const v4u*)(X1B + (size_t)t * D) + lane;
    v4u xv[4];
#pragma unroll
    for (int j = 0; j < 4; ++j) xv[j] = xr[64 * j];
    const float inv = 1.0f / sqrtf(SSQ[t] * (1.f / D) + RMS_EPS);
    const int id0 = IDX[(size_t)t * NPAIR + lane], id1 = IDX[(size_t)t * NPAIR + 64 + lane];
    const float g0 = GATE[(size_t)t * NPAIR + lane], g1 = GATE[(size_t)t * NPAIR + 64 + lane];
    float res0 = 0.f, res1 = 0.f;
#pragma unroll 1
    for (int pb = 0; pb < 128; pb += 4) {
        float a[4];
        v4u uv[4][4];
#pragma unroll
        for (int k = 0; k < 4; ++k) {
            const int p = pb + k;
            const int e = (p < 64) ? __builtin_amdgcn_readlane(id0, p & 63) : __builtin_amdgcn_readlane(id1, p & 63);
            const v4u* ur = (const v4u*)(UT + (size_t)e * D) + lane;
#pragma unroll
            for (int j = 0; j < 4; ++j) uv[k][j] = ur[64 * j];
        }
#pragma unroll
        for (int k = 0; k < 4; ++k) {
            float s = 0.f;
#pragma unroll
            for (int j = 0; j < 4; ++j) s = dot8(xv[j], uv[k][j], s);
            a[k] = wave_sum(s);
        }
#pragma unroll
        for (int k = 0; k < 4; ++k) { const int p = pb + k; if (p < 64) { if (lane == p) res0 = a[k]; } else { if (lane == p - 64) res1 = a[k]; } }
    }
    const float h0 = res0 * inv, h1 = res1 * inv;
    const float act0 = 0.5f * h0 * (1.f + erff(h0 * 0.70710678118654752f)) * g0, act1 = 0.5f * h1 * (1.f + erff(h1 * 0.70710678118654752f)) * g1;
    LIST[(size_t)lane * T + t] = ((unsigned)id0 << 16) | f2bf(act0);
    LIST[(size_t)(lane + 64) * T + t] = ((unsigned)id1 << 16) | f2bf(act1);
}

__device__ __forceinline__ void peer_v_role(const unsigned char* VQ, const unsigned* LIST, float* X  , float* SSQ2, LAS unsigned char* lds, int c, int wave, int lane, int tid) {
    __syncthreads();
    {
        const v4u* src = (const v4u*)(VQ + (size_t)c * NEXP * 8);
#pragma unroll 4
        for (int i = tid; i < NEXP * 8 / 16; i += NWAVES * 64) *(LAS v4u*)(lds + (size_t)i * 16) = src[i];
    }
    __syncthreads();
    for (int tg = wave; tg < T / 64; tg += NWAVES) {
        const int t = tg * 64 + lane;
        float acc[8];
#pragma unroll
        for (int i = 0; i < 8; ++i) acc[i] = 0.f;
        const unsigned* lp = LIST + t;
#pragma unroll 1
        for (int j0 = 0; j0 < NPAIR; j0 += 8) {
            unsigned w[8];
#pragma unroll
            for (int k = 0; k < 8; ++k) w[k] = lp[(size_t)(j0 + k) * T];
#pragma unroll
            for (int k = 0; k < 8; ++k) {
                const u32x2 q = *(const LAS u32x2*)(lds + (w[k] >> 16) * 8);
                const float a = __uint_as_float(w[k] << 16);
                const f32x2 v0 = __builtin_amdgcn_cvt_pk_f32_fp8((int)q.x, false), v1 = __builtin_amdgcn_cvt_pk_f32_fp8((int)q.x, true);
                const f32x2 v2 = __builtin_amdgcn_cvt_pk_f32_fp8((int)q.y, false), v3 = __builtin_amdgcn_cvt_pk_f32_fp8((int)q.y, true);
                acc[0] += a * v0.x; acc[1] += a * v0.y; acc[2] += a * v1.x; acc[3] += a * v1.y; acc[4] += a * v2.x; acc[5] += a * v2.y; acc[6] += a * v3.x; acc[7] += a * v3.y;
            }
        }
        float* xp = X + (size_t)t * D + 8 * c;
        const f32x4 x0 = *(const f32x4*)xp, x1 = *(const f32x4*)(xp + 4);
        const f32x4 y0 = (f32x4){acc[0] + x0.x, acc[1] + x0.y, acc[2] + x0.z, acc[3] + x0.w}, y1 = (f32x4){acc[4] + x1.x, acc[5] + x1.y, acc[6] + x1.z, acc[7] + x1.w};
        *(f32x4*)xp = y0; *(f32x4*)(xp + 4) = y1;
        const float ss = (y0.x * y0.x + y0.y * y0.y) + (y0.z * y0.z + y0.w * y0.w) + (y1.x * y1.x + y1.y * y1.y) + (y1.z * y1.z + y1.w * y1.w);
        atomicAdd(SSQ2 + t, ss);
    }
}
__device__ __forceinline__ void final_norm_row(float* X, const float* SSQ2, const float* gfin, int t, int lane) {
    const float inv = 1.0f / sqrtf(SSQ2[t] * (1.f / D) + RMS_EPS);
    f32x4* xr = (f32x4*)(X + (size_t)t * D) + lane; const f32x4* gr = (const f32x4*)gfin + lane;
    f32x4 v[8];
#pragma unroll
    for (int j = 0; j < 8; ++j) v[j] = xr[64 * j];
#pragma unroll
    for (int j = 0; j < 8; ++j) { const f32x4 g = gr[64 * j]; xr[64 * j] = (f32x4){v[j].x * inv * g.x, v[j].y * inv * g.y, v[j].z * inv * g.z, v[j].w * inv * g.w}; }
}

#ifndef PHASE_MASK
#define PHASE_MASK 0x1ff
#endif
#define PH_ON(k) ((PHASE_MASK >> (k)) & 1)
#ifndef REP_MASK
#define REP_MASK 0
#endif
#define PH_REP(k) (1 + ((REP_MASK >> (k)) & 1))
__global__ void __launch_bounds__(NWAVES * 64, 2) hyb_fwd(Ptrs P) {
    extern __shared__ __attribute__((aligned(16))) unsigned char lds_raw[];
    LAS unsigned char* lds = (LAS unsigned char*)lds_raw;
    volatile LAS unsigned* MISC = (volatile LAS unsigned*)(lds + MISC_OFF);
    const int tid = threadIdx.x, lane = tid & 63, wave = __builtin_amdgcn_readfirstlane(tid >> 6);
    const int G = gridDim.x; const int bx = blockIdx.x; const int vcu = (G % 8 == 0) ? (bx % 8) * (G / 8) + bx / 8 : bx;
    unsigned* ctl = (unsigned*)(P.ws + WS_CTL);
    for (int u = tid; u < (LDS_BYTES - LDSCTL_OFF) / 4; u += NWAVES * 64) ((LAS unsigned*)(lds + LDSCTL_OFF))[u] = 0u;
    __syncthreads();
    XcdBarrier bar = xcd_barrier_post(ctl + CW_BAR, MISC + 8);
    const int gw = vcu * NWAVES + wave, NGW = G * NWAVES;
    float* SSQ = (float*)(ctl + CW_SSQ);
    bf16* PROJ = (bf16*)(P.ws + WS_PROJ);

    for (int rep = 0; rep < PH_REP(0); ++rep) { if (PH_ON(0)) p0_prologue(P, lds, vcu, G, wave, lane, tid); if (rep + 1 < PH_REP(0)) xcd_barrier(bar); }
    xcd_barrier(bar);

    for (int rep = 0; rep < PH_REP(1); ++rep) if (PH_ON(1)) {
        pg8::Gemm g{(const pg8::bf16_t*)(P.ws + WS_XN), (const pg8::bf16_t*)(P.ws + WS_WIN), T, INW, D}; pg8::StaticOrder S; S.init(T, INW, G, bx);
        pg8::EpiStore E{(pg8::bf16_t*)PROJ, INW};
        pg8::gemm_phase<pg8::EpiStore, pg8::StaticOrder, true, true>(lds + RING_OFF, g, S, E);
    }
    xcd_barrier(bar);

    if (PH_ON(2)) {
        p2_conv(P, gw * 64 + lane, NGW * 64);
        bf16* YA = (bf16*)(P.ws + WS_YA);
        LAS unsigned char* vl = lds + RING_OFF + wave * 4096;
        constexpr int NTASK = (T / 32) * NH;
        for (int it = gw; it < NTASK; it += NGW) { const int task = NTASK - 1 - it; attn_task(PROJ, YA, vl, task / NH, task % NH, lane); }
    }
    xcd_barrier(bar);

    if (PH_ON(3)) {
        pg8::StaticOrder S; S.init(T, D, G, bx);
        pg8::bf16_t* MERGED = (pg8::bf16_t*)(P.ws + WS_XN);
        { pg8::Gemm g{(const pg8::bf16_t*)(P.ws + WS_YC), (const pg8::bf16_t*)(P.ws + WS_WCO), T, D, CW};
          pg8::EpiGate<0> E{(const pg8::bf16_t*)PROJ + C_GC, INW, MERGED, D};
          pg8::gemm_phase<pg8::EpiGate<0>, pg8::StaticOrder, true, true>(lds + RING_OFF, g, S, E); }
        { pg8::Gemm g{(const pg8::bf16_t*)(P.ws + WS_YA), (const pg8::bf16_t*)(P.ws + WS_WAO), T, D, AW};
          pg8::EpiGate<1> E{(const pg8::bf16_t*)PROJ + C_GA, INW, MERGED, D};
          pg8::gemm_phase<pg8::EpiGate<1>, pg8::StaticOrder, true, true>(lds + RING_OFF, g, S, E); }
    }
    xcd_barrier(bar);

    if (PH_ON(4)) {
        pg8::Gemm g{(const pg8::bf16_t*)(P.ws + WS_XN), (const pg8::bf16_t*)(P.ws + WS_WO), T, D, D}; pg8::StaticOrder S; S.init(T, D, G, bx);
        pg8::EpiX1 E{P.x, P.out, (pg8::bf16_t*)(P.ws + WS_X1B), SSQ, D};
        pg8::gemm_phase<pg8::EpiX1, pg8::StaticOrder, true, true>(lds + RING_OFF, g, S, E);
    }
    xcd_barrier(bar);

    if (PH_ON(5)) {
        pg8::Gemm g{(const pg8::bf16_t*)(P.ws + WS_X1B), (const pg8::bf16_t*)(P.ws + WS_WQ), T, D, D}; pg8::StaticOrder S; S.init(T, D, G, bx);
        pg8::EpiQP E{SSQ, (pg8::bf16_t*)(P.ws + WS_QP), D, 1.f / D, RMS_EPS};
        pg8::gemm_phase<pg8::EpiQP, pg8::StaticOrder, true, true>(lds + RING_OFF, g, S, E);
    }
    xcd_barrier(bar);

    if (PH_ON(6)) {
        constexpr int NTASK = (T / 32) * PH;
        for (int it = gw; it < NTASK; it += NGW) topk_task((const bf16*)(P.ws + WS_QP), (const bf16*)(P.ws + WS_SK), (int*)(P.ws + WS_IDX), (float*)(P.ws + WS_GATE), it / PH, it % PH, lane);
    }
    xcd_barrier(bar);

    for (int rep = 0; rep < PH_REP(7); ++rep) if (PH_ON(7)) for (int t = gw; t < T; t += NGW) peer_u_token((const bf16*)(P.ws + WS_X1B), (const bf16*)(P.ws + WS_UT), SSQ, (const int*)(P.ws + WS_IDX), (const float*)(P.ws + WS_GATE), (unsigned*)(P.ws + WS_LIST), t, lane);
    xcd_barrier(bar);

    float* SSQ2 = (float*)(ctl + CW_SSQ2);
    if (PH_ON(8)) for (int c = vcu; c < D / 8; c += G) peer_v_role(P.ws + WS_VQ, (const unsigned*)(P.ws + WS_LIST), P.out, SSQ2, lds, c, wave, lane, tid);
    xcd_barrier(bar);

    for (int t = gw; t < T; t += NGW) final_norm_row(P.out, SSQ2, P.norm_final, t, lane);
}

extern "C" void kernel_launch(void* const* d_in, const int* in_sizes, int n_in, void* d_out, int out_size, void* d_ws, size_t ws_size, hipStream_t stream) {
    static int grid = 0;
    if (grid == 0) {
        if (n_in != 13 || out_size != T * D || ws_size < WS_END) { fprintf(stderr, "kernel_launch: unexpected shapes (n_in %d out %d ws %zu)\n", n_in, out_size, ws_size); grid = -1; return; }
        int dev = 0, cus = 0, per_cu = 0;
        if (hipGetDevice(&dev) != hipSuccess || hipDeviceGetAttribute(&cus, hipDeviceAttributeMultiprocessorCount, dev) != hipSuccess) { grid = -1; return; }
        if (hipFuncSetAttribute((const void*)hyb_fwd, hipFuncAttributeMaxDynamicSharedMemorySize, LDS_BYTES) != hipSuccess) { fprintf(stderr, "kernel_launch: hipFuncSetAttribute failed\n"); grid = -1; return; }
        if (hipOccupancyMaxActiveBlocksPerMultiprocessor(&per_cu, (const void*)hyb_fwd, NWAVES * 64, LDS_BYTES) != hipSuccess || per_cu < 1) { fprintf(stderr, "kernel_launch: occupancy query says %d\n", per_cu); per_cu = 1; }
        (void)hipGetLastError();
        grid = cus;
    }
    if (grid < 0) return;
    (void)hipMemsetAsync((char*)d_ws + WS_CTL, 0, CTL_ZERO_BYTES, stream);
    Ptrs p{};
    p.x = (const float*)d_in[0]; p.norm_mix = (const float*)d_in[1]; p.w_in = (const float*)d_in[2]; p.conv_w = (const float*)d_in[3];
    p.w_conv_out = (const float*)d_in[4]; p.w_attn_out = (const float*)d_in[5]; p.w_out = (const float*)d_in[6]; p.norm_ffn = (const float*)d_in[7];
    p.peer_wq = (const float*)d_in[8]; p.peer_sk = (const float*)d_in[9]; p.peer_u = (const float*)d_in[10]; p.peer_v = (const float*)d_in[11]; p.norm_final = (const float*)d_in[12];
    p.out = (float*)d_out; p.ws = (unsigned char*)d_ws;
    void* args[] = {&p};
    hipError_t e = hipLaunchCooperativeKernel((const void*)hyb_fwd, dim3(grid), dim3(NWAVES * 64), args, LDS_BYTES, stream);
    if (e != hipSuccess) fprintf(stderr, "kernel_launch: cooperative launch failed: %s (grid %d)\n", hipGetErrorString(e), grid);
}
```

```cpp
#include <hip/hip_runtime.h>
#include <cstdio>
#include <cstdint>
namespace pg8 {
#define PG8_LAS __attribute__((address_space(3)))
typedef unsigned short bf16_t;
typedef short bf16x8 __attribute__((ext_vector_type(8)));
typedef float f32x4 __attribute__((ext_vector_type(4)));
typedef unsigned u32x4 __attribute__((ext_vector_type(4)));
constexpr int BM = 256, BK = 64, HALF = 128, HTB = HALF * BK * 2  , STAGE_BYTES = 8 * HTB, NXCD = 8, WGM = 8;

__host__ __device__ __forceinline__ int lds_byte(int r, int c) { const int st = (r >> 4) * 2 + (c >> 5), rr = r & 15, cc = c & 31, ob = rr * 64 + cc * 2; return st * 1024 + (ob ^ (((ob >> 9) & 1) << 5)); }
__host__ __device__ __forceinline__ void stage_rc(int b, int& R, int& C) { const int st = b / 1024, sb = b % 1024, swz = sb ^ (((sb >> 9) & 1) << 5); R = (st >> 1) * 16 + swz / 64; C = (st & 1) * 32 + (swz % 64) / 2; }
__host__ __device__ __forceinline__ int perm32(int rho) { const int n = rho >> 4, i = rho & 15; return 8 * (i >> 2) + 4 * n + (i & 3); }

struct Unit { int pm, pn; };
struct Gemm { const bf16_t* A; const bf16_t* Bt; int M, N, K; };

struct StaticOrder {
    int nM, nN, nwg, G, c;
    __host__ __device__ void init(int M, int N, int G_, int c_) { nM = M / BM; nN = N / BM; nwg = nM * nN; G = G_; c = c_; }
    __host__ __device__ bool next(int i, Unit& u) const {
        const long L = (long)i * G + c; if (L >= nwg) return false;
        int wgid = (int)L; { const int q = nwg / NXCD, r = nwg % NXCD, xcd = wgid % NXCD, off = wgid / NXCD; wgid = (xcd < r ? xcd * (q + 1) : r * (q + 1) + (xcd - r) * q) + off; }
        const int nig = WGM * nN, gid = wgid / nig, fm = gid * WGM, gsz = (nM - fm) < WGM ? (nM - fm) : WGM;
        u.pm = fm + ((wgid % nig) % gsz); u.pn = (wgid % nig) / gsz; return true;
    }
    __device__ __forceinline__ void a_ready(const Unit&) const {}
    __device__ __forceinline__ void done(const Unit&) const {}
};


typedef int i32x4 __attribute__((ext_vector_type(4)));
__device__ __forceinline__ unsigned cvt_pk_bf16(float lo, float hi) { unsigned r; asm volatile("v_cvt_pk_bf16_f32 %0, %1, %2" : "=v"(r) : "v"(lo), "v"(hi)); return r; }
__device__ __forceinline__ float bf_lo(unsigned w) { return __uint_as_float(w << 16); }
__device__ __forceinline__ float bf_hi(unsigned w) { return __uint_as_float(w & 0xffff0000u); }
__device__ __forceinline__ float sigmoidf_fast(float x) { return __builtin_amdgcn_rcpf(1.0f + __builtin_amdgcn_exp2f(-1.4426950408889634f * x)); }

struct EpiStore {
    static constexpr bool PERM = true, AFTER_DRAIN = false;
    bf16_t* O; int ldc;
    __device__ __forceinline__ void operator()(const f32x4 (&acc)[2][2][4][2], const Unit& u, int wr, int wc, int fr, int fq) const {
        const int row0 = u.pm * BM + wr * 64 + fr, col0 = u.pn * BM + wc * 32 + 8 * fq;
#pragma unroll
        for (int ai = 0; ai < 2; ++ai)
#pragma unroll
            for (int m = 0; m < 4; ++m) { bf16_t* rowp = O + (size_t)(row0 + ai * HALF + m * 16) * ldc + col0;
#pragma unroll
                for (int bj = 0; bj < 2; ++bj) { const f32x4 v0 = acc[ai][bj][m][0], v1 = acc[ai][bj][m][1];
                    u32x4 w; w.x = cvt_pk_bf16(v0[0], v0[1]); w.y = cvt_pk_bf16(v0[2], v0[3]); w.z = cvt_pk_bf16(v1[0], v1[1]); w.w = cvt_pk_bf16(v1[2], v1[3]);
                    *(u32x4*)(rowp + bj * HALF) = w; } }
    }
};
struct EpiStoreI8 {
    static constexpr bool PERM = true, AFTER_DRAIN = false;
    bf16_t* O; int ldc; const float* SA; const float* SB;
    __device__ __forceinline__ void operator()(const f32x4 (&acc)[2][2][4][2], const Unit& u, int wr, int wc, int fr, int fq) const {
        const int row0 = u.pm * BM + wr * 64 + fr, col0 = u.pn * BM + wc * 32 + 8 * fq;
        f32x4 sb[2][2];
#pragma unroll
        for (int bj = 0; bj < 2; ++bj) { sb[bj][0] = *(const f32x4*)(SB + col0 + bj * HALF) * (1.f / 127.f); sb[bj][1] = *(const f32x4*)(SB + col0 + bj * HALF + 4) * (1.f / 127.f); }
#pragma unroll
        for (int ai = 0; ai < 2; ++ai)
#pragma unroll
            for (int m = 0; m < 4; ++m) { const int row = row0 + ai * HALF + m * 16; const float sa = SA[row]; bf16_t* rowp = O + (size_t)row * ldc + col0;
#pragma unroll
                for (int bj = 0; bj < 2; ++bj) { const i32x4 i0 = __builtin_bit_cast(i32x4, acc[ai][bj][m][0]), i1 = __builtin_bit_cast(i32x4, acc[ai][bj][m][1]);
                    const f32x4 v0 = (f32x4){(float)i0.x, (float)i0.y, (float)i0.z, (float)i0.w} * sb[bj][0] * sa, v1 = (f32x4){(float)i1.x, (float)i1.y, (float)i1.z, (float)i1.w} * sb[bj][1] * sa;
                    u32x4 w; w.x = cvt_pk_bf16(v0[0], v0[1]); w.y = cvt_pk_bf16(v0[2], v0[3]); w.z = cvt_pk_bf16(v1[0], v1[1]); w.w = cvt_pk_bf16(v1[2], v1[3]);
                    *(u32x4*)(rowp + bj * HALF) = w; } }
    }
};
template <int PASS> struct EpiGate {
    static constexpr bool PERM = true, AFTER_DRAIN = false;
    const bf16_t* G; int ldg; bf16_t* O; int ldc;
    __device__ __forceinline__ void operator()(const f32x4 (&acc)[2][2][4][2], const Unit& u, int wr, int wc, int fr, int fq) const {
        const int row0 = u.pm * BM + wr * 64 + fr, col0 = u.pn * BM + wc * 32 + 8 * fq;
#pragma unroll
        for (int ai = 0; ai < 2; ++ai)
#pragma unroll
            for (int m = 0; m < 4; ++m) { const size_t row = (size_t)(row0 + ai * HALF + m * 16);
#pragma unroll
                for (int bj = 0; bj < 2; ++bj) { const f32x4 v0 = acc[ai][bj][m][0], v1 = acc[ai][bj][m][1];
                    const u32x4 g = *(const u32x4*)(G + row * ldg + col0 + bj * HALF);
                    float r[8];
                    r[0] = v0[0] * sigmoidf_fast(bf_lo(g.x)); r[1] = v0[1] * sigmoidf_fast(bf_hi(g.x)); r[2] = v0[2] * sigmoidf_fast(bf_lo(g.y)); r[3] = v0[3] * sigmoidf_fast(bf_hi(g.y));
                    r[4] = v1[0] * sigmoidf_fast(bf_lo(g.z)); r[5] = v1[1] * sigmoidf_fast(bf_hi(g.z)); r[6] = v1[2] * sigmoidf_fast(bf_lo(g.w)); r[7] = v1[3] * sigmoidf_fast(bf_hi(g.w));
                    bf16_t* op = O + row * ldc + col0 + bj * HALF;
                    if (PASS == 1) { const u32x4 p = *(const u32x4*)op;
                        r[0] += bf_lo(p.x); r[1] += bf_hi(p.x); r[2] += bf_lo(p.y); r[3] += bf_hi(p.y); r[4] += bf_lo(p.z); r[5] += bf_hi(p.z); r[6] += bf_lo(p.w); r[7] += bf_hi(p.w); }
                    u32x4 w; w.x = cvt_pk_bf16(r[0], r[1]); w.y = cvt_pk_bf16(r[2], r[3]); w.z = cvt_pk_bf16(r[4], r[5]); w.w = cvt_pk_bf16(r[6], r[7]);
                    *(u32x4*)op = w; }
                asm volatile("" ::: "memory"); }
    }
};
struct EpiX1 {
    static constexpr bool PERM = true, AFTER_DRAIN = false;
    const float* X; float* X1; bf16_t* X1B; float* SSQ; int ldc;
    __device__ __forceinline__ void operator()(const f32x4 (&acc)[2][2][4][2], const Unit& u, int wr, int wc, int fr, int fq) const {
        const int row0 = u.pm * BM + wr * 64 + fr, col0 = u.pn * BM + wc * 32 + 8 * fq;
#pragma unroll
        for (int ai = 0; ai < 2; ++ai)
#pragma unroll
            for (int m = 0; m < 4; ++m) { const size_t row = (size_t)(row0 + ai * HALF + m * 16); float ss = 0.f;
#pragma unroll
                for (int bj = 0; bj < 2; ++bj) { const size_t off = row * ldc + col0 + bj * HALF;
                    const f32x4 x0 = *(const f32x4*)(X + off), x1 = *(const f32x4*)(X + off + 4);
                    const f32x4 v0 = acc[ai][bj][m][0] + x0, v1 = acc[ai][bj][m][1] + x1;
                    *(f32x4*)(X1 + off) = v0; *(f32x4*)(X1 + off + 4) = v1;
                    u32x4 w; w.x = cvt_pk_bf16(v0[0], v0[1]); w.y = cvt_pk_bf16(v0[2], v0[3]); w.z = cvt_pk_bf16(v1[0], v1[1]); w.w = cvt_pk_bf16(v1[2], v1[3]);
                    *(u32x4*)(X1B + off) = w;
                    ss += (v0[0] * v0[0] + v0[1] * v0[1]) + (v0[2] * v0[2] + v0[3] * v0[3]) + (v1[0] * v1[0] + v1[1] * v1[1]) + (v1[2] * v1[2] + v1[3] * v1[3]); }
                ss += __shfl_xor(ss, 16); ss += __shfl_xor(ss, 32);
                if (fq == 0) atomicAdd(SSQ + row, ss);
                asm volatile("" ::: "memory"); }
    }
};
struct EpiQP {
    static constexpr bool PERM = true, AFTER_DRAIN = false;
    const float* SSQ; bf16_t* O; int ldc; float inv_n, eps;
    __device__ __forceinline__ void operator()(const f32x4 (&acc)[2][2][4][2], const Unit& u, int wr, int wc, int fr, int fq) const {
        const int row0 = u.pm * BM + wr * 64 + fr, col0 = u.pn * BM + wc * 32 + 8 * fq;
#pragma unroll
        for (int ai = 0; ai < 2; ++ai)
#pragma unroll
            for (int m = 0; m < 4; ++m) { const size_t row = (size_t)(row0 + ai * HALF + m * 16); const float inv = 1.0f / sqrtf(SSQ[row] * inv_n + eps);
                bf16_t* rowp = O + row * ldc + col0;
#pragma unroll
                for (int bj = 0; bj < 2; ++bj) { const f32x4 v0 = acc[ai][bj][m][0] * inv, v1 = acc[ai][bj][m][1] * inv;
                    u32x4 w; w.x = cvt_pk_bf16(v0[0], v0[1]); w.y = cvt_pk_bf16(v0[2], v0[3]); w.z = cvt_pk_bf16(v1[0], v1[1]); w.w = cvt_pk_bf16(v1[2], v1[3]);
                    *(u32x4*)(rowp + bj * HALF) = w; } }
    }
};


template <bool I8> __device__ __forceinline__ f32x4 mma16(bf16x8 a, bf16x8 b, f32x4 c) {
    if constexpr (I8) return __builtin_bit_cast(f32x4, __builtin_amdgcn_mfma_i32_16x16x64_i8(__builtin_bit_cast(i32x4, a), __builtin_bit_cast(i32x4, b), __builtin_bit_cast(i32x4, c), 0, 0, 0));
    else return __builtin_amdgcn_mfma_f32_16x16x32_bf16(a, b, c, 0, 0, 0);
}
template <class Epi, class Sched, bool ALIGN_EPI = false, bool SP2 = false, bool I8 = false>
__device__ __forceinline__ void gemm_phase(PG8_LAS unsigned char* lds, const Gemm g, const Sched& S, const Epi& E) {
    const int tid = threadIdx.x, wid = __builtin_amdgcn_readfirstlane(tid >> 6), lane = tid & 63, wr = wid >> 2, wc = wid & 3, fr = lane & 15, fq = lane >> 4;
    const int K = I8 ? g.K / 2 : g.K, nt = K / BK;
    unsigned voffA[2], voffB[2];
#pragma unroll
    for (int i = 0; i < 2; ++i) { int R, C; stage_rc(tid * 16 + i * 8192, R, C); const int Rb = Epi::PERM ? ((R & ~31) + perm32(R & 31)) : R;
        voffA[i] = (unsigned)(R * K + C) * 2u; voffB[i] = (unsigned)(Rb * K + C) * 2u; }
    const size_t kstep = (size_t)(BK * 2);
    const size_t hstep = (size_t)HALF * K * 2;
    const size_t tstep = 2 * hstep;
    const unsigned ldsw = (unsigned)wid * 1024u;
    const int aoff = lds_byte(wr * 64 + fr, fq * 8), boff = lds_byte(wc * 32 + fr, fq * 8);
#define PG8_SA(b, h) (((b) * 2 + (h)) * HTB)
#define PG8_SB(b, h) ((4 + (b) * 2 + (h)) * HTB)
#define PG8_STAGE(bufoff, gbase, voff) do { _Pragma("unroll") for (int _i = 0; _i < 2; ++_i) \
        __builtin_amdgcn_global_load_lds((const unsigned*)((const char*)(gbase) + (voff)[_i]), (PG8_LAS unsigned*)(lds + (bufoff) + ldsw + _i * 8192), 16, 0, 0); } while (0)
#define PG8_LDA(dst, b, h) do { _Pragma("unroll") for (int m = 0; m < 4; ++m) _Pragma("unroll") for (int k = 0; k < 2; ++k) dst[m][k] = *(const PG8_LAS bf16x8*)(lds + PG8_SA(b, h) + aoff + m * 2048 + k * 1024); } while (0)
#define PG8_LDB(dst, b, h) do { _Pragma("unroll") for (int n = 0; n < 2; ++n) _Pragma("unroll") for (int k = 0; k < 2; ++k) dst[n][k] = *(const PG8_LAS bf16x8*)(lds + PG8_SB(b, h) + boff + n * 2048 + k * 1024); } while (0)
#define PG8_MMA(ai, bj, At, Bt) do { __builtin_amdgcn_s_setprio(1); _Pragma("unroll") for (int m = 0; m < 4; ++m) _Pragma("unroll") for (int n = 0; n < 2; ++n) _Pragma("unroll") for (int k = 0; k < 2; ++k) \
        acc[ai][bj][m][n] = mma16<I8>(Bt[n][k], At[m][k], acc[ai][bj][m][n]); __builtin_amdgcn_s_setprio(0); } while (0)
#define PG8_WAIT_V(n) asm volatile("s_waitcnt vmcnt(" #n ")" ::: "memory")
#define PG8_WAIT_L(n) asm volatile("s_waitcnt lgkmcnt(" #n ")" ::: "memory")
#define PG8_BAR __builtin_amdgcn_s_barrier()
#define PG8_SCHED __builtin_amdgcn_sched_barrier(0)
    Unit cur, nxt; int ui = 0;
    if (!S.next(0, cur)) return;
    f32x4 acc[2][2][4][2];
#pragma unroll
    for (int a = 0; a < 2; ++a)
#pragma unroll
        for (int b = 0; b < 2; ++b)
#pragma unroll
            for (int m = 0; m < 4; ++m)
#pragma unroll
                for (int n = 0; n < 2; ++n) acc[a][b][m][n] = (f32x4){0.f, 0.f, 0.f, 0.f};
    bf16x8 At[4][2], B0[2][2], B1[2][2];
    const char* cA = (const char*)g.A + (size_t)cur.pm * tstep; const char* cB = (const char*)g.Bt + (size_t)cur.pn * tstep;
    S.a_ready(cur);
    if constexpr (SP2) {
        PG8_STAGE(PG8_SB(0, 0), cB, voffB); PG8_STAGE(PG8_SB(0, 1), cB + hstep, voffB); PG8_STAGE(PG8_SA(0, 0), cA, voffA); PG8_STAGE(PG8_SA(0, 1), cA + hstep, voffA);
        if (wr == 1) PG8_BAR;
        PG8_WAIT_V(2); PG8_BAR;
        PG8_STAGE(PG8_SB(1, 0), cB + kstep, voffB); PG8_STAGE(PG8_SA(1, 0), cA + kstep, voffA); PG8_STAGE(PG8_SB(1, 1), cB + hstep + kstep, voffB);
        PG8_WAIT_V(6); PG8_BAR;
    } else {
        PG8_STAGE(PG8_SB(0, 0), cB, voffB); PG8_STAGE(PG8_SA(0, 0), cA, voffA); PG8_STAGE(PG8_SB(0, 1), cB + hstep, voffB); PG8_STAGE(PG8_SA(0, 1), cA + hstep, voffA);
        if (wr == 1) PG8_BAR;
        PG8_WAIT_V(4); PG8_BAR;
        PG8_STAGE(PG8_SB(1, 0), cB + kstep, voffB); PG8_STAGE(PG8_SA(1, 0), cA + kstep, voffA); PG8_STAGE(PG8_SB(1, 1), cB + hstep + kstep, voffB);
        PG8_WAIT_V(6); PG8_BAR;
    }
    for (;;) {
        const bool has_next = S.next(ui + 1, nxt);
        const char* nA = has_next ? (const char*)g.A + (size_t)nxt.pm * tstep : cA; const char* nB = has_next ? (const char*)g.Bt + (size_t)nxt.pn * tstep : cB;
        for (int t = 0; t < nt; t += 2) {
            const bool last = (t == nt - 2);
            const char* a1 = cA + (size_t)(t + 1) * kstep;
            const char* a2 = last ? nA : cA + (size_t)(t + 2) * kstep; const char* b2 = last ? nB : cB + (size_t)(t + 2) * kstep;
            const char* a3 = a2 + kstep; const char* b3 = b2 + kstep;
            if (last && has_next) S.a_ready(nxt);
            if constexpr (SP2) {
            PG8_LDB(B0, 0, 0); PG8_LDB(B1, 0, 1); PG8_SCHED; PG8_LDA(At, 0, 0); PG8_STAGE(PG8_SA(1, 1), a1 + hstep, voffA);
            PG8_WAIT_V(8); PG8_WAIT_L(0); PG8_BAR; PG8_MMA(0, 0, At, B0); PG8_MMA(0, 1, At, B1); PG8_BAR; PG8_SCHED;
            PG8_LDA(At, 0, 1); PG8_STAGE(PG8_SB(0, 0), b2, voffB); PG8_STAGE(PG8_SB(0, 1), b2 + hstep, voffB); PG8_STAGE(PG8_SA(0, 0), a2, voffA);
            PG8_WAIT_V(8); PG8_WAIT_L(0); PG8_BAR; PG8_MMA(1, 0, At, B0); PG8_MMA(1, 1, At, B1); PG8_BAR; PG8_SCHED;
            PG8_LDB(B0, 1, 0); PG8_LDB(B1, 1, 1); PG8_SCHED; PG8_LDA(At, 1, 0); PG8_STAGE(PG8_SA(0, 1), a2 + hstep, voffA);
            PG8_WAIT_V(8); PG8_WAIT_L(0); PG8_BAR; PG8_MMA(0, 0, At, B0); PG8_MMA(0, 1, At, B1); PG8_BAR; PG8_SCHED;
            PG8_LDA(At, 1, 1); PG8_STAGE(PG8_SB(1, 0), b3, voffB); PG8_STAGE(PG8_SB(1, 1), b3 + hstep, voffB); PG8_STAGE(PG8_SA(1, 0), a3, voffA);
            PG8_WAIT_V(8); PG8_WAIT_L(0); PG8_BAR; PG8_MMA(1, 0, At, B0); PG8_MMA(1, 1, At, B1); PG8_BAR; PG8_SCHED;
            } else {
            PG8_LDB(B0, 0, 0); PG8_SCHED; PG8_LDA(At, 0, 0); PG8_STAGE(PG8_SA(1, 1), a1 + hstep, voffA);
            PG8_WAIT_L(8); PG8_BAR; PG8_WAIT_L(0); PG8_MMA(0, 0, At, B0); PG8_BAR; PG8_SCHED;
            PG8_LDB(B1, 0, 1); PG8_STAGE(PG8_SB(0, 0), b2, voffB);
            PG8_BAR; PG8_WAIT_L(0); PG8_MMA(0, 1, At, B1); PG8_BAR;
            PG8_LDA(At, 0, 1); PG8_STAGE(PG8_SA(0, 0), a2, voffA);
            PG8_BAR; PG8_WAIT_L(0); PG8_MMA(1, 0, At, B0); PG8_BAR; PG8_SCHED;
            PG8_STAGE(PG8_SB(0, 1), b2 + hstep, voffB);
            PG8_WAIT_V(6); PG8_BAR; PG8_MMA(1, 1, At, B1); PG8_BAR;
            PG8_LDB(B0, 1, 0); PG8_SCHED; PG8_LDA(At, 1, 0); PG8_STAGE(PG8_SA(0, 1), a2 + hstep, voffA);
            PG8_WAIT_L(8); PG8_BAR; PG8_WAIT_L(0); PG8_MMA(0, 0, At, B0); PG8_BAR; PG8_SCHED;
            PG8_LDB(B1, 1, 1); PG8_STAGE(PG8_SB(1, 0), b3, voffB);
            PG8_BAR; PG8_WAIT_L(0); PG8_MMA(0, 1, At, B1); PG8_BAR;
            PG8_LDA(At, 1, 1); PG8_STAGE(PG8_SA(1, 0), a3, voffA);
            PG8_BAR; PG8_WAIT_L(0); PG8_MMA(1, 0, At, B0); PG8_BAR; PG8_SCHED;
            PG8_STAGE(PG8_SB(1, 1), b3 + hstep, voffB);
            PG8_WAIT_V(6); PG8_BAR; PG8_MMA(1, 1, At, B1); PG8_BAR;
            }
        }
        if constexpr (ALIGN_EPI) { if (wr == 0) PG8_BAR; }
        if constexpr (!Epi::AFTER_DRAIN) { E(acc, cur, wr, wc, fr, fq); S.done(cur); }
        if (!has_next) break;
#pragma unroll
        for (int a = 0; a < 2; ++a)
#pragma unroll
            for (int b = 0; b < 2; ++b)
#pragma unroll
                for (int m = 0; m < 4; ++m)
#pragma unroll
                    for (int n = 0; n < 2; ++n) acc[a][b][m][n] = (f32x4){0.f, 0.f, 0.f, 0.f};
        cur = nxt; cA = nA; cB = nB; ++ui;
        if constexpr (ALIGN_EPI) { if (wr == 1) PG8_BAR; }
    }
    PG8_WAIT_V(0);
    if constexpr (!ALIGN_EPI) { if (wr == 0) PG8_BAR; }
    PG8_BAR;
    if constexpr (Epi::AFTER_DRAIN) { E.fused(acc, cur, wr, wc, fr, fq, lds, wid, lane); S.done(cur); }
#undef PG8_SA
#undef PG8_SB
#undef PG8_STAGE
#undef PG8_LDA
#undef PG8_LDB
#undef PG8_MMA
#undef PG8_WAIT_V
#undef PG8_WAIT_L
#undef PG8_BAR
#undef PG8_SCHED
}
}


constexpr int NWAVES = 8;
constexpr int T = 8192, D = 2048, CW = 1024, AW = 1024, NH = 16, HD = 64, INW = 10240;
constexpr int C_CB = 0, C_CC = 1024, C_CH = 2048, C_Q = 3072, C_K = 4096, C_V = 5120, C_GC = 6144, C_GA = 8192;
constexpr int NS = 16, DW = 128, NG = 16, EG = 1024;
__host__ __device__ constexpr int egroup(int e) { return ((e >> 7) ^ e) & 15; }
__host__ __device__ constexpr int erow(int e) { return ((e >> 7) << 3) | ((e >> 4) & 7); }
constexpr int PH = 8, PKEYS = 128, PHALF = 128, PQD = 256, PTOPK = 16, NEXP = 16384, NPAIR = PH * PTOPK;
constexpr float RMS_EPS = 1e-6f;

constexpr size_t MiB = 1u << 20;
constexpr size_t WS_CTL = 0, CTL_ZERO_BYTES = 1 * MiB;
constexpr size_t WS_WIN = 1 * MiB;
constexpr size_t WS_SA = 22 * MiB;
constexpr size_t WS_WCO = 41 * MiB;
constexpr size_t WS_WAO = 45 * MiB;
constexpr size_t WS_WO = 49 * MiB;
constexpr size_t WS_WQ = 57 * MiB;
constexpr size_t WS_SK = 65 * MiB;
constexpr size_t WS_XN = 66 * MiB;
constexpr size_t WS_YC = 98 * MiB;
constexpr size_t WS_YA = 114 * MiB;
constexpr size_t WS_UQ = 130 * MiB;
constexpr size_t WS_SU = 162 * MiB;
constexpr size_t WS_VQ = 194 * MiB;
constexpr size_t WS_PROJ = 258 * MiB;
constexpr size_t WS_X1B = WS_PROJ;
constexpr size_t WS_QP = WS_PROJ + 32 * MiB;
constexpr size_t WS_IDX = WS_PROJ + 64 * MiB;
constexpr size_t WS_GATE = WS_PROJ + 68 * MiB;
constexpr size_t WS_ACT = WS_PROJ + 72 * MiB;
constexpr size_t WS_LIST = WS_PROJ + 76 * MiB;
constexpr size_t WS_ES = WS_PROJ + 80 * MiB;
constexpr size_t WS_GS = WS_PROJ + 82 * MiB;
constexpr size_t WS_OFFN = WS_PROJ + 86 * MiB;
constexpr size_t WS_SXS = WS_PROJ + 87 * MiB;
constexpr size_t WS_XQ = WS_PROJ + 88 * MiB;
constexpr size_t WS_PART = WS_PROJ + 104 * MiB;
constexpr size_t WS_ESG = WS_PROJ + 168 * MiB;
constexpr size_t WS_END = 432 * MiB;
constexpr int CW_BAR = 4096;
constexpr int CW_SSQ = 65536;
constexpr int CW_COLMAX = CW_SSQ + 16384;
constexpr int CW_SSQ2 = CW_SSQ + 8192;
static_assert((CW_COLMAX + INW) * 4 <= (int)CTL_ZERO_BYTES, "ctl");

constexpr int RING_OFF = 0, RING_BYTES = 131072;
constexpr int LDSCTL_OFF = RING_BYTES, MISC_OFF = LDSCTL_OFF + 320;
constexpr int LDS_BYTES = 163840;
constexpr int LDS_SU_OFF = 132096;

#define GAS __attribute__((address_space(1)))
#define LAS __attribute__((address_space(3)))
typedef unsigned short bf16;
typedef unsigned v4u __attribute__((ext_vector_type(4)));
typedef float f32x4 __attribute__((ext_vector_type(4)));
typedef short bf16x8 __attribute__((ext_vector_type(8)));
typedef GAS unsigned gu32;
typedef GAS unsigned long long gu64;
#define RLX_AGENT __ATOMIC_RELAXED, __HIP_MEMORY_SCOPE_AGENT
#define LDS_WAIT() asm volatile("s_waitcnt lgkmcnt(0)" ::: "memory")
#define VM_WAIT() asm volatile("s_waitcnt vmcnt(0)" ::: "memory")
__device__ __forceinline__ unsigned long long rt() { return __builtin_amdgcn_s_memrealtime(); }
__device__ __forceinline__ unsigned f2bf(float f) { unsigned u = __builtin_bit_cast(unsigned, f); return (u + 0x7fffu + ((u >> 16) & 1u)) >> 16; }
__device__ __forceinline__ unsigned pk2(float lo, float hi) { return f2bf(lo) | (f2bf(hi) << 16); }

#define XB_TMO      128
#define XB_XCNT(j)  (256  + 64 * (j))
#define XB_XSUB(j)  (1280 + 64 * (j))
#define XB_XGEN(j)  (2304 + 64 * (j))
#define XB_TOP      3328
#define XB_TOPGEN   3392
#define XCD_BAR_WORDS 3456
#define XB_SPIN_CAP (1u << 18)

__device__ __forceinline__ unsigned xb_ld(unsigned* p)              { return __hip_atomic_load(p, __ATOMIC_RELAXED, __HIP_MEMORY_SCOPE_AGENT); }
__device__ __forceinline__ unsigned xb_add(unsigned* p, unsigned v) { return __hip_atomic_fetch_add(p, v, __ATOMIC_RELAXED, __HIP_MEMORY_SCOPE_AGENT); }
__device__ __forceinline__ unsigned xb_xcc_id() { return (unsigned)__builtin_amdgcn_s_getreg((3 << 11) | 20) & 0xFu; }
#define XB_SPIN(cond, bar) do { unsigned _sp = 0; while (cond) { __builtin_amdgcn_s_sleep(1); \
    if ((++_sp & 255u) == 0u) { if (xb_ld(&(bar)[XB_TMO])) break; if (_sp > XB_SPIN_CAP) { atomicAdd(&(bar)[XB_TMO], 1u); break; } } } } while (0)

struct XcdBarrier {
    unsigned* bar; unsigned x;
    volatile LAS unsigned* st;
};

__device__ __forceinline__ XcdBarrier xcd_barrier_post(unsigned* bar, volatile LAS unsigned* st) {
    XcdBarrier b; b.bar = bar; b.x = xb_xcc_id(); b.st = st;
    if (threadIdx.x == 0) (void)xb_add(&bar[XB_XCNT(b.x)], 1u);
    return b;
}
__device__ __forceinline__ void xcd_barrier_complete(unsigned* bar, unsigned x, unsigned& nloc, unsigned& nx) {
    const unsigned G = gridDim.x * gridDim.y * gridDim.z;
    unsigned sum, cnt, mine, sp = 0u;
    for (;;) {
        sum = 0u; cnt = 0u; mine = 0u;
#pragma unroll
        for (unsigned j = 0; j < 16; ++j) { const unsigned c = xb_ld(&bar[XB_XCNT(j)]); sum += c; cnt += (c > 0u) ? 1u : 0u; mine = (j == x) ? c : mine; }
        if (sum == G) break;
        __builtin_amdgcn_s_sleep(1);
        if ((++sp & 255u) == 0u) { if (xb_ld(&bar[XB_TMO])) break; if (sp > XB_SPIN_CAP) { atomicAdd(&bar[XB_TMO], 1u); break; } }
    }
    nloc = mine > 0u ? mine : 1u; nx = cnt > 0u ? cnt : 1u;
}

__device__ __forceinline__ void xcd_barrier(const XcdBarrier& b) {
    asm volatile("s_waitcnt vmcnt(0)" ::: "memory");
    __syncthreads();
    if (threadIdx.x == 0) {
        unsigned* bar = b.bar;
        __builtin_amdgcn_s_waitcnt(0);
        unsigned nloc = b.st[0], nx = b.st[1];
        if (nloc == 0u) { xcd_barrier_complete(bar, b.x, nloc, nx); b.st[0] = nloc; b.st[1] = nx; }
        const unsigned old = xb_add(&bar[XB_XSUB(b.x)], 1u);
        const unsigned gen = old / nloc;
        if (old + 1u == (gen + 1u) * nloc) {
            __builtin_amdgcn_fence(__ATOMIC_RELEASE, "agent");
            asm volatile("s_waitcnt vmcnt(0)" ::: "memory");
            const unsigned og = xb_add(&bar[XB_TOP], 1u);
            const unsigned tg = og / nx;
            if (og + 1u == (tg + 1u) * nx) xb_add(&bar[XB_TOPGEN], 1u);
            else XB_SPIN(xb_ld(&bar[XB_TOPGEN]) == tg, bar);
            __builtin_amdgcn_fence(__ATOMIC_ACQUIRE, "agent");
            xb_add(&bar[XB_XGEN(b.x)], 1u);
            asm volatile("s_waitcnt vmcnt(0)" ::: "memory");
        } else {
            XB_SPIN(xb_ld(&bar[XB_XGEN(b.x)]) == gen, bar);
            __builtin_amdgcn_fence(__ATOMIC_ACQUIRE, "agent");
            asm volatile("s_waitcnt vmcnt(0)" ::: "memory");
        }
    }
    __syncthreads();
}


#define PROBE_PHASE -1
#define PROBE_A 0
#define PROBE_B 1
#define STAMP(i) do { if (PROBE_PHASE >= 0 && blockIdx.x == 0 && threadIdx.x == 0) *(volatile LAS unsigned long long*)(lds + LDSCTL_OFF + 64 + 8 * (i)) = __builtin_amdgcn_s_memrealtime(); } while (0)
typedef float f32x16 __attribute__((ext_vector_type(16)));
typedef short s16x4 __attribute__((ext_vector_type(4)));
typedef unsigned u32x2 __attribute__((ext_vector_type(2)));
typedef float f32x2 __attribute__((ext_vector_type(2)));
__device__ __forceinline__ float wave_sum(float v) {
#pragma unroll
    for (int o = 1; o < 64; o <<= 1) v += __shfl_xor(v, o);
    return v;
}
__device__ __forceinline__ float partner32(float v) { return __shfl_xor(v, 32); }
__device__ __forceinline__ int partner32i(int v) { return __shfl_xor(v, 32); }
__device__ __forceinline__ int crow(int r, int hi) { return (r & 3) + 8 * (r >> 2) + 4 * hi; }
__device__ __forceinline__ float bflo(unsigned w) { return __uint_as_float(w << 16); }
__device__ __forceinline__ float bfhi(unsigned w) { return __uint_as_float(w & 0xffff0000u); }
__device__ __forceinline__ unsigned cvtpk(float lo, float hi) { unsigned r; asm volatile("v_cvt_pk_bf16_f32 %0, %1, %2" : "=v"(r) : "v"(lo), "v"(hi)); return r; }

struct TrItem { const float* W; bf16* WT; const float* kscale; int K, N, k0, n0; };
__device__ __forceinline__ void tr_load(const TrItem& it, f32x4 (&v)[8], int lane) {
    const int rr = lane >> 3, ch = lane & 7;
#pragma unroll
    for (int i = 0; i < 8; ++i) v[i] = *(const f32x4*)(it.W + (size_t)(it.k0 + rr + 8 * i) * it.N + it.n0 + 4 * ch);
}
__device__ __forceinline__ void tr_finish(const TrItem& it, f32x4 (&v)[8], LAS float* scr, int lane) {
    const int rr = lane >> 3, ch = lane & 7;
    if (it.kscale) {
#pragma unroll
        for (int i = 0; i < 8; ++i) v[i] = v[i] * it.kscale[it.k0 + rr + 8 * i];
    }
#pragma unroll
    for (int i = 0; i < 8; ++i) { LAS float* p = scr + (rr + 8 * i) * 33 + 4 * ch; p[0] = v[i].x; p[1] = v[i].y; p[2] = v[i].z; p[3] = v[i].w; }
    LDS_WAIT(); asm volatile("" ::: "memory");
    const int c = lane & 7;
#pragma unroll
    for (int j = 0; j < 4; ++j) { const int n = (lane >> 3) + 8 * j; const LAS float* s = scr + (8 * c) * 33 + n;
        v4u o; o.x = pk2(s[0 * 33], s[1 * 33]); o.y = pk2(s[2 * 33], s[3 * 33]); o.z = pk2(s[4 * 33], s[5 * 33]); o.w = pk2(s[6 * 33], s[7 * 33]);
        *(v4u*)(it.WT + (size_t)(it.n0 + n) * it.K + it.k0 + 8 * c) = o; }
    LDS_WAIT(); asm volatile("" ::: "memory");
}
__device__ __forceinline__ float wave_max(float v) {
#pragma unroll
    for (int o = 1; o < 64; o <<= 1) v = fmaxf(v, __shfl_xor(v, o));
    return v;
}
__device__ __forceinline__ void rms_rows2_to_i8(const float* x0, const float* x1, const float* gain, unsigned char* o0, unsigned char* o1, float* sa0, float* sa1, int lane) {
    const f32x4* xa = (const f32x4*)x0 + lane; const f32x4* xb = (const f32x4*)x1 + lane; const f32x4* gr = (const f32x4*)gain + lane;
    f32x4 va[8], vb[8]; float sa = 0.f, sb = 0.f;
#pragma unroll
    for (int j = 0; j < 8; ++j) { va[j] = xa[64 * j]; vb[j] = xb[64 * j]; }
#pragma unroll
    for (int j = 0; j < 8; ++j) { sa += (va[j].x * va[j].x + va[j].y * va[j].y) + (va[j].z * va[j].z + va[j].w * va[j].w); sb += (vb[j].x * vb[j].x + vb[j].y * vb[j].y) + (vb[j].z * vb[j].z + vb[j].w * vb[j].w); }
    const float ia = 1.f / sqrtf(wave_sum(sa) * (1.f / D) + RMS_EPS), ib = 1.f / sqrtf(wave_sum(sb) * (1.f / D) + RMS_EPS);
    float ma = 0.f, mb = 0.f;
#pragma unroll
    for (int j = 0; j < 8; ++j) { const f32x4 g = gr[64 * j]; va[j] = va[j] * g * ia; vb[j] = vb[j] * g * ib;
        ma = fmaxf(ma, fmaxf(fmaxf(fabsf(va[j].x), fabsf(va[j].y)), fmaxf(fabsf(va[j].z), fabsf(va[j].w)))); mb = fmaxf(mb, fmaxf(fmaxf(fabsf(vb[j].x), fabsf(vb[j].y)), fmaxf(fabsf(vb[j].z), fabsf(vb[j].w)))); }
    ma = wave_max(ma); mb = wave_max(mb);
    const float qa = ma > 0.f ? 127.f / ma : 0.f, qb = mb > 0.f ? 127.f / mb : 0.f;
    unsigned* pa = (unsigned*)o0 + lane; unsigned* pb = (unsigned*)o1 + lane;
#pragma unroll
    for (int j = 0; j < 8; ++j) {
        pa[64 * j] = (unsigned)((int)rintf(va[j].x * qa) & 255) | ((unsigned)((int)rintf(va[j].y * qa) & 255) << 8) | ((unsigned)((int)rintf(va[j].z * qa) & 255) << 16) | ((unsigned)((int)rintf(va[j].w * qa) & 255) << 24);
        pb[64 * j] = (unsigned)((int)rintf(vb[j].x * qb) & 255) | ((unsigned)((int)rintf(vb[j].y * qb) & 255) << 8) | ((unsigned)((int)rintf(vb[j].z * qb) & 255) << 16) | ((unsigned)((int)rintf(vb[j].w * qb) & 255) << 24); }
    if (lane == 0) { *sa0 = ma * (1.f / 127.f); *sa1 = mb * (1.f / 127.f); }
}
__device__ __forceinline__ void tr_finish_i8(const TrItem& it, f32x4 (&v)[8], const float* colmax, LAS float* scr, int lane) {
    const int rr = lane >> 3, ch = lane & 7;
#pragma unroll
    for (int i = 0; i < 8; ++i) { LAS float* p = scr + (rr + 8 * i) * 33 + 4 * ch; p[0] = v[i].x; p[1] = v[i].y; p[2] = v[i].z; p[3] = v[i].w; }
    LDS_WAIT(); asm volatile("" ::: "memory");
    const int c = lane & 3;
#pragma unroll
    for (int j = 0; j < 2; ++j) { const int n = (lane >> 2) + 16 * j; const LAS float* s = scr + (16 * c) * 33 + n;
        const float cm = colmax[it.n0 + n]; const float q = cm > 0.f ? 127.f / cm : 0.f;
        unsigned w[4];
#pragma unroll
        for (int d = 0; d < 4; ++d) w[d] = (unsigned)((int)rintf(s[(4 * d) * 33] * q) & 255) | ((unsigned)((int)rintf(s[(4 * d + 1) * 33] * q) & 255) << 8) | ((unsigned)((int)rintf(s[(4 * d + 2) * 33] * q) & 255) << 16) | ((unsigned)((int)rintf(s[(4 * d + 3) * 33] * q) & 255) << 24);
        *(v4u*)((unsigned char*)it.WT + (size_t)(it.n0 + n) * it.K + it.k0 + 16 * c) = (v4u){w[0], w[1], w[2], w[3]}; }
    LDS_WAIT(); asm volatile("" ::: "memory");
}

struct Ptrs {
    const float *x, *norm_mix, *w_in, *conv_w, *w_conv_out, *w_attn_out, *w_out, *norm_ffn, *peer_wq, *peer_sk, *peer_u, *peer_v, *norm_final;
    float* out; unsigned char* ws;
};

__device__ __forceinline__ void p0_prologue(const Ptrs& P, LAS unsigned char* lds, int vcu, int G, int wave, int lane, int tid) {
    LAS float* scr = (LAS float*)(lds + RING_OFF + wave * 16384);
    const int gw = vcu * NWAVES + wave, NGW = G * NWAVES;
    bf16* WCO = (bf16*)(P.ws + WS_WCO); bf16* WAO = (bf16*)(P.ws + WS_WAO); bf16* WO = (bf16*)(P.ws + WS_WO); bf16* WQ = (bf16*)(P.ws + WS_WQ);
    constexpr int I_CO = (CW / 64) * (D / 32), I_AO = (AW / 64) * (D / 32), I_O = (D / 64) * (D / 32), I_Q = I_O;
    constexpr int NITEMS = I_CO + I_AO + I_O + I_Q;
    auto mk = [&](int it) {
        TrItem t; int r = it, K, N;
        if (r < I_CO) { t.W = P.w_conv_out; t.WT = WCO; t.kscale = nullptr; K = CW; N = D; }
        else if ((r -= I_CO) < I_AO) { t.W = P.w_attn_out; t.WT = WAO; t.kscale = nullptr; K = AW; N = D; }
        else if ((r -= I_AO) < I_O) { t.W = P.w_out; t.WT = WO; t.kscale = nullptr; K = D; N = D; }
        else { r -= I_O; t.W = P.peer_wq; t.WT = WQ; t.kscale = P.norm_ffn; K = D; N = D; }
        const int nblk = N / 32; t.K = K; t.N = N; t.k0 = 64 * (r / nblk); t.n0 = 32 * (r % nblk); return t; };
    {
        unsigned* CM = (unsigned*)(P.ws + WS_CTL) + CW_COLMAX;
        constexpr int NCB = INW / 256;
        for (int it = gw; it < (D / 64) * NCB; it += NGW) {
            const int kb = it / NCB, cb = it % NCB; const float* src = P.w_in + (size_t)(64 * kb) * INW + 256 * cb + 4 * lane;
            f32x4 m = (f32x4){0.f, 0.f, 0.f, 0.f};
#pragma unroll 16
            for (int r = 0; r < 64; ++r) { const f32x4 v = *(const f32x4*)(src + (size_t)r * INW); m.x = fmaxf(m.x, fabsf(v.x)); m.y = fmaxf(m.y, fabsf(v.y)); m.z = fmaxf(m.z, fabsf(v.z)); m.w = fmaxf(m.w, fabsf(v.w)); }
            unsigned* d = CM + 256 * cb + 4 * lane;
            atomicMax(d, __float_as_uint(m.x)); atomicMax(d + 1, __float_as_uint(m.y)); atomicMax(d + 2, __float_as_uint(m.z)); atomicMax(d + 3, __float_as_uint(m.w));
        }
    }
    {
        f32x4 va[8], vb[8];
        int it = gw;
        if (it < NITEMS) { const TrItem a = mk(it); tr_load(a, va, lane); }
        for (; it < NITEMS; it += 2 * NGW) {
            const TrItem a = mk(it);
            const bool hb = it + NGW < NITEMS; TrItem b = a; if (hb) { b = mk(it + NGW); tr_load(b, vb, lane); }
            tr_finish(a, va, scr, lane);
            if (it + 2 * NGW < NITEMS) { const TrItem c = mk(it + 2 * NGW); tr_load(c, va, lane); }
            if (hb) tr_finish(b, vb, scr, lane);
        }
    }
    unsigned char* XN = P.ws + WS_XN; float* SA = (float*)(P.ws + WS_SA);
    for (int m = gw; m < T / 2; m += NGW) rms_rows2_to_i8(P.x + (size_t)(2 * m) * D, P.x + (size_t)(2 * m + 1) * D, P.norm_mix, XN + (size_t)(2 * m) * D, XN + (size_t)(2 * m + 1) * D, SA + 2 * m, SA + 2 * m + 1, lane);
    {
        unsigned char* UQ = P.ws + WS_UQ; float* SU = (float*)(P.ws + WS_SU);
        const float* gr = P.norm_ffn + 4 * lane;
        for (int e2 = gw; e2 < NEXP / 2; e2 += NGW) {
            f32x4 v[2][8];
#pragma unroll
            for (int h = 0; h < 2; ++h)
#pragma unroll
                for (int j = 0; j < 8; ++j) v[h][j] = *(const f32x4*)(P.peer_u + (size_t)(2 * e2 + h) * D + 4 * lane + 256 * j);
#pragma unroll
            for (int j = 0; j < 8; ++j) { const f32x4 gg = *(const f32x4*)(gr + 256 * j); v[0][j] = v[0][j] * gg; v[1][j] = v[1][j] * gg; }
#pragma unroll
            for (int h = 0; h < 2; ++h) {
                const int e = 2 * e2 + h, g = egroup(e), r = erow(e);
#pragma unroll
                for (int j = 0; j < 8; ++j) {
                    float m = fmaxf(fmaxf(fabsf(v[h][j].x), fabsf(v[h][j].y)), fmaxf(fabsf(v[h][j].z), fabsf(v[h][j].w)));
                    m = fmaxf(m, __shfl_xor(m, 1)); m = fmaxf(m, __shfl_xor(m, 2)); m = fmaxf(m, __shfl_xor(m, 4)); m = fmaxf(m, __shfl_xor(m, 8)); m = fmaxf(m, __shfl_xor(m, 16));
                    const float inv = m > 0.f ? 127.f / m : 0.f;
                    const int q0 = (int)rintf(v[h][j].x * inv), q1 = (int)rintf(v[h][j].y * inv), q2 = (int)rintf(v[h][j].z * inv), q3 = (int)rintf(v[h][j].w * inv);
                    const unsigned w = (unsigned)(q0 & 255) | ((unsigned)(q1 & 255) << 8) | ((unsigned)(q2 & 255) << 16) | ((unsigned)(q3 & 255) << 24);
                    const int sl = 2 * j + (lane >> 5), role = g * NS + sl;
                    *(unsigned*)(UQ + ((size_t)role * EG + r) * DW + 4 * (lane & 31)) = w;
                    if ((lane & 31) == 0) SU[role * EG + r] = m * (1.f / 127.f);
                }
            }
        }
    }
    {
        const int gt = (vcu * NWAVES + wave) * 64 + lane, NGT = G * NWAVES * 64;
        bf16* SK = (bf16*)(P.ws + WS_SK);
        for (int it = gt; it < 2 * PKEYS * PHALF; it += NGT) SK[it] = (bf16)f2bf(P.peer_sk[it]);
    }
    {
        LAS unsigned char* tile = lds + RING_OFF;
        unsigned char* VQ = P.ws + WS_VQ;
        __syncthreads();
        for (int b = vcu; b < NEXP / 32; b += G) {
            const int e0 = b * 32;
#pragma unroll
            for (int i = 0; i < 4; ++i) {
                const int er = wave * 4 + i; const float* vr = P.peer_v + (size_t)(e0 + er) * D + 4 * lane;
#pragma unroll
                for (int j = 0; j < 8; ++j) {
                    const f32x4 v = *(const f32x4*)(vr + 256 * j);
                    int w = 0; w = __builtin_amdgcn_cvt_pk_fp8_f32(v.x, v.y, w, false); w = __builtin_amdgcn_cvt_pk_fp8_f32(v.z, v.w, w, true);
                    const int c = (lane >> 1) + 32 * j;
                    *(LAS int*)(tile + (c * 33 + er) * 8 + 4 * (lane & 1)) = w;
                }
            }
            __syncthreads();
#pragma unroll 4
            for (int k = 0; k < 16; ++k) {
                const int c = wave * 32 + 2 * k + (lane >> 5), er = lane & 31;
                const u32x2 q = *(const LAS u32x2*)(tile + (c * 33 + er) * 8);
                *(u32x2*)(VQ + ((size_t)c * NEXP + e0 + er) * 8) = q;
            }
            __syncthreads();
        }
    }
}

__device__ __forceinline__ void p0_win_i8(const Ptrs& P, LAS unsigned char* lds, int vcu, int G, int wave, int lane) {
    LAS float* scr = (LAS float*)(lds + RING_OFF + wave * 16384);
    const int gw = vcu * NWAVES + wave, NGW = G * NWAVES;
    const float* CM = (const float*)((const unsigned*)(P.ws + WS_CTL) + CW_COLMAX);
    constexpr int NITEMS = (D / 64) * (INW / 32);
    auto mk = [&](int it) { TrItem t; t.W = P.w_in; t.WT = (bf16*)(P.ws + WS_WIN); t.kscale = nullptr; t.K = D; t.N = INW; t.k0 = 64 * (it & 31); t.n0 = 32 * (it >> 5); return t; };
    f32x4 va[8], vb[8];
    int it = gw;
    if (it < NITEMS) { const TrItem a = mk(it); tr_load(a, va, lane); }
    for (; it < NITEMS; it += 2 * NGW) {
        const TrItem a = mk(it);
        const bool hb = it + NGW < NITEMS; TrItem b = a; if (hb) { b = mk(it + NGW); tr_load(b, vb, lane); }
        tr_finish_i8(a, va, CM, scr, lane);
        if (it + 2 * NGW < NITEMS) { const TrItem c = mk(it + 2 * NGW); tr_load(c, va, lane); }
        if (hb) tr_finish_i8(b, vb, CM, scr, lane);
    }
}

__device__ __forceinline__ void p2_conv(const Ptrs& P, int gt, int NGT) {
    const bf16* PROJ = (const bf16*)(P.ws + WS_PROJ); bf16* YC = (bf16*)(P.ws + WS_YC);
    constexpr int NIT = (T / 8) * (CW / 8);
    for (int it = gt; it < NIT; it += NGT) {
        const int ch = it % (CW / 8), tb = it / (CW / 8), c0 = ch * 8, t0 = tb * 8;
        float w0[8], w1[8], w2[8];
#pragma unroll
        for (int i = 0; i < 8; ++i) { w0[i] = P.conv_w[c0 + i]; w1[i] = P.conv_w[CW + c0 + i]; w2[i] = P.conv_w[2 * CW + c0 + i]; }
        float zm2[8], zm1[8];
#pragma unroll
        for (int i = 0; i < 8; ++i) { zm2[i] = 0.f; zm1[i] = 0.f; }
#pragma unroll
        for (int dt = -2; dt < 8; ++dt) {
            const int t = t0 + dt; if (t < 0) continue;
            const v4u cc = *(const v4u*)(PROJ + (size_t)t * INW + C_CC + c0), hh = *(const v4u*)(PROJ + (size_t)t * INW + C_CH + c0);
            float z[8];
            z[0] = bflo(cc.x) * bflo(hh.x); z[1] = bfhi(cc.x) * bfhi(hh.x); z[2] = bflo(cc.y) * bflo(hh.y); z[3] = bfhi(cc.y) * bfhi(hh.y);
            z[4] = bflo(cc.z) * bflo(hh.z); z[5] = bfhi(cc.z) * bfhi(hh.z); z[6] = bflo(cc.w) * bflo(hh.w); z[7] = bfhi(cc.w) * bfhi(hh.w);
            if (dt >= 0) {
                const v4u cb = *(const v4u*)(PROJ + (size_t)t * INW + C_CB + c0);
                float b[8] = {bflo(cb.x), bfhi(cb.x), bflo(cb.y), bfhi(cb.y), bflo(cb.z), bfhi(cb.z), bflo(cb.w), bfhi(cb.w)};
                float y[8];
#pragma unroll
                for (int i = 0; i < 8; ++i) y[i] = b[i] * (w0[i] * zm2[i] + w1[i] * zm1[i] + w2[i] * z[i]);
                v4u o; o.x = pk2(y[0], y[1]); o.y = pk2(y[2], y[3]); o.z = pk2(y[4], y[5]); o.w = pk2(y[6], y[7]);
                *(v4u*)(YC + (size_t)t * CW + c0) = o;
            }
#pragma unroll
            for (int i = 0; i < 8; ++i) { zm2[i] = zm1[i]; zm1[i] = z[i]; }
        }
    }
}

__device__ __forceinline__ s16x4 vtr(LAS const unsigned char* p) { typedef short v4i16_t __attribute__((ext_vector_type(4))); return __builtin_bit_cast(s16x4, __builtin_amdgcn_ds_read_tr16_b64_v4i16((LAS v4i16_t*)p)); }

__device__ __forceinline__ void attn_task(const bf16* PROJ, bf16* YA, LAS unsigned char* vl  , int qt, int h, int lane) {
    const int r32 = lane & 31, hi = lane >> 5, q0 = qt * 32;
    const bf16* Qp = PROJ + (size_t)(q0 + r32) * INW + C_Q + h * HD + 8 * hi;
    bf16x8 qf[4];
#pragma unroll
    for (int s = 0; s < 4; ++s) qf[s] = *(const bf16x8*)(Qp + 16 * s);
    float carry = 1.f;
    f32x16 o0, o1;
#pragma unroll
    for (int r = 0; r < 16; ++r) { o0[r] = 0.f; o1[r] = 0.f; }
    const int g1 = (lane >> 4) & 1, qq = (lane & 15) >> 2, pp = lane & 3;
    LAS const unsigned char* vrd = vl + (4 * hi + qq) * 128 + g1 * 32 + pp * 8;
    for (int kt = qt; kt >= 0; --kt) {
        const int k0 = kt * 32;
        const bf16* Kp = PROJ + (size_t)(k0 + r32) * INW + C_K + h * HD + 8 * hi;
        bf16x8 kf[4];
#pragma unroll
        for (int s = 0; s < 4; ++s) kf[s] = *(const bf16x8*)(Kp + 16 * s);
        v4u vv[4];
#pragma unroll
        for (int i = 0; i < 4; ++i) { const int c = lane + 64 * i, row = c >> 3, chn = c & 7; vv[i] = *(const v4u*)(PROJ + (size_t)(k0 + row) * INW + C_V + h * HD + chn * 8); }
        f32x16 S;
#pragma unroll
        for (int r = 0; r < 16; ++r) S[r] = 0.f;
#pragma unroll
        for (int s = 0; s < 4; ++s) S = __builtin_amdgcn_mfma_f32_32x32x16_bf16(kf[s], qf[s], S, 0, 0, 0);
#pragma unroll
        for (int i = 0; i < 4; ++i) { const int c = lane + 64 * i, row = c >> 3, chn = c & 7; *(LAS v4u*)(vl + row * 128 + chn * 16) = vv[i]; }
        float kp[16], bt[16];
        const float cs = 0.125f * 1.4426950408889634f;
#pragma unroll
        for (int r = 0; r < 16; ++r) { const float a = fminf(S[r] * cs, 126.f); const float e = __builtin_amdgcn_exp2f(a); const float ri = __builtin_amdgcn_rcpf(1.f + e); kp[r] = ri; bt[r] = e * ri; }
        if (kt == qt) {
#pragma unroll
            for (int r = 0; r < 16; ++r) { if (crow(r, hi) >= r32) { kp[r] = 1.f; bt[r] = 0.f; } }
        }
        float Pm[4], Qm[4], Tt[4];
#pragma unroll
        for (int i = 0; i < 4; ++i) { Pm[i] = (kp[4 * i] * kp[4 * i + 1]) * (kp[4 * i + 2] * kp[4 * i + 3]); Qm[i] = partner32(Pm[i]); Tt[i] = Pm[i] * Qm[i]; }
        float R[4]; R[3] = 1.f; R[2] = Tt[3]; R[1] = Tt[3] * Tt[2]; R[0] = R[1] * Tt[1];
        const float total = R[0] * Tt[0];
        float w[16];
#pragma unroll
        for (int i = 0; i < 4; ++i) {
            const float base = carry * R[i] * (hi ? 1.f : Qm[i]);
            const float x3 = base, x2 = x3 * kp[4 * i + 3], x1 = x2 * kp[4 * i + 2], x0 = x1 * kp[4 * i + 1];
            w[4 * i + 3] = bt[4 * i + 3] * x3; w[4 * i + 2] = bt[4 * i + 2] * x2; w[4 * i + 1] = bt[4 * i + 1] * x1; w[4 * i] = bt[4 * i] * x0;
        }
        carry *= total;
        v4u wa0, wa1;
        wa0.x = cvtpk(w[0], w[1]); wa0.y = cvtpk(w[2], w[3]); wa0.z = cvtpk(w[4], w[5]); wa0.w = cvtpk(w[6], w[7]);
        wa1.x = cvtpk(w[8], w[9]); wa1.y = cvtpk(w[10], w[11]); wa1.z = cvtpk(w[12], w[13]); wa1.w = cvtpk(w[14], w[15]);
        asm volatile("s_waitcnt lgkmcnt(0)" ::: "memory");
        s16x4 l00 = vtr(vrd + 0 * 64 + 0 * 2048), h00 = vtr(vrd + 0 * 64 + 0 * 2048 + 1024);
        s16x4 l01 = vtr(vrd + 0 * 64 + 1 * 2048), h01 = vtr(vrd + 0 * 64 + 1 * 2048 + 1024);
        s16x4 l10 = vtr(vrd + 1 * 64 + 0 * 2048), h10 = vtr(vrd + 1 * 64 + 0 * 2048 + 1024);
        s16x4 l11 = vtr(vrd + 1 * 64 + 1 * 2048), h11 = vtr(vrd + 1 * 64 + 1 * 2048 + 1024);
        asm volatile("s_waitcnt lgkmcnt(0)" ::: "memory");
#define PKV(l, hh) (bf16x8){l[0], l[1], l[2], l[3], hh[0], hh[1], hh[2], hh[3]}
        o0 = __builtin_amdgcn_mfma_f32_32x32x16_bf16(__builtin_bit_cast(bf16x8, wa0), PKV(l00, h00), o0, 0, 0, 0);
        o0 = __builtin_amdgcn_mfma_f32_32x32x16_bf16(__builtin_bit_cast(bf16x8, wa1), PKV(l01, h01), o0, 0, 0, 0);
        o1 = __builtin_amdgcn_mfma_f32_32x32x16_bf16(__builtin_bit_cast(bf16x8, wa0), PKV(l10, h10), o1, 0, 0, 0);
        o1 = __builtin_amdgcn_mfma_f32_32x32x16_bf16(__builtin_bit_cast(bf16x8, wa1), PKV(l11, h11), o1, 0, 0, 0);
#undef PKV
        if (__all(carry < 1e-30f)) break;
    }
    bf16* Op = YA + (size_t)q0 * AW + h * HD + r32;
#pragma unroll
    for (int r = 0; r < 16; ++r) { const int qr = crow(r, hi); Op[(size_t)qr * AW] = (bf16)f2bf(o0[r]); Op[(size_t)qr * AW + 32] = (bf16)f2bf(o1[r]); }
}

template <int N> __device__ __forceinline__ float take_max(float (&v)[N]) {
    float m = v[0];
#pragma unroll
    for (int i = 1; i < N; ++i) m = fmaxf(m, v[i]);
    const float g = fmaxf(m, partner32(m));
#pragma unroll
    for (int i = 0; i < N; ++i) v[i] = (v[i] == g) ? -INFINITY : v[i];
    return g;
}
struct constexpr_ij { int i, j; };
__host__ __device__ constexpr constexpr_ij cand_ij(int k) {
    int n = 0;
    for (int i = 0; i < 16; ++i) for (int j = 0; j < 16; ++j) if ((i + 1) * (j + 1) <= 16) { if (n == k) return constexpr_ij{i, j}; ++n; }
    return constexpr_ij{0, 0};
}
__device__ __forceinline__ void topk_task(const bf16* QP, const bf16* SK, int* IDX, float* GATE, int tt, int h, int lane) {
    const int r32 = lane & 31, hi = lane >> 5, t = tt * 32 + r32;
    float top[2][16];
#pragma unroll
    for (int side = 0; side < 2; ++side) {
        const bf16* Qp = QP + (size_t)t * D + h * PQD + side * PHALF + 8 * hi;
        bf16x8 qf[8];
#pragma unroll
        for (int s = 0; s < 8; ++s) qf[s] = *(const bf16x8*)(Qp + 16 * s);
        float sc[64];
#pragma unroll
        for (int kb = 0; kb < 4; ++kb) {
            const bf16* Kp = SK + (size_t)(side * PKEYS + kb * 32 + r32) * PHALF + 8 * hi;
            asm volatile("" : "+v"(Kp));
            f32x16 S;
#pragma unroll
            for (int r = 0; r < 16; ++r) S[r] = 0.f;
#pragma unroll
            for (int s = 0; s < 8; ++s) { const bf16x8 kf = *(const bf16x8*)(Kp + 16 * s); S = __builtin_amdgcn_mfma_f32_32x32x16_bf16(kf, qf[s], S, 0, 0, 0); }
#pragma unroll
            for (int r = 0; r < 16; ++r) { const unsigned key = (unsigned)(kb * 32 + crow(r, hi)); sc[kb * 16 + r] = __uint_as_float((__float_as_uint(S[r]) & ~127u) | (127u - key)); }
            asm volatile("" ::: "memory");
        }
#pragma unroll
        for (int k = 0; k < 16; ++k) top[side][k] = take_max<64>(sc);
        asm volatile("" ::: "memory");
    }
    asm volatile("" ::: "memory");
    float cv[25]; int ci[25];
#pragma unroll
    for (int k = 0; k < 25; ++k) {
        constexpr_ij c0 = cand_ij(k), c1 = cand_ij(k + 25);
        const float a = hi ? top[0][c1.i] : top[0][c0.i], b = hi ? top[1][c1.j] : top[1][c0.j];
        const float s = a + b;
        cv[k] = __uint_as_float((__float_as_uint(s) & ~63u) | (unsigned)(hi ? 63 - (k + 25) : 63 - k));
        ci[k] = (int)(127u - (__float_as_uint(a) & 127u)) * PKEYS + (int)(127u - (__float_as_uint(b) & 127u));
    }
    float sv[16]; int si[16];
#pragma unroll
    for (int k = 0; k < 16; ++k) {
        float m = cv[0];
#pragma unroll
        for (int i = 1; i < 25; ++i) m = fmaxf(m, cv[i]);
        const float g = fmaxf(m, partner32(m));
        int id = 0;
#pragma unroll
        for (int i = 0; i < 25; ++i) { const bool hit = (cv[i] == g); id = hit ? ci[i] : id; cv[i] = hit ? -INFINITY : cv[i]; }
        const int pid = partner32i(id);
        sv[k] = g; si[k] = id > pid ? id : pid;
    }
    float ex[16], sum = 0.f;
#pragma unroll
    for (int k = 0; k < 16; ++k) { ex[k] = __expf(sv[k] - sv[0]); sum += ex[k]; }
    const float rs = 1.f / sum;
    if (!hi) {
        int* ip = IDX + (size_t)t * NPAIR + h * PTOPK;
#pragma unroll
        for (int k = 0; k < 16; k += 4) *(int4*)(ip + k) = make_int4(si[k], si[k + 1], si[k + 2], si[k + 3]);
    } else {
        float* gp = GATE + (size_t)t * NPAIR + h * PTOPK;
#pragma unroll
        for (int k = 0; k < 16; k += 4) *(f32x4*)(gp + k) = (f32x4){ex[k] * rs, ex[k + 1] * rs, ex[k + 2] * rs, ex[k + 3] * rs};
    }
}

__device__ __forceinline__ void sortq_token(const bf16* X1B, const float* SSQ, const int* IDX, const float* GATE, unsigned short* ES, unsigned short* ESG, float* GS, unsigned short* OFFN, float* SXS, unsigned char* XQ, int t, int lane) {
    const int id0 = IDX[(size_t)t * NPAIR + lane], id1 = IDX[(size_t)t * NPAIR + 64 + lane];
    const float g0 = GATE[(size_t)t * NPAIR + lane], g1 = GATE[(size_t)t * NPAIR + 64 + lane];
    const int k0 = egroup(id0), k1 = egroup(id1);
    int off = 0, pos0 = 0, pos1 = 0, myoffn = 0, rk0 = 0, rk1 = 0;
#pragma unroll
    for (int g = 0; g < NG; ++g) {
        const unsigned long long m0 = __ballot(k0 == g), m1 = __ballot(k1 == g);
        const int c0 = __popcll(m0), c1 = __popcll(m1);
        const int r0 = __builtin_amdgcn_mbcnt_hi((unsigned)(m0 >> 32), __builtin_amdgcn_mbcnt_lo((unsigned)m0, 0));
        const int r1 = __builtin_amdgcn_mbcnt_hi((unsigned)(m1 >> 32), __builtin_amdgcn_mbcnt_lo((unsigned)m1, 0));
        if (k0 == g) { pos0 = off + r0; rk0 = r0; }
        if (k1 == g) { pos1 = off + c0 + r1; rk1 = c0 + r1; }
        if (lane == g) myoffn = off | ((c0 + c1) << 8);
        off += c0 + c1;
    }
    ES[(size_t)t * NPAIR + pos0] = (unsigned short)id0; ES[(size_t)t * NPAIR + pos1] = (unsigned short)id1;
    if (rk0 < 16) ESG[((size_t)t * NG + k0) * 16 + rk0] = (unsigned short)id0;
    if (rk1 < 16) ESG[((size_t)t * NG + k1) * 16 + rk1] = (unsigned short)id1;
    GS[(size_t)t * NPAIR + pos0] = g0; GS[(size_t)t * NPAIR + pos1] = g1;
    if (lane < NG) OFFN[(size_t)t * NG + lane] = (unsigned short)myoffn;
    const float inv_rms = 1.0f / sqrtf(SSQ[t] * (1.f / D) + RMS_EPS);
    const v4u* xr = (const v4u*)(X1B + (size_t)t * D) + lane;
#pragma unroll
    for (int j = 0; j < 4; ++j) {
        const v4u xv = xr[64 * j];
        float f[8] = {bflo(xv.x), bfhi(xv.x), bflo(xv.y), bfhi(xv.y), bflo(xv.z), bfhi(xv.z), bflo(xv.w), bfhi(xv.w)};
        float m = 0.f;
#pragma unroll
        for (int i = 0; i < 8; ++i) m = fmaxf(m, fabsf(f[i]));
        m = fmaxf(m, __shfl_xor(m, 1)); m = fmaxf(m, __shfl_xor(m, 2)); m = fmaxf(m, __shfl_xor(m, 4)); m = fmaxf(m, __shfl_xor(m, 8));
        const float inv = m > 0.f ? 127.f / m : 0.f;
        unsigned w0 = 0, w1 = 0;
#pragma unroll
        for (int i = 0; i < 4; ++i) { w0 |= ((unsigned)((int)rintf(f[i] * inv) & 255)) << (8 * i); w1 |= ((unsigned)((int)rintf(f[4 + i] * inv) & 255)) << (8 * i); }
        *(u32x2*)(XQ + (size_t)t * D + 512 * j + 8 * lane) = (u32x2){w0, w1};
        if ((lane & 15) == 0) SXS[(size_t)t * NS + 4 * j + (lane >> 4)] = m * (1.f / 127.f) * inv_rms;
    }
}

#define U_DPPDOT(C) asm volatile("v_dot4c_i32_i8_dpp %0, %4, %8 row_ror:" #C " row_mask:0xf bank_mask:0xf\n\tv_dot4c_i32_i8_dpp %1, %5, %9 row_ror:" #C " row_mask:0xf bank_mask:0xf\n\t" \
        "v_dot4c_i32_i8_dpp %2, %6, %10 row_ror:" #C " row_mask:0xf bank_mask:0xf\n\tv_dot4c_i32_i8_dpp %3, %7, %11 row_ror:" #C " row_mask:0xf bank_mask:0xf" \
        : "+v"(a0_), "+v"(a1_), "+v"(a2_), "+v"(a3_) : "v"(xv_.x), "v"(xv_.y), "v"(xv_.z), "v"(xv_.w), "v"(tb_[C].x), "v"(tb_[C].y), "v"(tb_[C].z), "v"(tb_[C].w))
__device__ __forceinline__ void peer_u_role(const unsigned char* UQ, const float* SU, const unsigned char* XQ, const float* SXS, const unsigned short* ES, const unsigned short* ESG, const unsigned short* OFFN, float* PART,
                                            LAS unsigned char* lds, int role, int wave, int lane, int tid) {
    const int s = role & (NS - 1), g = role >> 4;
    __syncthreads();
    {
        const v4u* src = (const v4u*)(UQ + (size_t)role * EG * DW);
#pragma unroll 4
        for (int i = tid; i < EG * DW / 16; i += NWAVES * 64) *(LAS v4u*)(lds + (size_t)i * 16) = src[i];
        const float* ssrc = SU + (size_t)role * EG;
        for (int i = tid; i < EG; i += NWAVES * 64) *(LAS float*)(lds + LDS_SU_OFF + i * 4) = ssrc[i];
    }
    __syncthreads();
    STAMP(20);
    const int ts = lane >> 4, k = lane & 15, cid = lane & 7;
    float* part = PART + (size_t)s * T * NPAIR;
    int coff[8];
#pragma unroll
    for (int c_ = 0; c_ < 8; ++c_) coff[c_] = ((cid - c_) & 7) * 16;
    const int rot = (role * 37) & 255;
#define U_TQ(I) (wave + NWAVES * (((I) + rot) & 255))
#define U_LOAD(I, OF, E, XV, SX) do { const size_t tt_ = (size_t)(4 * U_TQ(I) + ts); \
        OF = OFFN[tt_ * NG + g]; E = ESG[(tt_ * NG + g) * 16 + k]; XV = *(const v4u*)(XQ + tt_ * D + s * DW + 16 * cid); SX = SXS[tt_ * NS + s]; } while (0)
#define U_DOT(ACC, EV, XV, ACTIVE) do { LAS const unsigned char* rowp_ = lds + erow((int)(EV)) * DW; v4u tb_[8]; const v4u xv_ = (XV); \
        _Pragma("unroll") for (int c_ = 0; c_ < 8; ++c_) tb_[c_] = (v4u){0u, 0u, 0u, 0u}; \
        if (ACTIVE) { _Pragma("unroll") for (int c_ = 0; c_ < 8; ++c_) tb_[c_] = *(const LAS v4u*)(rowp_ + coff[c_]); } \
        int a0_ = 0, a1_ = 0, a2_ = 0, a3_ = 0; \
        asm volatile("s_nop 4\n\tv_dot4c_i32_i8 %0, %4, %8\n\tv_dot4c_i32_i8 %1, %5, %9\n\tv_dot4c_i32_i8 %2, %6, %10\n\tv_dot4c_i32_i8 %3, %7, %11" \
            : "+v"(a0_), "+v"(a1_), "+v"(a2_), "+v"(a3_) : "v"(xv_.x), "v"(xv_.y), "v"(xv_.z), "v"(xv_.w), "v"(tb_[0].x), "v"(tb_[0].y), "v"(tb_[0].z), "v"(tb_[0].w)); \
        U_DPPDOT(1); U_DPPDOT(2); U_DPPDOT(3); U_DPPDOT(4); U_DPPDOT(5); U_DPPDOT(6); U_DPPDOT(7); ACC = (a0_ + a1_) + (a2_ + a3_); } while (0)
#define U_COMP(I, OF, E, XV, SX) do { const int t_ = 4 * U_TQ(I) + ts; const int j0_ = (OF) & 255, n_ = (OF) >> 8; int acc_; U_DOT(acc_, E, XV, k < n_); \
        const float su_ = *(const LAS float*)(lds + LDS_SU_OFF + erow((int)(E)) * 4); \
        if (k < n_) part[(size_t)t_ * NPAIR + j0_ + k] = (float)acc_ * su_ * (SX); } while (0)
    unsigned of0, of1, of2, of3, of4, of5, of6, of7, e0, e1, e2, e3, e4, e5, e6, e7; v4u x0, x1, x2, x3, x4, x5, x6, x7; float s0, s1, s2, s3, s4, s5, s6, s7;
    U_LOAD(0, of0, e0, x0, s0); U_LOAD(1, of1, e1, x1, s1); U_LOAD(2, of2, e2, x2, s2); U_LOAD(3, of3, e3, x3, s3);
#pragma unroll 1
    for (int it = 0; it < T / 4 / NWAVES; it += 8) {
        U_LOAD(it + 4, of4, e4, x4, s4); U_COMP(it, of0, e0, x0, s0); __builtin_amdgcn_sched_barrier(0);
        U_LOAD(it + 5, of5, e5, x5, s5); U_COMP(it + 1, of1, e1, x1, s1); __builtin_amdgcn_sched_barrier(0);
        U_LOAD(it + 6, of6, e6, x6, s6); U_COMP(it + 2, of2, e2, x2, s2); __builtin_amdgcn_sched_barrier(0);
        U_LOAD(it + 7, of7, e7, x7, s7); U_COMP(it + 3, of3, e3, x3, s3); __builtin_amdgcn_sched_barrier(0);
        U_LOAD(it + 8, of0, e0, x0, s0); U_COMP(it + 4, of4, e4, x4, s4); __builtin_amdgcn_sched_barrier(0);
        U_LOAD(it + 9, of1, e1, x1, s1); U_COMP(it + 5, of5, e5, x5, s5); __builtin_amdgcn_sched_barrier(0);
        U_LOAD(it + 10, of2, e2, x2, s2); U_COMP(it + 6, of6, e6, x6, s6); __builtin_amdgcn_sched_barrier(0);
        U_LOAD(it + 11, of3, e3, x3, s3); U_COMP(it + 7, of7, e7, x7, s7); __builtin_amdgcn_sched_barrier(0);
    }
    STAMP(21);
    {
        unsigned ofl[16];
#pragma unroll
        for (int b16 = 0; b16 < 16; ++b16) { const int i_ = b16 * 64 + lane; const int t_l = 4 * (wave + NWAVES * (i_ >> 2)) + (i_ & 3); ofl[b16] = OFFN[(size_t)t_l * NG + g]; }
#pragma unroll
        for (int b16 = 0; b16 < 16; ++b16) {
            const int i_ = b16 * 64 + lane; const int t_l = 4 * (wave + NWAVES * (i_ >> 2)) + (i_ & 3);
            const unsigned of_l = ofl[b16];
            unsigned long long mask = __ballot((of_l >> 8) > 16u);
            while (mask) {
                const int b = __builtin_ctzll(mask); mask &= mask - 1;
                const int t_o = __builtin_amdgcn_readlane(t_l, b); const unsigned of_o = (unsigned)__builtin_amdgcn_readlane((int)of_l, b);
                const int j0_ = of_o & 255, n_ = of_o >> 8;
                const v4u xo = *(const v4u*)(XQ + (size_t)t_o * D + s * DW + 16 * cid); const float so = SXS[(size_t)t_o * NS + s];
                for (int kk = 16 + 16 * ts + k; __any(kk < n_); kk += 64) {
                    const unsigned e2 = (kk < n_) ? ES[(size_t)t_o * NPAIR + j0_ + kk] : 0u; int a2; U_DOT(a2, e2, xo, kk < n_);
                    const float su2 = *(const LAS float*)(lds + LDS_SU_OFF + erow((int)e2) * 4);
                    if (kk < n_) part[(size_t)t_o * NPAIR + j0_ + kk] = (float)a2 * su2 * so;
                }
            }
        }
    }
    STAMP(23);
#undef U_LOAD
#undef U_TQ
#undef U_DOT
#undef U_COMP
}

__device__ __forceinline__ void peer_reduce_tile(const float* PART, const float* GS, const unsigned short* ES, unsigned* LIST, LAS unsigned char* lds, int tile, int tid) {
    const int t0 = tile * 32;
    const int tloc = tid >> 4, jb = (tid & 15) * 8; const size_t base = (size_t)(t0 + tloc) * NPAIR + jb;
    f32x4 h0 = (f32x4){0.f, 0.f, 0.f, 0.f}, h1 = h0;
#pragma unroll
    for (int sl = 0; sl < NS; ++sl) { const float* p = PART + (size_t)sl * T * NPAIR + base; h0 += *(const f32x4*)p; h1 += *(const f32x4*)(p + 4); }
    const f32x4 ga = *(const f32x4*)(GS + base), gb = *(const f32x4*)(GS + base + 4);
    const v4u ev = *(const v4u*)(ES + base);
    const float hh[8] = {h0.x, h0.y, h0.z, h0.w, h1.x, h1.y, h1.z, h1.w}; const float gg[8] = {ga.x, ga.y, ga.z, ga.w, gb.x, gb.y, gb.z, gb.w};
    const unsigned ee[8] = {ev.x & 0xffffu, ev.x >> 16, ev.y & 0xffffu, ev.y >> 16, ev.z & 0xffffu, ev.z >> 16, ev.w & 0xffffu, ev.w >> 16};
    unsigned w[8];
#pragma unroll
    for (int i = 0; i < 8; ++i) { const float h = hh[i]; const float act = 0.5f * h * (1.f + erff(h * 0.70710678118654752f)) * gg[i]; w[i] = (ee[i] << 16) | f2bf(act); }
    unsigned* dst = LIST + ((size_t)(jb >> 2) * T + (t0 + tloc)) * 4;
    *(v4u*)dst = (v4u){w[0], w[1], w[2], w[3]}; *(v4u*)(dst + (size_t)T * 4) = (v4u){w[4], w[5], w[6], w[7]};
}

__device__ __forceinline__ void peer_v_role(const unsigned char* VQ, const unsigned* LIST, float* X  , float* SSQ2, LAS unsigned char* lds, int c, int wave, int lane, int tid) {
    __syncthreads();
    {
        const v4u* src = (const v4u*)(VQ + (size_t)c * NEXP * 8);
#pragma unroll 4
        for (int i = tid; i < NEXP * 8 / 16; i += NWAVES * 64) *(LAS v4u*)(lds + (size_t)i * 16) = src[i];
    }
    __syncthreads();
    STAMP(22);
    for (int tgi = 0; tgi < T / 64 / NWAVES; ++tgi) {
        const int tg = wave + NWAVES * ((tgi + c) & (T / 64 / NWAVES - 1));
        const int t = tg * 64 + lane;
        f32x2 a01 = (f32x2){0.f, 0.f}, a23 = a01, a45 = a01, a67 = a01;
        const unsigned voff = (unsigned)t * 16u;
        const char* lbase = (const char*)LIST;
#define V_LOAD8(W, J0) do { W[0] = *(const v4u*)(lbase + (size_t)((J0) >> 2) * (T * 16) + voff); W[1] = *(const v4u*)(lbase + (size_t)(((J0) >> 2) + 1) * (T * 16) + voff); } while (0)
#define V_RD1(Q, WW) Q = *(const LAS u32x2*)(lds + (((WW) >> 13) & 0x7fff8u))
#define V_DSRD8(Q, W) do { V_RD1(Q[0], W[0].x); V_RD1(Q[1], W[0].y); V_RD1(Q[2], W[0].z); V_RD1(Q[3], W[0].w); V_RD1(Q[4], W[1].x); V_RD1(Q[5], W[1].y); V_RD1(Q[6], W[1].z); V_RD1(Q[7], W[1].w); } while (0)
#define V_ONE(QQ, WW) do { const u32x2 q_ = (QQ); const float a_ = __uint_as_float((WW) << 16); const f32x2 aa_ = (f32x2){a_, a_}; \
            a01 = __builtin_elementwise_fma(aa_, __builtin_amdgcn_cvt_pk_f32_fp8((int)q_.x, false), a01); a23 = __builtin_elementwise_fma(aa_, __builtin_amdgcn_cvt_pk_f32_fp8((int)q_.x, true), a23); \
            a45 = __builtin_elementwise_fma(aa_, __builtin_amdgcn_cvt_pk_f32_fp8((int)q_.y, false), a45); a67 = __builtin_elementwise_fma(aa_, __builtin_amdgcn_cvt_pk_f32_fp8((int)q_.y, true), a67); } while (0)
#define V_COMP8(Q, W) do { V_ONE(Q[0], W[0].x); V_ONE(Q[1], W[0].y); V_ONE(Q[2], W[0].z); V_ONE(Q[3], W[0].w); V_ONE(Q[4], W[1].x); V_ONE(Q[5], W[1].y); V_ONE(Q[6], W[1].z); V_ONE(Q[7], W[1].w); } while (0)
        v4u w0[2], w1[2], w2[2], w3[2]; u32x2 qa[8], qb[8];
        V_LOAD8(w0, 0); V_LOAD8(w1, 8); V_LOAD8(w2, 16);
        V_DSRD8(qa, w0);
#pragma unroll 1
        for (int j0 = 0; j0 < NPAIR; j0 += 32) {
            V_LOAD8(w3, j0 + 24); V_DSRD8(qb, w1); __builtin_amdgcn_sched_barrier(0); V_COMP8(qa, w0); __builtin_amdgcn_sched_barrier(0);
            V_LOAD8(w0, j0 + 32); V_DSRD8(qa, w2); __builtin_amdgcn_sched_barrier(0); V_COMP8(qb, w1); __builtin_amdgcn_sched_barrier(0);
            V_LOAD8(w1, j0 + 40); V_DSRD8(qb, w3); __builtin_amdgcn_sched_barrier(0); V_COMP8(qa, w2); __builtin_amdgcn_sched_barrier(0);
            V_LOAD8(w2, j0 + 48); V_DSRD8(qa, w0); __builtin_amdgcn_sched_barrier(0); V_COMP8(qb, w3); __builtin_amdgcn_sched_barrier(0);
        }
#undef V_RD1
#undef V_DSRD8
#undef V_LOAD8
#undef V_COMP8
#undef V_ONE
        float acc[8] = {a01.x, a01.y, a23.x, a23.y, a45.x, a45.y, a67.x, a67.y};
        float* xp = X + (size_t)t * D + 8 * c;
        const f32x4 x0 = *(const f32x4*)xp, x1 = *(const f32x4*)(xp + 4);
        const f32x4 y0 = (f32x4){acc[0] + x0.x, acc[1] + x0.y, acc[2] + x0.z, acc[3] + x0.w}, y1 = (f32x4){acc[4] + x1.x, acc[5] + x1.y, acc[6] + x1.z, acc[7] + x1.w};
        *(f32x4*)xp = y0; *(f32x4*)(xp + 4) = y1;
        const float ss = (y0.x * y0.x + y0.y * y0.y) + (y0.z * y0.z + y0.w * y0.w) + (y1.x * y1.x + y1.y * y1.y) + (y1.z * y1.z + y1.w * y1.w);
        atomicAdd(SSQ2 + t, ss);
    }
    STAMP(24);
}
__device__ __forceinline__ void final_norm_row(float* X, const float* SSQ2, const float* gfin, int t, int lane) {
    const float inv = 1.0f / sqrtf(SSQ2[t] * (1.f / D) + RMS_EPS);
    f32x4* xr = (f32x4*)(X + (size_t)t * D) + lane; const f32x4* gr = (const f32x4*)gfin + lane;
    f32x4 v[8];
#pragma unroll
    for (int j = 0; j < 8; ++j) v[j] = xr[64 * j];
#pragma unroll
    for (int j = 0; j < 8; ++j) { const f32x4 g = gr[64 * j]; xr[64 * j] = (f32x4){v[j].x * inv * g.x, v[j].y * inv * g.y, v[j].z * inv * g.z, v[j].w * inv * g.w}; }
}

#ifndef PHASE_MASK
#define PHASE_MASK 0x1ff
#endif
#define PH_ON(k) ((PHASE_MASK >> (k)) & 1)
#ifndef REP_MASK
#define REP_MASK 0
#endif
#define PH_REP(k) (1 + ((REP_MASK >> (k)) & 1))
__device__ __forceinline__ Ptrs load_args() {
#if defined(__HIP_DEVICE_COMPILE__)
    const __attribute__((address_space(4))) Ptrs* pp = (const __attribute__((address_space(4))) Ptrs*)__builtin_amdgcn_kernarg_segment_ptr();
    asm volatile("" : "+s"(pp));
    Ptrs r;
    r.x = pp->x; r.norm_mix = pp->norm_mix; r.w_in = pp->w_in; r.conv_w = pp->conv_w; r.w_conv_out = pp->w_conv_out; r.w_attn_out = pp->w_attn_out; r.w_out = pp->w_out; r.norm_ffn = pp->norm_ffn;
    r.peer_wq = pp->peer_wq; r.peer_sk = pp->peer_sk; r.peer_u = pp->peer_u; r.peer_v = pp->peer_v; r.norm_final = pp->norm_final; r.out = pp->out; r.ws = pp->ws;
    return r;
#else
    return Ptrs{};
#endif
}
__global__ void __launch_bounds__(NWAVES * 64, 2) hyb_fwd(Ptrs Punused) {
    extern __shared__ __attribute__((aligned(16))) unsigned char lds_raw[];
    LAS unsigned char* lds = (LAS unsigned char*)lds_raw;
    const int G = gridDim.x; const int bx = blockIdx.x; const int vcu = (G % 8 == 0) ? (bx % 8) * (G / 8) + bx / 8 : bx;
#define TIDV int tid_ = threadIdx.x; asm volatile("" : "+v"(tid_)); const int tid = tid_, lane = tid & 63, wave = __builtin_amdgcn_readfirstlane(tid >> 6); const int gw = vcu * NWAVES + wave, NGW = G * NWAVES; (void)gw; (void)NGW; (void)lane;
    XcdBarrier bar;
    {
        TIDV; const Ptrs P = load_args();
        volatile LAS unsigned* MISC = (volatile LAS unsigned*)(lds + MISC_OFF);
        for (int u = tid; u < 128; u += NWAVES * 64) ((LAS unsigned*)(lds + LDSCTL_OFF))[u] = 0u;
        __syncthreads();
        bar = xcd_barrier_post((unsigned*)(P.ws + WS_CTL) + CW_BAR, MISC + 8);
    }
#define CTLP ((unsigned*)(P.ws + WS_CTL))
    STAMP(0);

    if (PH_ON(0)) { TIDV; const Ptrs P = load_args(); p0_prologue(P, lds, vcu, G, wave, lane, tid); }
    xcd_barrier(bar);
    { TIDV; const Ptrs P = load_args(); p0_win_i8(P, lds, vcu, G, wave, lane); }
    xcd_barrier(bar);
    STAMP(1);

    if (PH_ON(1)) {
        const Ptrs P = load_args();
        pg8::Gemm g{(const pg8::bf16_t*)(P.ws + WS_XN), (const pg8::bf16_t*)(P.ws + WS_WIN), T, INW, D}; pg8::StaticOrder S; S.init(T, INW, G, bx);
        pg8::EpiStoreI8 E{(pg8::bf16_t*)(P.ws + WS_PROJ), INW, (const float*)(P.ws + WS_SA), (const float*)(CTLP + CW_COLMAX)};
        pg8::gemm_phase<pg8::EpiStoreI8, pg8::StaticOrder, true, true, true>(lds + RING_OFF, g, S, E);
    }
    xcd_barrier(bar);
    STAMP(2);

    if (PH_ON(2)) {
        TIDV; const Ptrs P = load_args();
        p2_conv(P, gw * 64 + lane, NGW * 64);
        const bf16* PROJ = (const bf16*)(P.ws + WS_PROJ); bf16* YA = (bf16*)(P.ws + WS_YA);
        LAS unsigned char* vl = lds + RING_OFF + wave * 4096;
        constexpr int NTASK = (T / 32) * NH;
        for (int it = gw; it < NTASK; it += NGW) { const int task = NTASK - 1 - it; attn_task(PROJ, YA, vl, task / NH, task % NH, lane); }
    }
    xcd_barrier(bar);
    STAMP(3);

    if (PH_ON(3)) {
        pg8::StaticOrder S; S.init(T, D, G, bx);
        { const Ptrs P = load_args();
          pg8::Gemm g{(const pg8::bf16_t*)(P.ws + WS_YC), (const pg8::bf16_t*)(P.ws + WS_WCO), T, D, CW};
          pg8::EpiGate<0> E{(const pg8::bf16_t*)(P.ws + WS_PROJ) + C_GC, INW, (pg8::bf16_t*)(P.ws + WS_XN), D};
          pg8::gemm_phase<pg8::EpiGate<0>, pg8::StaticOrder, true, true>(lds + RING_OFF, g, S, E); }
        { const Ptrs P = load_args();
          pg8::Gemm g{(const pg8::bf16_t*)(P.ws + WS_YA), (const pg8::bf16_t*)(P.ws + WS_WAO), T, D, AW};
          pg8::EpiGate<1> E{(const pg8::bf16_t*)(P.ws + WS_PROJ) + C_GA, INW, (pg8::bf16_t*)(P.ws + WS_XN), D};
          pg8::gemm_phase<pg8::EpiGate<1>, pg8::StaticOrder, true, true>(lds + RING_OFF, g, S, E); }
    }
    xcd_barrier(bar);
    STAMP(4);

    if (PH_ON(4)) {
        const Ptrs P = load_args();
        pg8::Gemm g{(const pg8::bf16_t*)(P.ws + WS_XN), (const pg8::bf16_t*)(P.ws + WS_WO), T, D, D}; pg8::StaticOrder S; S.init(T, D, G, bx);
        pg8::EpiX1 E{P.x, P.out, (pg8::bf16_t*)(P.ws + WS_X1B), (float*)(CTLP + CW_SSQ), D};
        pg8::gemm_phase<pg8::EpiX1, pg8::StaticOrder, true, true>(lds + RING_OFF, g, S, E);
    }
    xcd_barrier(bar);
    STAMP(5);

    if (PH_ON(5)) {
        const Ptrs P = load_args();
        pg8::Gemm g{(const pg8::bf16_t*)(P.ws + WS_X1B), (const pg8::bf16_t*)(P.ws + WS_WQ), T, D, D}; pg8::StaticOrder S; S.init(T, D, G, bx);
        pg8::EpiQP E{(const float*)(CTLP + CW_SSQ), (pg8::bf16_t*)(P.ws + WS_QP), D, 1.f / D, RMS_EPS};
        pg8::gemm_phase<pg8::EpiQP, pg8::StaticOrder, true, true>(lds + RING_OFF, g, S, E);
    }
    xcd_barrier(bar);
    STAMP(6);

    if (PH_ON(6)) {
        TIDV; const Ptrs P = load_args();
        constexpr int NTASK = (T / 32) * PH;
        for (int it = gw; it < NTASK; it += NGW) topk_task((const bf16*)(P.ws + WS_QP), (const bf16*)(P.ws + WS_SK), (int*)(P.ws + WS_IDX), (float*)(P.ws + WS_GATE), it / PH, it % PH, lane);
    }
    xcd_barrier(bar);
    STAMP(7);

    {
        TIDV; const Ptrs P = load_args();
        for (int t = gw; t < T; t += NGW) sortq_token((const bf16*)(P.ws + WS_X1B), (const float*)(CTLP + CW_SSQ), (const int*)(P.ws + WS_IDX), (const float*)(P.ws + WS_GATE), (unsigned short*)(P.ws + WS_ES), (unsigned short*)(P.ws + WS_ESG), (float*)(P.ws + WS_GS),
                                                     (unsigned short*)(P.ws + WS_OFFN), (float*)(P.ws + WS_SXS), P.ws + WS_XQ, t, lane);
    }
    xcd_barrier(bar);
    STAMP(8);
    {
        TIDV; const Ptrs P = load_args();
        for (int role = bx; role < NS * NG; role += G) peer_u_role(P.ws + WS_UQ, (const float*)(P.ws + WS_SU), P.ws + WS_XQ, (const float*)(P.ws + WS_SXS), (const unsigned short*)(P.ws + WS_ES), (const unsigned short*)(P.ws + WS_ESG),
                                                                  (const unsigned short*)(P.ws + WS_OFFN), (float*)(P.ws + WS_PART), lds, role, wave, lane, tid);
    }
    xcd_barrier(bar);
    STAMP(9);
    {
        TIDV; const Ptrs P = load_args();
        for (int tile = vcu; tile < T / 32; tile += G) peer_reduce_tile((const float*)(P.ws + WS_PART), (const float*)(P.ws + WS_GS), (const unsigned short*)(P.ws + WS_ES), (unsigned*)(P.ws + WS_LIST), lds, tile, tid);
    }
    xcd_barrier(bar);
    STAMP(10);

    if (PH_ON(8)) {
        TIDV; const Ptrs P = load_args();
        for (int c = vcu; c < D / 8; c += G) peer_v_role(P.ws + WS_VQ, (const unsigned*)(P.ws + WS_LIST), P.out, (float*)(CTLP + CW_SSQ2), lds, c, wave, lane, tid);
    }
    xcd_barrier(bar);
    STAMP(11);

    {
        TIDV; const Ptrs P = load_args();
        for (int t = gw; t < T; t += NGW) final_norm_row(P.out, (const float*)(CTLP + CW_SSQ2), P.norm_final, t, lane);
    }
    if (PROBE_PHASE >= 0 && blockIdx.x == 0 && threadIdx.x == 0) {
        const unsigned long long now = __builtin_amdgcn_s_memrealtime();
        *(volatile LAS unsigned long long*)(lds + LDSCTL_OFF + 64 + 8 * 12) = now;
        const unsigned long long a = *(volatile LAS unsigned long long*)(lds + LDSCTL_OFF + 64 + 8 * PROBE_A);
        const unsigned long long b = *(volatile LAS unsigned long long*)(lds + LDSCTL_OFF + 64 + 8 * PROBE_B);
        const unsigned long long dt = (b - a) * 8ull;
        while (__builtin_amdgcn_s_memrealtime() - now < dt) __builtin_amdgcn_s_sleep(8);
    }
}

extern "C" void kernel_launch(void* const* d_in, const int* in_sizes, int n_in, void* d_out, int out_size, void* d_ws, size_t ws_size, hipStream_t stream) {
    static int grid = 0;
    if (grid == 0) {
        if (n_in != 13 || out_size != T * D || ws_size < WS_END) { fprintf(stderr, "kernel_launch: unexpected shapes (n_in %d out %d ws %zu)\n", n_in, out_size, ws_size); grid = -1; return; }
        int dev = 0, cus = 0, per_cu = 0;
        if (hipGetDevice(&dev) != hipSuccess || hipDeviceGetAttribute(&cus, hipDeviceAttributeMultiprocessorCount, dev) != hipSuccess) { grid = -1; return; }
        if (hipFuncSetAttribute((const void*)hyb_fwd, hipFuncAttributeMaxDynamicSharedMemorySize, LDS_BYTES) != hipSuccess) { fprintf(stderr, "kernel_launch: hipFuncSetAttribute failed\n"); grid = -1; return; }
        if (hipOccupancyMaxActiveBlocksPerMultiprocessor(&per_cu, (const void*)hyb_fwd, NWAVES * 64, LDS_BYTES) != hipSuccess || per_cu < 1) { fprintf(stderr, "kernel_launch: occupancy query says %d\n", per_cu); per_cu = 1; }
        (void)hipGetLastError();
        grid = cus;
    }
    if (grid < 0) return;
    (void)hipMemsetAsync((char*)d_ws + WS_CTL, 0, CTL_ZERO_BYTES, stream);
    Ptrs p{};
    p.x = (const float*)d_in[0]; p.norm_mix = (const float*)d_in[1]; p.w_in = (const float*)d_in[2]; p.conv_w = (const float*)d_in[3];
    p.w_conv_out = (const float*)d_in[4]; p.w_attn_out = (const float*)d_in[5]; p.w_out = (const float*)d_in[6]; p.norm_ffn = (const float*)d_in[7];
    p.peer_wq = (const float*)d_in[8]; p.peer_sk = (const float*)d_in[9]; p.peer_u = (const float*)d_in[10]; p.peer_v = (const float*)d_in[11]; p.norm_final = (const float*)d_in[12];
    p.out = (float*)d_out; p.ws = (unsigned char*)d_ws;
    void* args[] = {&p};
    hipError_t e = hipLaunchCooperativeKernel((const void*)hyb_fwd, dim3(grid), dim3(NWAVES * 64), args, LDS_BYTES, stream);
    if (e != hipSuccess) fprintf(stderr, "kernel_launch: cooperative launch failed: %s (grid %d)\n", hipGetErrorString(e), grid);
}
```

```cpp
#include <hip/hip_runtime.h>
#include <cstdio>
#include <cstdint>
namespace pg8 {
#define PG8_LAS __attribute__((address_space(3)))
typedef unsigned short bf16_t;
typedef short bf16x8 __attribute__((ext_vector_type(8)));
typedef float f32x4 __attribute__((ext_vector_type(4)));
typedef unsigned u32x4 __attribute__((ext_vector_type(4)));
constexpr int BM = 256, BK = 64, HALF = 128, HTB = HALF * BK * 2  , STAGE_BYTES = 8 * HTB, NXCD = 8, WGM = 8;

__host__ __device__ __forceinline__ int lds_byte(int r, int c) { const int st = (r >> 4) * 2 + (c >> 5), rr = r & 15, cc = c & 31, ob = rr * 64 + cc * 2; return st * 1024 + (ob ^ (((ob >> 9) & 1) << 5)); }
__host__ __device__ __forceinline__ void stage_rc(int b, int& R, int& C) { const int st = b / 1024, sb = b % 1024, swz = sb ^ (((sb >> 9) & 1) << 5); R = (st >> 1) * 16 + swz / 64; C = (st & 1) * 32 + (swz % 64) / 2; }
__host__ __device__ __forceinline__ int perm32(int rho) { const int n = rho >> 4, i = rho & 15; return 8 * (i >> 2) + 4 * n + (i & 3); }

struct Unit { int pm, pn; };
struct Gemm { const bf16_t* A; const bf16_t* Bt; int M, N, K; };

struct StaticOrder {
    int nM, nN, nwg, G, c;
    __host__ __device__ void init(int M, int N, int G_, int c_) { nM = M / BM; nN = N / BM; nwg = nM * nN; G = G_; c = c_; }
    __host__ __device__ bool next(int i, Unit& u) const {
        const long L = (long)i * G + c; if (L >= nwg) return false;
        int wgid = (int)L; { const int q = nwg / NXCD, r = nwg % NXCD, xcd = wgid % NXCD, off = wgid / NXCD; wgid = (xcd < r ? xcd * (q + 1) : r * (q + 1) + (xcd - r) * q) + off; }
        const int nig = WGM * nN, gid = wgid / nig, fm = gid * WGM, gsz = (nM - fm) < WGM ? (nM - fm) : WGM;
        u.pm = fm + ((wgid % nig) % gsz); u.pn = (wgid % nig) / gsz; return true;
    }
    __device__ __forceinline__ void a_ready(const Unit&) const {}
    __device__ __forceinline__ void done(const Unit&) const {}
};


typedef int i32x4 __attribute__((ext_vector_type(4)));
__device__ __forceinline__ unsigned cvt_pk_bf16(float lo, float hi) { unsigned r; asm volatile("v_cvt_pk_bf16_f32 %0, %1, %2" : "=v"(r) : "v"(lo), "v"(hi)); return r; }
__device__ __forceinline__ float bf_lo(unsigned w) { return __uint_as_float(w << 16); }
__device__ __forceinline__ float bf_hi(unsigned w) { return __uint_as_float(w & 0xffff0000u); }
__device__ __forceinline__ float sigmoidf_fast(float x) { return __builtin_amdgcn_rcpf(1.0f + __builtin_amdgcn_exp2f(-1.4426950408889634f * x)); }

struct EpiStore {
    static constexpr bool PERM = true, AFTER_DRAIN = false;
    bf16_t* O; int ldc;
    __device__ __forceinline__ void operator()(const f32x4 (&acc)[2][2][4][2], const Unit& u, int wr, int wc, int fr, int fq) const {
        const int row0 = u.pm * BM + wr * 64 + fr, col0 = u.pn * BM + wc * 32 + 8 * fq;
#pragma unroll
        for (int ai = 0; ai < 2; ++ai)
#pragma unroll
            for (int m = 0; m < 4; ++m) { bf16_t* rowp = O + (size_t)(row0 + ai * HALF + m * 16) * ldc + col0;
#pragma unroll
                for (int bj = 0; bj < 2; ++bj) { const f32x4 v0 = acc[ai][bj][m][0], v1 = acc[ai][bj][m][1];
                    u32x4 w; w.x = cvt_pk_bf16(v0[0], v0[1]); w.y = cvt_pk_bf16(v0[2], v0[3]); w.z = cvt_pk_bf16(v1[0], v1[1]); w.w = cvt_pk_bf16(v1[2], v1[3]);
                    *(u32x4*)(rowp + bj * HALF) = w; } }
    }
};
struct EpiStoreI8 {
    static constexpr bool PERM = true, AFTER_DRAIN = false;
    bf16_t* O; int ldc; const float* SA; const float* SB;
    __device__ __forceinline__ void operator()(const f32x4 (&acc)[2][2][4][2], const Unit& u, int wr, int wc, int fr, int fq) const {
        const int row0 = u.pm * BM + wr * 64 + fr, col0 = u.pn * BM + wc * 32 + 8 * fq;
        f32x4 sb[2][2];
#pragma unroll
        for (int bj = 0; bj < 2; ++bj) { sb[bj][0] = *(const f32x4*)(SB + col0 + bj * HALF) * (1.f / 127.f); sb[bj][1] = *(const f32x4*)(SB + col0 + bj * HALF + 4) * (1.f / 127.f); }
#pragma unroll
        for (int ai = 0; ai < 2; ++ai)
#pragma unroll
            for (int m = 0; m < 4; ++m) { const int row = row0 + ai * HALF + m * 16; const float sa = SA[row]; bf16_t* rowp = O + (size_t)row * ldc + col0;
#pragma unroll
                for (int bj = 0; bj < 2; ++bj) { const i32x4 i0 = __builtin_bit_cast(i32x4, acc[ai][bj][m][0]), i1 = __builtin_bit_cast(i32x4, acc[ai][bj][m][1]);
                    const f32x4 v0 = (f32x4){(float)i0.x, (float)i0.y, (float)i0.z, (float)i0.w} * sb[bj][0] * sa, v1 = (f32x4){(float)i1.x, (float)i1.y, (float)i1.z, (float)i1.w} * sb[bj][1] * sa;
                    u32x4 w; w.x = cvt_pk_bf16(v0[0], v0[1]); w.y = cvt_pk_bf16(v0[2], v0[3]); w.z = cvt_pk_bf16(v1[0], v1[1]); w.w = cvt_pk_bf16(v1[2], v1[3]);
                    *(u32x4*)(rowp + bj * HALF) = w; } }
    }
};
template <int PASS> struct EpiGate {
    static constexpr bool PERM = true, AFTER_DRAIN = false;
    const bf16_t* G; int ldg; bf16_t* O; int ldc;
    __device__ __forceinline__ void operator()(const f32x4 (&acc)[2][2][4][2], const Unit& u, int wr, int wc, int fr, int fq) const {
        const int row0 = u.pm * BM + wr * 64 + fr, col0 = u.pn * BM + wc * 32 + 8 * fq;
#pragma unroll
        for (int ai = 0; ai < 2; ++ai)
#pragma unroll
            for (int m = 0; m < 4; ++m) { const size_t row = (size_t)(row0 + ai * HALF + m * 16);
#pragma unroll
                for (int bj = 0; bj < 2; ++bj) { const f32x4 v0 = acc[ai][bj][m][0], v1 = acc[ai][bj][m][1];
                    const u32x4 g = *(const u32x4*)(G + row * ldg + col0 + bj * HALF);
                    float r[8];
                    r[0] = v0[0] * sigmoidf_fast(bf_lo(g.x)); r[1] = v0[1] * sigmoidf_fast(bf_hi(g.x)); r[2] = v0[2] * sigmoidf_fast(bf_lo(g.y)); r[3] = v0[3] * sigmoidf_fast(bf_hi(g.y));
                    r[4] = v1[0] * sigmoidf_fast(bf_lo(g.z)); r[5] = v1[1] * sigmoidf_fast(bf_hi(g.z)); r[6] = v1[2] * sigmoidf_fast(bf_lo(g.w)); r[7] = v1[3] * sigmoidf_fast(bf_hi(g.w));
                    bf16_t* op = O + row * ldc + col0 + bj * HALF;
                    if (PASS == 1) { const u32x4 p = *(const u32x4*)op;
                        r[0] += bf_lo(p.x); r[1] += bf_hi(p.x); r[2] += bf_lo(p.y); r[3] += bf_hi(p.y); r[4] += bf_lo(p.z); r[5] += bf_hi(p.z); r[6] += bf_lo(p.w); r[7] += bf_hi(p.w); }
                    u32x4 w; w.x = cvt_pk_bf16(r[0], r[1]); w.y = cvt_pk_bf16(r[2], r[3]); w.z = cvt_pk_bf16(r[4], r[5]); w.w = cvt_pk_bf16(r[6], r[7]);
                    *(u32x4*)op = w; }
                asm volatile("" ::: "memory"); }
    }
};
struct EpiX1 {
    static constexpr bool PERM = true, AFTER_DRAIN = false;
    const float* X; bf16_t* X1B; float* SSQ; int ldc;
    __device__ __forceinline__ void operator()(const f32x4 (&acc)[2][2][4][2], const Unit& u, int wr, int wc, int fr, int fq) const {
        const int row0 = u.pm * BM + wr * 64 + fr, col0 = u.pn * BM + wc * 32 + 8 * fq;
#pragma unroll
        for (int ai = 0; ai < 2; ++ai)
#pragma unroll
            for (int m = 0; m < 4; ++m) { const size_t row = (size_t)(row0 + ai * HALF + m * 16); float ss = 0.f;
#pragma unroll
                for (int bj = 0; bj < 2; ++bj) { const size_t off = row * ldc + col0 + bj * HALF;
                    const f32x4 x0 = *(const f32x4*)(X + off), x1 = *(const f32x4*)(X + off + 4);
                    const f32x4 v0 = acc[ai][bj][m][0] + x0, v1 = acc[ai][bj][m][1] + x1;
                    u32x4 w; w.x = cvt_pk_bf16(v0[0], v0[1]); w.y = cvt_pk_bf16(v0[2], v0[3]); w.z = cvt_pk_bf16(v1[0], v1[1]); w.w = cvt_pk_bf16(v1[2], v1[3]);
                    *(u32x4*)(X1B + off) = w;
                    ss += (v0[0] * v0[0] + v0[1] * v0[1]) + (v0[2] * v0[2] + v0[3] * v0[3]) + (v1[0] * v1[0] + v1[1] * v1[1]) + (v1[2] * v1[2] + v1[3] * v1[3]); }
                ss += __shfl_xor(ss, 16); ss += __shfl_xor(ss, 32);
                if (fq == 0) atomicAdd(SSQ + row, ss);
                asm volatile("" ::: "memory"); }
    }
};
struct EpiQP {
    static constexpr bool PERM = true, AFTER_DRAIN = false;
    const float* SSQ; bf16_t* O; int ldc; float inv_n, eps;
    __device__ __forceinline__ void operator()(const f32x4 (&acc)[2][2][4][2], const Unit& u, int wr, int wc, int fr, int fq) const {
        const int row0 = u.pm * BM + wr * 64 + fr, col0 = u.pn * BM + wc * 32 + 8 * fq;
#pragma unroll
        for (int ai = 0; ai < 2; ++ai)
#pragma unroll
            for (int m = 0; m < 4; ++m) { const size_t row = (size_t)(row0 + ai * HALF + m * 16); const float inv = 1.0f / sqrtf(SSQ[row] * inv_n + eps);
                bf16_t* rowp = O + row * ldc + col0;
#pragma unroll
                for (int bj = 0; bj < 2; ++bj) { const f32x4 v0 = acc[ai][bj][m][0] * inv, v1 = acc[ai][bj][m][1] * inv;
                    u32x4 w; w.x = cvt_pk_bf16(v0[0], v0[1]); w.y = cvt_pk_bf16(v0[2], v0[3]); w.z = cvt_pk_bf16(v1[0], v1[1]); w.w = cvt_pk_bf16(v1[2], v1[3]);
                    *(u32x4*)(rowp + bj * HALF) = w; } }
    }
};


template <bool I8> __device__ __forceinline__ f32x4 mma16(bf16x8 a, bf16x8 b, f32x4 c) {
    if constexpr (I8) return __builtin_bit_cast(f32x4, __builtin_amdgcn_mfma_i32_16x16x64_i8(__builtin_bit_cast(i32x4, a), __builtin_bit_cast(i32x4, b), __builtin_bit_cast(i32x4, c), 0, 0, 0));
    else return __builtin_amdgcn_mfma_f32_16x16x32_bf16(a, b, c, 0, 0, 0);
}
template <class Epi, class Sched, bool ALIGN_EPI = false, bool SP2 = false, bool I8 = false>
__device__ __forceinline__ void gemm_phase(PG8_LAS unsigned char* lds, const Gemm g, const Sched& S, const Epi& E) {
    const int tid = threadIdx.x, wid = __builtin_amdgcn_readfirstlane(tid >> 6), lane = tid & 63, wr = wid >> 2, wc = wid & 3, fr = lane & 15, fq = lane >> 4;
    const int K = I8 ? g.K / 2 : g.K, nt = K / BK;
    unsigned voffA[2], voffB[2];
#pragma unroll
    for (int i = 0; i < 2; ++i) { int R, C; stage_rc(tid * 16 + i * 8192, R, C); const int Rb = Epi::PERM ? ((R & ~31) + perm32(R & 31)) : R;
        voffA[i] = (unsigned)(R * K + C) * 2u; voffB[i] = (unsigned)(Rb * K + C) * 2u; }
    const size_t kstep = (size_t)(BK * 2);
    const size_t hstep = (size_t)HALF * K * 2;
    const size_t tstep = 2 * hstep;
    const unsigned ldsw = (unsigned)wid * 1024u;
    const int aoff = lds_byte(wr * 64 + fr, fq * 8), boff = lds_byte(wc * 32 + fr, fq * 8);
#define PG8_SA(b, h) (((b) * 2 + (h)) * HTB)
#define PG8_SB(b, h) ((4 + (b) * 2 + (h)) * HTB)
#define PG8_STAGE(bufoff, gbase, voff) do { _Pragma("unroll") for (int _i = 0; _i < 2; ++_i) \
        __builtin_amdgcn_global_load_lds((const unsigned*)((const char*)(gbase) + (voff)[_i]), (PG8_LAS unsigned*)(lds + (bufoff) + ldsw + _i * 8192), 16, 0, 0); } while (0)
#define PG8_LDA(dst, b, h) do { _Pragma("unroll") for (int m = 0; m < 4; ++m) _Pragma("unroll") for (int k = 0; k < 2; ++k) dst[m][k] = *(const PG8_LAS bf16x8*)(lds + PG8_SA(b, h) + aoff + m * 2048 + k * 1024); } while (0)
#define PG8_LDB(dst, b, h) do { _Pragma("unroll") for (int n = 0; n < 2; ++n) _Pragma("unroll") for (int k = 0; k < 2; ++k) dst[n][k] = *(const PG8_LAS bf16x8*)(lds + PG8_SB(b, h) + boff + n * 2048 + k * 1024); } while (0)
#define PG8_MMA(ai, bj, At, Bt) do { __builtin_amdgcn_s_setprio(1); _Pragma("unroll") for (int m = 0; m < 4; ++m) _Pragma("unroll") for (int n = 0; n < 2; ++n) _Pragma("unroll") for (int k = 0; k < 2; ++k) \
        acc[ai][bj][m][n] = mma16<I8>(Bt[n][k], At[m][k], acc[ai][bj][m][n]); __builtin_amdgcn_s_setprio(0); } while (0)
#define PG8_WAIT_V(n) asm volatile("s_waitcnt vmcnt(" #n ")" ::: "memory")
#define PG8_WAIT_L(n) asm volatile("s_waitcnt lgkmcnt(" #n ")" ::: "memory")
#define PG8_BAR __builtin_amdgcn_s_barrier()
#define PG8_SCHED __builtin_amdgcn_sched_barrier(0)
    Unit cur, nxt; int ui = 0;
    if (!S.next(0, cur)) return;
    f32x4 acc[2][2][4][2];
#pragma unroll
    for (int a = 0; a < 2; ++a)
#pragma unroll
        for (int b = 0; b < 2; ++b)
#pragma unroll
            for (int m = 0; m < 4; ++m)
#pragma unroll
                for (int n = 0; n < 2; ++n) acc[a][b][m][n] = (f32x4){0.f, 0.f, 0.f, 0.f};
    bf16x8 At[4][2], B0[2][2], B1[2][2];
    const char* cA = (const char*)g.A + (size_t)cur.pm * tstep; const char* cB = (const char*)g.Bt + (size_t)cur.pn * tstep;
    S.a_ready(cur);
    if constexpr (SP2) {
        PG8_STAGE(PG8_SB(0, 0), cB, voffB); PG8_STAGE(PG8_SB(0, 1), cB + hstep, voffB); PG8_STAGE(PG8_SA(0, 0), cA, voffA); PG8_STAGE(PG8_SA(0, 1), cA + hstep, voffA);
        if (wr == 1) PG8_BAR;
        PG8_WAIT_V(2); PG8_BAR;
        PG8_STAGE(PG8_SB(1, 0), cB + kstep, voffB); PG8_STAGE(PG8_SA(1, 0), cA + kstep, voffA); PG8_STAGE(PG8_SB(1, 1), cB + hstep + kstep, voffB);
        PG8_WAIT_V(6); PG8_BAR;
    } else {
        PG8_STAGE(PG8_SB(0, 0), cB, voffB); PG8_STAGE(PG8_SA(0, 0), cA, voffA); PG8_STAGE(PG8_SB(0, 1), cB + hstep, voffB); PG8_STAGE(PG8_SA(0, 1), cA + hstep, voffA);
        if (wr == 1) PG8_BAR;
        PG8_WAIT_V(4); PG8_BAR;
        PG8_STAGE(PG8_SB(1, 0), cB + kstep, voffB); PG8_STAGE(PG8_SA(1, 0), cA + kstep, voffA); PG8_STAGE(PG8_SB(1, 1), cB + hstep + kstep, voffB);
        PG8_WAIT_V(6); PG8_BAR;
    }
    for (;;) {
        const bool has_next = S.next(ui + 1, nxt);
        const char* nA = has_next ? (const char*)g.A + (size_t)nxt.pm * tstep : cA; const char* nB = has_next ? (const char*)g.Bt + (size_t)nxt.pn * tstep : cB;
        for (int t = 0; t < nt; t += 2) {
            const bool last = (t == nt - 2);
            const char* a1 = cA + (size_t)(t + 1) * kstep;
            const char* a2 = last ? nA : cA + (size_t)(t + 2) * kstep; const char* b2 = last ? nB : cB + (size_t)(t + 2) * kstep;
            const char* a3 = a2 + kstep; const char* b3 = b2 + kstep;
            if (last && has_next) S.a_ready(nxt);
            if constexpr (SP2) {
            PG8_LDB(B0, 0, 0); PG8_LDB(B1, 0, 1); PG8_SCHED; PG8_LDA(At, 0, 0); PG8_STAGE(PG8_SA(1, 1), a1 + hstep, voffA);
            PG8_WAIT_V(8); PG8_WAIT_L(0); PG8_BAR; PG8_MMA(0, 0, At, B0); PG8_MMA(0, 1, At, B1); PG8_BAR; PG8_SCHED;
            PG8_LDA(At, 0, 1); PG8_STAGE(PG8_SB(0, 0), b2, voffB); PG8_STAGE(PG8_SB(0, 1), b2 + hstep, voffB); PG8_STAGE(PG8_SA(0, 0), a2, voffA);
            PG8_WAIT_V(8); PG8_WAIT_L(0); PG8_BAR; PG8_MMA(1, 0, At, B0); PG8_MMA(1, 1, At, B1); PG8_BAR; PG8_SCHED;
            PG8_LDB(B0, 1, 0); PG8_LDB(B1, 1, 1); PG8_SCHED; PG8_LDA(At, 1, 0); PG8_STAGE(PG8_SA(0, 1), a2 + hstep, voffA);
            PG8_WAIT_V(8); PG8_WAIT_L(0); PG8_BAR; PG8_MMA(0, 0, At, B0); PG8_MMA(0, 1, At, B1); PG8_BAR; PG8_SCHED;
            PG8_LDA(At, 1, 1); PG8_STAGE(PG8_SB(1, 0), b3, voffB); PG8_STAGE(PG8_SB(1, 1), b3 + hstep, voffB); PG8_STAGE(PG8_SA(1, 0), a3, voffA);
            PG8_WAIT_V(8); PG8_WAIT_L(0); PG8_BAR; PG8_MMA(1, 0, At, B0); PG8_MMA(1, 1, At, B1); PG8_BAR; PG8_SCHED;
            } else {
            PG8_LDB(B0, 0, 0); PG8_SCHED; PG8_LDA(At, 0, 0); PG8_STAGE(PG8_SA(1, 1), a1 + hstep, voffA);
            PG8_WAIT_L(8); PG8_BAR; PG8_WAIT_L(0); PG8_MMA(0, 0, At, B0); PG8_BAR; PG8_SCHED;
            PG8_LDB(B1, 0, 1); PG8_STAGE(PG8_SB(0, 0), b2, voffB);
            PG8_BAR; PG8_WAIT_L(0); PG8_MMA(0, 1, At, B1); PG8_BAR;
            PG8_LDA(At, 0, 1); PG8_STAGE(PG8_SA(0, 0), a2, voffA);
            PG8_BAR; PG8_WAIT_L(0); PG8_MMA(1, 0, At, B0); PG8_BAR; PG8_SCHED;
            PG8_STAGE(PG8_SB(0, 1), b2 + hstep, voffB);
            PG8_WAIT_V(6); PG8_BAR; PG8_MMA(1, 1, At, B1); PG8_BAR;
            PG8_LDB(B0, 1, 0); PG8_SCHED; PG8_LDA(At, 1, 0); PG8_STAGE(PG8_SA(0, 1), a2 + hstep, voffA);
            PG8_WAIT_L(8); PG8_BAR; PG8_WAIT_L(0); PG8_MMA(0, 0, At, B0); PG8_BAR; PG8_SCHED;
            PG8_LDB(B1, 1, 1); PG8_STAGE(PG8_SB(1, 0), b3, voffB);
            PG8_BAR; PG8_WAIT_L(0); PG8_MMA(0, 1, At, B1); PG8_BAR;
            PG8_LDA(At, 1, 1); PG8_STAGE(PG8_SA(1, 0), a3, voffA);
            PG8_BAR; PG8_WAIT_L(0); PG8_MMA(1, 0, At, B0); PG8_BAR; PG8_SCHED;
            PG8_STAGE(PG8_SB(1, 1), b3 + hstep, voffB);
            PG8_WAIT_V(6); PG8_BAR; PG8_MMA(1, 1, At, B1); PG8_BAR;
            }
        }
        if constexpr (ALIGN_EPI) { if (wr == 0) PG8_BAR; }
        if constexpr (!Epi::AFTER_DRAIN) { E(acc, cur, wr, wc, fr, fq); S.done(cur); }
        if (!has_next) break;
#pragma unroll
        for (int a = 0; a < 2; ++a)
#pragma unroll
            for (int b = 0; b < 2; ++b)
#pragma unroll
                for (int m = 0; m < 4; ++m)
#pragma unroll
                    for (int n = 0; n < 2; ++n) acc[a][b][m][n] = (f32x4){0.f, 0.f, 0.f, 0.f};
        cur = nxt; cA = nA; cB = nB; ++ui;
        if constexpr (ALIGN_EPI) { if (wr == 1) PG8_BAR; }
    }
    PG8_WAIT_V(0);
    if constexpr (!ALIGN_EPI) { if (wr == 0) PG8_BAR; }
    PG8_BAR;
    if constexpr (Epi::AFTER_DRAIN) { E.fused(acc, cur, wr, wc, fr, fq, lds, wid, lane); S.done(cur); }
#undef PG8_SA
#undef PG8_SB
#undef PG8_STAGE
#undef PG8_LDA
#undef PG8_LDB
#undef PG8_MMA
#undef PG8_WAIT_V
#undef PG8_WAIT_L
#undef PG8_BAR
#undef PG8_SCHED
}
}


constexpr int NWAVES = 8;
constexpr int T = 8192, D = 2048, CW = 1024, AW = 1024, NH = 16, HD = 64, INW = 10240;
constexpr int C_CB = 0, C_CC = 1024, C_CH = 2048, C_Q = 3072, C_K = 4096, C_V = 5120, C_GC = 6144, C_GA = 8192;
constexpr int NS = 16, DW = 128, NG = 16, EG = 1024;
__host__ __device__ constexpr int egroup(int e) { return ((e >> 7) ^ e) & 15; }
__host__ __device__ constexpr int erow(int e) { return ((e >> 7) << 3) | ((e >> 4) & 7); }
constexpr int PH = 8, PKEYS = 128, PHALF = 128, PQD = 256, PTOPK = 16, NEXP = 16384, NPAIR = PH * PTOPK;
constexpr float RMS_EPS = 1e-6f;

constexpr size_t MiB = 1u << 20;
constexpr size_t WS_CTL = 0, CTL_ZERO_BYTES = 1 * MiB;
constexpr size_t WS_WIN = 1 * MiB;
constexpr size_t WS_SA = 22 * MiB;
constexpr size_t WS_WCO = 41 * MiB;
constexpr size_t WS_WAO = 45 * MiB;
constexpr size_t WS_WO = 49 * MiB;
constexpr size_t WS_WQ = 57 * MiB;
constexpr size_t WS_SK = 65 * MiB;
constexpr size_t WS_XN = 66 * MiB;
constexpr size_t WS_YC = 98 * MiB;
constexpr size_t WS_YA = 114 * MiB;
constexpr size_t WS_UQ = 130 * MiB;
constexpr size_t WS_SU = 162 * MiB;
constexpr size_t WS_VQ = 194 * MiB;
constexpr size_t WS_PROJ = 258 * MiB;
constexpr size_t WS_X1B = WS_PROJ;
constexpr size_t WS_QP = WS_PROJ + 32 * MiB;
constexpr size_t WS_IDX = WS_PROJ + 64 * MiB;
constexpr size_t WS_GATE = WS_PROJ + 68 * MiB;
constexpr size_t WS_ACT = WS_PROJ + 72 * MiB;
constexpr size_t WS_LIST = WS_PROJ + 76 * MiB;
constexpr size_t WS_ES = WS_PROJ + 80 * MiB;
constexpr size_t WS_GS = WS_PROJ + 82 * MiB;
constexpr size_t WS_OFFN = WS_PROJ + 86 * MiB;
constexpr size_t WS_SXS = WS_PROJ + 87 * MiB;
constexpr size_t WS_XQ = WS_PROJ + 88 * MiB;
constexpr size_t WS_PART = WS_PROJ + 104 * MiB;
constexpr size_t WS_ESG = WS_PROJ + 168 * MiB;
constexpr size_t WS_END = 432 * MiB;
constexpr int CW_BAR = 4096;
constexpr int CW_SSQ = 65536;
constexpr int CW_COLMAX = CW_SSQ + 16384;
constexpr int CW_SSQ2 = CW_SSQ + 8192;
static_assert((CW_COLMAX + INW) * 4 <= (int)CTL_ZERO_BYTES, "ctl");

constexpr int RING_OFF = 0, RING_BYTES = 131072;
constexpr int LDSCTL_OFF = RING_BYTES, MISC_OFF = LDSCTL_OFF + 320;
constexpr int LDS_BYTES = 163840;
constexpr int LDS_SU_OFF = 132096;

#define GAS __attribute__((address_space(1)))
#define LAS __attribute__((address_space(3)))
typedef unsigned short bf16;
typedef unsigned v4u __attribute__((ext_vector_type(4)));
typedef float f32x4 __attribute__((ext_vector_type(4)));
typedef short bf16x8 __attribute__((ext_vector_type(8)));
typedef GAS unsigned gu32;
typedef GAS unsigned long long gu64;
#define RLX_AGENT __ATOMIC_RELAXED, __HIP_MEMORY_SCOPE_AGENT
#define LDS_WAIT() asm volatile("s_waitcnt lgkmcnt(0)" ::: "memory")
#define VM_WAIT() asm volatile("s_waitcnt vmcnt(0)" ::: "memory")
__device__ __forceinline__ unsigned long long rt() { return __builtin_amdgcn_s_memrealtime(); }
__device__ __forceinline__ unsigned f2bf(float f) { unsigned u = __builtin_bit_cast(unsigned, f); return (u + 0x7fffu + ((u >> 16) & 1u)) >> 16; }
__device__ __forceinline__ unsigned pk2(float lo, float hi) { return f2bf(lo) | (f2bf(hi) << 16); }

#define XB_TMO      128
#define XB_XCNT(j)  (256  + 64 * (j))
#define XB_XSUB(j)  (1280 + 64 * (j))
#define XB_XGEN(j)  (2304 + 64 * (j))
#define XB_TOP      3328
#define XB_TOPGEN   3392
#define XCD_BAR_WORDS 3456
#define XB_SPIN_CAP (1u << 18)

__device__ __forceinline__ unsigned xb_ld(unsigned* p)              { return __hip_atomic_load(p, __ATOMIC_RELAXED, __HIP_MEMORY_SCOPE_AGENT); }
__device__ __forceinline__ unsigned xb_add(unsigned* p, unsigned v) { return __hip_atomic_fetch_add(p, v, __ATOMIC_RELAXED, __HIP_MEMORY_SCOPE_AGENT); }
__device__ __forceinline__ unsigned xb_xcc_id() { return (unsigned)__builtin_amdgcn_s_getreg((3 << 11) | 20) & 0xFu; }
#define XB_SPIN(cond, bar) do { unsigned _sp = 0; while (cond) { __builtin_amdgcn_s_sleep(1); \
    if ((++_sp & 255u) == 0u) { if (xb_ld(&(bar)[XB_TMO])) break; if (_sp > XB_SPIN_CAP) { atomicAdd(&(bar)[XB_TMO], 1u); break; } } } } while (0)

struct XcdBarrier {
    unsigned* bar; unsigned x;
    volatile LAS unsigned* st;
};

__device__ __forceinline__ XcdBarrier xcd_barrier_post(unsigned* bar, volatile LAS unsigned* st) {
    XcdBarrier b; b.bar = bar; b.x = xb_xcc_id(); b.st = st;
    if (threadIdx.x == 0) (void)xb_add(&bar[XB_XCNT(b.x)], 1u);
    return b;
}
__device__ __forceinline__ void xcd_barrier_complete(unsigned* bar, unsigned x, unsigned& nloc, unsigned& nx) {
    const unsigned G = gridDim.x * gridDim.y * gridDim.z;
    unsigned sum, cnt, mine, sp = 0u;
    for (;;) {
        sum = 0u; cnt = 0u; mine = 0u;
#pragma unroll
        for (unsigned j = 0; j < 16; ++j) { const unsigned c = xb_ld(&bar[XB_XCNT(j)]); sum += c; cnt += (c > 0u) ? 1u : 0u; mine = (j == x) ? c : mine; }
        if (sum == G) break;
        __builtin_amdgcn_s_sleep(1);
        if ((++sp & 255u) == 0u) { if (xb_ld(&bar[XB_TMO])) break; if (sp > XB_SPIN_CAP) { atomicAdd(&bar[XB_TMO], 1u); break; } }
    }
    nloc = mine > 0u ? mine : 1u; nx = cnt > 0u ? cnt : 1u;
}

__device__ __forceinline__ void xcd_barrier(const XcdBarrier& b) {
    asm volatile("s_waitcnt vmcnt(0)" ::: "memory");
    __syncthreads();
    if (threadIdx.x == 0) {
        unsigned* bar = b.bar;
        __builtin_amdgcn_s_waitcnt(0);
        unsigned nloc = b.st[0], nx = b.st[1];
        if (nloc == 0u) { xcd_barrier_complete(bar, b.x, nloc, nx); b.st[0] = nloc; b.st[1] = nx; }
        const unsigned old = xb_add(&bar[XB_XSUB(b.x)], 1u);
        const unsigned gen = old / nloc;
        if (old + 1u == (gen + 1u) * nloc) {
            __builtin_amdgcn_fence(__ATOMIC_RELEASE, "agent");
            asm volatile("s_waitcnt vmcnt(0)" ::: "memory");
            const unsigned og = xb_add(&bar[XB_TOP], 1u);
            const unsigned tg = og / nx;
            if (og + 1u == (tg + 1u) * nx) xb_add(&bar[XB_TOPGEN], 1u);
            else XB_SPIN(xb_ld(&bar[XB_TOPGEN]) == tg, bar);
            __builtin_amdgcn_fence(__ATOMIC_ACQUIRE, "agent");
            xb_add(&bar[XB_XGEN(b.x)], 1u);
            asm volatile("s_waitcnt vmcnt(0)" ::: "memory");
        } else {
            XB_SPIN(xb_ld(&bar[XB_XGEN(b.x)]) == gen, bar);
            __builtin_amdgcn_fence(__ATOMIC_ACQUIRE, "agent");
            asm volatile("s_waitcnt vmcnt(0)" ::: "memory");
        }
    }
    __syncthreads();
}


#define PROBE_PHASE -1
#define PROBE_A 0
#define PROBE_B 1
#define STAMP(i) do { if (PROBE_PHASE >= 0 && blockIdx.x == 0 && threadIdx.x == 0) *(volatile LAS unsigned long long*)(lds + LDSCTL_OFF + 64 + 8 * (i)) = __builtin_amdgcn_s_memrealtime(); } while (0)
typedef float f32x16 __attribute__((ext_vector_type(16)));
typedef short s16x4 __attribute__((ext_vector_type(4)));
typedef unsigned u32x2 __attribute__((ext_vector_type(2)));
typedef float f32x2 __attribute__((ext_vector_type(2)));
__device__ __forceinline__ float wave_sum(float v) {
#pragma unroll
    for (int o = 1; o < 64; o <<= 1) v += __shfl_xor(v, o);
    return v;
}
__device__ __forceinline__ float partner32(float v) { return __shfl_xor(v, 32); }
__device__ __forceinline__ int partner32i(int v) { return __shfl_xor(v, 32); }
__device__ __forceinline__ int crow(int r, int hi) { return (r & 3) + 8 * (r >> 2) + 4 * hi; }
__device__ __forceinline__ float bflo(unsigned w) { return __uint_as_float(w << 16); }
__device__ __forceinline__ float bfhi(unsigned w) { return __uint_as_float(w & 0xffff0000u); }
__device__ __forceinline__ unsigned cvtpk(float lo, float hi) { unsigned r; asm volatile("v_cvt_pk_bf16_f32 %0, %1, %2" : "=v"(r) : "v"(lo), "v"(hi)); return r; }

struct TrItem { const float* W; bf16* WT; const float* kscale; int K, N, k0, n0; };
__device__ __forceinline__ void tr_load(const TrItem& it, f32x4 (&v)[8], int lane) {
    const int rr = lane >> 3, ch = lane & 7;
#pragma unroll
    for (int i = 0; i < 8; ++i) v[i] = *(const f32x4*)(it.W + (size_t)(it.k0 + rr + 8 * i) * it.N + it.n0 + 4 * ch);
}
__device__ __forceinline__ void tr_finish(const TrItem& it, f32x4 (&v)[8], LAS float* scr, int lane) {
    const int rr = lane >> 3, ch = lane & 7;
    if (it.kscale) {
#pragma unroll
        for (int i = 0; i < 8; ++i) v[i] = v[i] * it.kscale[it.k0 + rr + 8 * i];
    }
#pragma unroll
    for (int i = 0; i < 8; ++i) { LAS float* p = scr + (rr + 8 * i) * 33 + 4 * ch; p[0] = v[i].x; p[1] = v[i].y; p[2] = v[i].z; p[3] = v[i].w; }
    LDS_WAIT(); asm volatile("" ::: "memory");
    const int c = lane & 7;
#pragma unroll
    for (int j = 0; j < 4; ++j) { const int n = (lane >> 3) + 8 * j; const LAS float* s = scr + (8 * c) * 33 + n;
        v4u o; o.x = pk2(s[0 * 33], s[1 * 33]); o.y = pk2(s[2 * 33], s[3 * 33]); o.z = pk2(s[4 * 33], s[5 * 33]); o.w = pk2(s[6 * 33], s[7 * 33]);
        *(v4u*)(it.WT + (size_t)(it.n0 + n) * it.K + it.k0 + 8 * c) = o; }
    LDS_WAIT(); asm volatile("" ::: "memory");
}
__device__ __forceinline__ float wave_max(float v) {
#pragma unroll
    for (int o = 1; o < 64; o <<= 1) v = fmaxf(v, __shfl_xor(v, o));
    return v;
}
__device__ __forceinline__ void rms_rows2_to_i8(const float* x0, const float* x1, const float* gain, unsigned char* o0, unsigned char* o1, float* sa0, float* sa1, int lane) {
    const f32x4* xa = (const f32x4*)x0 + lane; const f32x4* xb = (const f32x4*)x1 + lane; const f32x4* gr = (const f32x4*)gain + lane;
    f32x4 va[8], vb[8]; float sa = 0.f, sb = 0.f;
#pragma unroll
    for (int j = 0; j < 8; ++j) { va[j] = xa[64 * j]; vb[j] = xb[64 * j]; }
#pragma unroll
    for (int j = 0; j < 8; ++j) { sa += (va[j].x * va[j].x + va[j].y * va[j].y) + (va[j].z * va[j].z + va[j].w * va[j].w); sb += (vb[j].x * vb[j].x + vb[j].y * vb[j].y) + (vb[j].z * vb[j].z + vb[j].w * vb[j].w); }
    const float ia = 1.f / sqrtf(wave_sum(sa) * (1.f / D) + RMS_EPS), ib = 1.f / sqrtf(wave_sum(sb) * (1.f / D) + RMS_EPS);
    float ma = 0.f, mb = 0.f;
#pragma unroll
    for (int j = 0; j < 8; ++j) { const f32x4 g = gr[64 * j]; va[j] = va[j] * g * ia; vb[j] = vb[j] * g * ib;
        ma = fmaxf(ma, fmaxf(fmaxf(fabsf(va[j].x), fabsf(va[j].y)), fmaxf(fabsf(va[j].z), fabsf(va[j].w)))); mb = fmaxf(mb, fmaxf(fmaxf(fabsf(vb[j].x), fabsf(vb[j].y)), fmaxf(fabsf(vb[j].z), fabsf(vb[j].w)))); }
    ma = wave_max(ma); mb = wave_max(mb);
    const float qa = ma > 0.f ? 127.f / ma : 0.f, qb = mb > 0.f ? 127.f / mb : 0.f;
    unsigned* pa = (unsigned*)o0 + lane; unsigned* pb = (unsigned*)o1 + lane;
#pragma unroll
    for (int j = 0; j < 8; ++j) {
        pa[64 * j] = (unsigned)((int)rintf(va[j].x * qa) & 255) | ((unsigned)((int)rintf(va[j].y * qa) & 255) << 8) | ((unsigned)((int)rintf(va[j].z * qa) & 255) << 16) | ((unsigned)((int)rintf(va[j].w * qa) & 255) << 24);
        pb[64 * j] = (unsigned)((int)rintf(vb[j].x * qb) & 255) | ((unsigned)((int)rintf(vb[j].y * qb) & 255) << 8) | ((unsigned)((int)rintf(vb[j].z * qb) & 255) << 16) | ((unsigned)((int)rintf(vb[j].w * qb) & 255) << 24); }
    if (lane == 0) { *sa0 = ma * (1.f / 127.f); *sa1 = mb * (1.f / 127.f); }
}
__device__ __forceinline__ void tr_finish_i8(const TrItem& it, f32x4 (&v)[8], const float* colmax, LAS float* scr, int lane) {
    const int rr = lane >> 3, ch = lane & 7;
#pragma unroll
    for (int i = 0; i < 8; ++i) { LAS float* p = scr + (rr + 8 * i) * 33 + 4 * ch; p[0] = v[i].x; p[1] = v[i].y; p[2] = v[i].z; p[3] = v[i].w; }
    LDS_WAIT(); asm volatile("" ::: "memory");
    const int c = lane & 3;
#pragma unroll
    for (int j = 0; j < 2; ++j) { const int n = (lane >> 2) + 16 * j; const LAS float* s = scr + (16 * c) * 33 + n;
        const float cm = colmax[it.n0 + n]; const float q = cm > 0.f ? 127.f / cm : 0.f;
        unsigned w[4];
#pragma unroll
        for (int d = 0; d < 4; ++d) w[d] = (unsigned)((int)rintf(s[(4 * d) * 33] * q) & 255) | ((unsigned)((int)rintf(s[(4 * d + 1) * 33] * q) & 255) << 8) | ((unsigned)((int)rintf(s[(4 * d + 2) * 33] * q) & 255) << 16) | ((unsigned)((int)rintf(s[(4 * d + 3) * 33] * q) & 255) << 24);
        *(v4u*)((unsigned char*)it.WT + (size_t)(it.n0 + n) * it.K + it.k0 + 16 * c) = (v4u){w[0], w[1], w[2], w[3]}; }
    LDS_WAIT(); asm volatile("" ::: "memory");
}

struct Ptrs {
    const float *x, *norm_mix, *w_in, *conv_w, *w_conv_out, *w_attn_out, *w_out, *norm_ffn, *peer_wq, *peer_sk, *peer_u, *peer_v, *norm_final;
    float* out; unsigned char* ws;
};

__device__ __forceinline__ void p0_prologue(const Ptrs& P, LAS unsigned char* lds, int vcu, int G, int wave, int lane, int tid) {
    LAS float* scr = (LAS float*)(lds + RING_OFF + wave * 16384);
    const int gw = vcu * NWAVES + wave, NGW = G * NWAVES;
    bf16* WCO = (bf16*)(P.ws + WS_WCO); bf16* WAO = (bf16*)(P.ws + WS_WAO); bf16* WO = (bf16*)(P.ws + WS_WO); bf16* WQ = (bf16*)(P.ws + WS_WQ);
    constexpr int I_CO = (CW / 64) * (D / 32), I_AO = (AW / 64) * (D / 32), I_O = (D / 64) * (D / 32), I_Q = I_O;
    constexpr int NITEMS = I_CO + I_AO + I_O + I_Q;
    auto mk = [&](int it) {
        TrItem t; int r = it, K, N;
        if (r < I_CO) { t.W = P.w_conv_out; t.WT = WCO; t.kscale = nullptr; K = CW; N = D; }
        else if ((r -= I_CO) < I_AO) { t.W = P.w_attn_out; t.WT = WAO; t.kscale = nullptr; K = AW; N = D; }
        else if ((r -= I_AO) < I_O) { t.W = P.w_out; t.WT = WO; t.kscale = nullptr; K = D; N = D; }
        else { r -= I_O; t.W = P.peer_wq; t.WT = WQ; t.kscale = P.norm_ffn; K = D; N = D; }
        const int nblk = N / 32; t.K = K; t.N = N; t.k0 = 64 * (r / nblk); t.n0 = 32 * (r % nblk); return t; };
    {
        f32x4 va[8], vb[8];
        int it = gw;
        if (it < NITEMS) { const TrItem a = mk(it); tr_load(a, va, lane); }
        for (; it < NITEMS; it += 2 * NGW) {
            const TrItem a = mk(it);
            const bool hb = it + NGW < NITEMS; TrItem b = a; if (hb) { b = mk(it + NGW); tr_load(b, vb, lane); }
            tr_finish(a, va, scr, lane);
            if (it + 2 * NGW < NITEMS) { const TrItem c = mk(it + 2 * NGW); tr_load(c, va, lane); }
            if (hb) tr_finish(b, vb, scr, lane);
        }
    }
    unsigned char* XN = P.ws + WS_XN; float* SA = (float*)(P.ws + WS_SA);
    for (int m = gw; m < T / 2; m += NGW) rms_rows2_to_i8(P.x + (size_t)(2 * m) * D, P.x + (size_t)(2 * m + 1) * D, P.norm_mix, XN + (size_t)(2 * m) * D, XN + (size_t)(2 * m + 1) * D, SA + 2 * m, SA + 2 * m + 1, lane);
    {
        unsigned char* UQ = P.ws + WS_UQ; float* SU = (float*)(P.ws + WS_SU);
        const float* gr = P.norm_ffn + 4 * lane;
        for (int e2 = gw; e2 < NEXP / 2; e2 += NGW) {
            f32x4 v[2][8];
#pragma unroll
            for (int h = 0; h < 2; ++h)
#pragma unroll
                for (int j = 0; j < 8; ++j) v[h][j] = *(const f32x4*)(P.peer_u + (size_t)(2 * e2 + h) * D + 4 * lane + 256 * j);
#pragma unroll
            for (int j = 0; j < 8; ++j) { const f32x4 gg = *(const f32x4*)(gr + 256 * j); v[0][j] = v[0][j] * gg; v[1][j] = v[1][j] * gg; }
#pragma unroll
            for (int h = 0; h < 2; ++h) {
                const int e = 2 * e2 + h, g = egroup(e), r = erow(e);
#pragma unroll
                for (int j = 0; j < 8; ++j) {
                    float m = fmaxf(fmaxf(fabsf(v[h][j].x), fabsf(v[h][j].y)), fmaxf(fabsf(v[h][j].z), fabsf(v[h][j].w)));
                    m = fmaxf(m, __shfl_xor(m, 1)); m = fmaxf(m, __shfl_xor(m, 2)); m = fmaxf(m, __shfl_xor(m, 4)); m = fmaxf(m, __shfl_xor(m, 8)); m = fmaxf(m, __shfl_xor(m, 16));
                    const float inv = m > 0.f ? 127.f / m : 0.f;
                    const int q0 = (int)rintf(v[h][j].x * inv), q1 = (int)rintf(v[h][j].y * inv), q2 = (int)rintf(v[h][j].z * inv), q3 = (int)rintf(v[h][j].w * inv);
                    const unsigned w = (unsigned)(q0 & 255) | ((unsigned)(q1 & 255) << 8) | ((unsigned)(q2 & 255) << 16) | ((unsigned)(q3 & 255) << 24);
                    const int sl = 2 * j + (lane >> 5), role = g * NS + sl;
                    *(unsigned*)(UQ + ((size_t)role * EG + r) * DW + 4 * (lane & 31)) = w;
                    if ((lane & 31) == 0) SU[role * EG + r] = m * (1.f / 127.f);
                }
            }
        }
    }
    {
        const int gt = (vcu * NWAVES + wave) * 64 + lane, NGT = G * NWAVES * 64;
        bf16* SK = (bf16*)(P.ws + WS_SK);
        for (int it = gt; it < 2 * PKEYS * PHALF; it += NGT) SK[it] = (bf16)f2bf(P.peer_sk[it]);
    }
    {
        LAS unsigned char* tile = lds + RING_OFF;
        unsigned char* VQ = P.ws + WS_VQ;
        __syncthreads();
        for (int b = vcu; b < NEXP / 32; b += G) {
            const int e0 = b * 32;
#pragma unroll
            for (int i = 0; i < 4; ++i) {
                const int er = wave * 4 + i; const float* vr = P.peer_v + (size_t)(e0 + er) * D + 4 * lane;
#pragma unroll
                for (int j = 0; j < 8; ++j) {
                    const f32x4 v = *(const f32x4*)(vr + 256 * j);
                    int w = 0; w = __builtin_amdgcn_cvt_pk_fp8_f32(v.x, v.y, w, false); w = __builtin_amdgcn_cvt_pk_fp8_f32(v.z, v.w, w, true);
                    const int c = (lane >> 1) + 32 * j;
                    *(LAS int*)(tile + (c * 33 + er) * 8 + 4 * (lane & 1)) = w;
                }
            }
            __syncthreads();
#pragma unroll 4
            for (int k = 0; k < 16; ++k) {
                const int c = wave * 32 + 2 * k + (lane >> 5), er = lane & 31;
                const u32x2 q = *(const LAS u32x2*)(tile + (c * 33 + er) * 8);
                *(u32x2*)(VQ + ((size_t)c * NEXP + e0 + er) * 8) = q;
            }
            __syncthreads();
        }
    }
    {
        unsigned* CM = (unsigned*)(P.ws + WS_CTL) + CW_COLMAX;
        constexpr int NCB = INW / 256;
        for (int it = gw; it < (D / 64) * NCB; it += NGW) {
            const int kb = it / NCB, cb = it % NCB; const float* src = P.w_in + (size_t)(64 * kb) * INW + 256 * cb + 4 * lane;
            f32x4 m = (f32x4){0.f, 0.f, 0.f, 0.f};
#pragma unroll 16
            for (int r = 0; r < 64; ++r) { const f32x4 v = *(const f32x4*)(src + (size_t)r * INW); m.x = fmaxf(m.x, fabsf(v.x)); m.y = fmaxf(m.y, fabsf(v.y)); m.z = fmaxf(m.z, fabsf(v.z)); m.w = fmaxf(m.w, fabsf(v.w)); }
            unsigned* d = CM + 256 * cb + 4 * lane;
            atomicMax(d, __float_as_uint(m.x)); atomicMax(d + 1, __float_as_uint(m.y)); atomicMax(d + 2, __float_as_uint(m.z)); atomicMax(d + 3, __float_as_uint(m.w));
        }
    }
}

__device__ __forceinline__ void p0_win_i8(const Ptrs& P, LAS unsigned char* lds, int vcu, int G, int wave, int lane) {
    LAS float* scr = (LAS float*)(lds + RING_OFF + wave * 16384);
    const int gw = vcu * NWAVES + wave, NGW = G * NWAVES;
    const float* CM = (const float*)((const unsigned*)(P.ws + WS_CTL) + CW_COLMAX);
    constexpr int NITEMS = (D / 64) * (INW / 32);
    auto mk = [&](int it) { TrItem t; t.W = P.w_in; t.WT = (bf16*)(P.ws + WS_WIN); t.kscale = nullptr; t.K = D; t.N = INW; t.k0 = 64 * (it & 31); t.n0 = 32 * (it >> 5); return t; };
    f32x4 va[8], vb[8];
    int it = gw;
    if (it < NITEMS) { const TrItem a = mk(it); tr_load(a, va, lane); }
    for (; it < NITEMS; it += 2 * NGW) {
        const TrItem a = mk(it);
        const bool hb = it + NGW < NITEMS; TrItem b = a; if (hb) { b = mk(it + NGW); tr_load(b, vb, lane); }
        tr_finish_i8(a, va, CM, scr, lane);
        if (it + 2 * NGW < NITEMS) { const TrItem c = mk(it + 2 * NGW); tr_load(c, va, lane); }
        if (hb) tr_finish_i8(b, vb, CM, scr, lane);
    }
}

__device__ __forceinline__ void p2_conv(const Ptrs& P, int gt, int NGT) {
    const bf16* PROJ = (const bf16*)(P.ws + WS_PROJ); bf16* YC = (bf16*)(P.ws + WS_YC);
    constexpr int NIT = (T / 8) * (CW / 8);
    for (int it = gt; it < NIT; it += NGT) {
        const int ch = it % (CW / 8), tb = it / (CW / 8), c0 = ch * 8, t0 = tb * 8;
        float w0[8], w1[8], w2[8];
#pragma unroll
        for (int i = 0; i < 8; ++i) { w0[i] = P.conv_w[c0 + i]; w1[i] = P.conv_w[CW + c0 + i]; w2[i] = P.conv_w[2 * CW + c0 + i]; }
        float zm2[8], zm1[8];
#pragma unroll
        for (int i = 0; i < 8; ++i) { zm2[i] = 0.f; zm1[i] = 0.f; }
#pragma unroll
        for (int dt = -2; dt < 8; ++dt) {
            const int t = t0 + dt; if (t < 0) continue;
            const v4u cc = *(const v4u*)(PROJ + (size_t)t * INW + C_CC + c0), hh = *(const v4u*)(PROJ + (size_t)t * INW + C_CH + c0);
            float z[8];
            z[0] = bflo(cc.x) * bflo(hh.x); z[1] = bfhi(cc.x) * bfhi(hh.x); z[2] = bflo(cc.y) * bflo(hh.y); z[3] = bfhi(cc.y) * bfhi(hh.y);
            z[4] = bflo(cc.z) * bflo(hh.z); z[5] = bfhi(cc.z) * bfhi(hh.z); z[6] = bflo(cc.w) * bflo(hh.w); z[7] = bfhi(cc.w) * bfhi(hh.w);
            if (dt >= 0) {
                const v4u cb = *(const v4u*)(PROJ + (size_t)t * INW + C_CB + c0);
                float b[8] = {bflo(cb.x), bfhi(cb.x), bflo(cb.y), bfhi(cb.y), bflo(cb.z), bfhi(cb.z), bflo(cb.w), bfhi(cb.w)};
                float y[8];
#pragma unroll
                for (int i = 0; i < 8; ++i) y[i] = b[i] * (w0[i] * zm2[i] + w1[i] * zm1[i] + w2[i] * z[i]);
                v4u o; o.x = pk2(y[0], y[1]); o.y = pk2(y[2], y[3]); o.z = pk2(y[4], y[5]); o.w = pk2(y[6], y[7]);
                *(v4u*)(YC + (size_t)t * CW + c0) = o;
            }
#pragma unroll
            for (int i = 0; i < 8; ++i) { zm2[i] = zm1[i]; zm1[i] = z[i]; }
        }
    }
}

__device__ __forceinline__ s16x4 vtr(LAS const unsigned char* p) { typedef short v4i16_t __attribute__((ext_vector_type(4))); return __builtin_bit_cast(s16x4, __builtin_amdgcn_ds_read_tr16_b64_v4i16((LAS v4i16_t*)p)); }

__device__ __forceinline__ void attn_task(const bf16* PROJ, bf16* YA, LAS unsigned char* vl  , int qt, int h, int lane) {
    const int r32 = lane & 31, hi = lane >> 5, q0 = qt * 32;
    const bf16* Qp = PROJ + (size_t)(q0 + r32) * INW + C_Q + h * HD + 8 * hi;
    bf16x8 qf[4];
#pragma unroll
    for (int s = 0; s < 4; ++s) qf[s] = *(const bf16x8*)(Qp + 16 * s);
    float carry = 1.f;
    f32x16 o0, o1;
#pragma unroll
    for (int r = 0; r < 16; ++r) { o0[r] = 0.f; o1[r] = 0.f; }
    const int g1 = (lane >> 4) & 1, qq = (lane & 15) >> 2, pp = lane & 3;
    LAS const unsigned char* vrd = vl + (4 * hi + qq) * 128 + g1 * 32 + pp * 8;
    for (int kt = qt; kt >= 0; --kt) {
        const int k0 = kt * 32;
        const bf16* Kp = PROJ + (size_t)(k0 + r32) * INW + C_K + h * HD + 8 * hi;
        bf16x8 kf[4];
#pragma unroll
        for (int s = 0; s < 4; ++s) kf[s] = *(const bf16x8*)(Kp + 16 * s);
        v4u vv[4];
#pragma unroll
        for (int i = 0; i < 4; ++i) { const int c = lane + 64 * i, row = c >> 3, chn = c & 7; vv[i] = *(const v4u*)(PROJ + (size_t)(k0 + row) * INW + C_V + h * HD + chn * 8); }
        f32x16 S;
#pragma unroll
        for (int r = 0; r < 16; ++r) S[r] = 0.f;
#pragma unroll
        for (int s = 0; s < 4; ++s) S = __builtin_amdgcn_mfma_f32_32x32x16_bf16(kf[s], qf[s], S, 0, 0, 0);
#pragma unroll
        for (int i = 0; i < 4; ++i) { const int c = lane + 64 * i, row = c >> 3, chn = c & 7; *(LAS v4u*)(vl + row * 128 + chn * 16) = vv[i]; }
        float kp[16], bt[16];
        const float cs = 0.125f * 1.4426950408889634f;
#pragma unroll
        for (int r = 0; r < 16; ++r) { const float a = fminf(S[r] * cs, 126.f); const float e = __builtin_amdgcn_exp2f(a); const float ri = __builtin_amdgcn_rcpf(1.f + e); kp[r] = ri; bt[r] = e * ri; }
        if (kt == qt) {
#pragma unroll
            for (int r = 0; r < 16; ++r) { if (crow(r, hi) >= r32) { kp[r] = 1.f; bt[r] = 0.f; } }
        }
        float Pm[4], Qm[4], Tt[4];
#pragma unroll
        for (int i = 0; i < 4; ++i) { Pm[i] = (kp[4 * i] * kp[4 * i + 1]) * (kp[4 * i + 2] * kp[4 * i + 3]); Qm[i] = partner32(Pm[i]); Tt[i] = Pm[i] * Qm[i]; }
        float R[4]; R[3] = 1.f; R[2] = Tt[3]; R[1] = Tt[3] * Tt[2]; R[0] = R[1] * Tt[1];
        const float total = R[0] * Tt[0];
        float w[16];
#pragma unroll
        for (int i = 0; i < 4; ++i) {
            const float base = carry * R[i] * (hi ? 1.f : Qm[i]);
            const float x3 = base, x2 = x3 * kp[4 * i + 3], x1 = x2 * kp[4 * i + 2], x0 = x1 * kp[4 * i + 1];
            w[4 * i + 3] = bt[4 * i + 3] * x3; w[4 * i + 2] = bt[4 * i + 2] * x2; w[4 * i + 1] = bt[4 * i + 1] * x1; w[4 * i] = bt[4 * i] * x0;
        }
        carry *= total;
        v4u wa0, wa1;
        wa0.x = cvtpk(w[0], w[1]); wa0.y = cvtpk(w[2], w[3]); wa0.z = cvtpk(w[4], w[5]); wa0.w = cvtpk(w[6], w[7]);
        wa1.x = cvtpk(w[8], w[9]); wa1.y = cvtpk(w[10], w[11]); wa1.z = cvtpk(w[12], w[13]); wa1.w = cvtpk(w[14], w[15]);
        asm volatile("s_waitcnt lgkmcnt(0)" ::: "memory");
        s16x4 l00 = vtr(vrd + 0 * 64 + 0 * 2048), h00 = vtr(vrd + 0 * 64 + 0 * 2048 + 1024);
        s16x4 l01 = vtr(vrd + 0 * 64 + 1 * 2048), h01 = vtr(vrd + 0 * 64 + 1 * 2048 + 1024);
        s16x4 l10 = vtr(vrd + 1 * 64 + 0 * 2048), h10 = vtr(vrd + 1 * 64 + 0 * 2048 + 1024);
        s16x4 l11 = vtr(vrd + 1 * 64 + 1 * 2048), h11 = vtr(vrd + 1 * 64 + 1 * 2048 + 1024);
        asm volatile("s_waitcnt lgkmcnt(0)" ::: "memory");
#define PKV(l, hh) (bf16x8){l[0], l[1], l[2], l[3], hh[0], hh[1], hh[2], hh[3]}
        o0 = __builtin_amdgcn_mfma_f32_32x32x16_bf16(__builtin_bit_cast(bf16x8, wa0), PKV(l00, h00), o0, 0, 0, 0);
        o0 = __builtin_amdgcn_mfma_f32_32x32x16_bf16(__builtin_bit_cast(bf16x8, wa1), PKV(l01, h01), o0, 0, 0, 0);
        o1 = __builtin_amdgcn_mfma_f32_32x32x16_bf16(__builtin_bit_cast(bf16x8, wa0), PKV(l10, h10), o1, 0, 0, 0);
        o1 = __builtin_amdgcn_mfma_f32_32x32x16_bf16(__builtin_bit_cast(bf16x8, wa1), PKV(l11, h11), o1, 0, 0, 0);
#undef PKV
        if (__all(carry < 1e-30f)) break;
    }
    bf16* Op = YA + (size_t)q0 * AW + h * HD + r32;
#pragma unroll
    for (int r = 0; r < 16; ++r) { const int qr = crow(r, hi); Op[(size_t)qr * AW] = (bf16)f2bf(o0[r]); Op[(size_t)qr * AW + 32] = (bf16)f2bf(o1[r]); }
}

template <int N> __device__ __forceinline__ float tree_max(const float (&v)[N]) {
    float t[N];
#pragma unroll
    for (int i = 0; i < N; ++i) t[i] = v[i];
#pragma unroll
    for (int w = N; w > 1; w = (w + 2) / 3) {
#pragma unroll
        for (int i = 0; i < (w + 2) / 3; ++i) { const float a = t[3 * i], b = (3 * i + 1 < w) ? t[3 * i + 1] : a, c = (3 * i + 2 < w) ? t[3 * i + 2] : a; t[i] = fmaxf(fmaxf(a, b), c); }
    }
    return t[0];
}
template <int N> __device__ __forceinline__ float take_max(float (&v)[N]) {
    const float m = tree_max<N>(v);
    const float g = fmaxf(m, partner32(m));
#pragma unroll
    for (int i = 0; i < N; ++i) v[i] = (v[i] == g) ? -INFINITY : v[i];
    return g;
}
struct constexpr_ij { int i, j; };
__host__ __device__ constexpr constexpr_ij cand_ij(int k) {
    int n = 0;
    for (int i = 0; i < 16; ++i) for (int j = 0; j < 16; ++j) if ((i + 1) * (j + 1) <= 16) { if (n == k) return constexpr_ij{i, j}; ++n; }
    return constexpr_ij{0, 0};
}
__device__ __forceinline__ void topk_task(const bf16* QP, const bf16* SK, int* IDX, float* GATE, int tt, int h, int lane) {
    const int r32 = lane & 31, hi = lane >> 5, t = tt * 32 + r32;
    float top[2][16];
#pragma unroll
    for (int side = 0; side < 2; ++side) {
        const bf16* Qp = QP + (size_t)t * D + h * PQD + side * PHALF + 8 * hi;
        bf16x8 qf[8];
#pragma unroll
        for (int s = 0; s < 8; ++s) qf[s] = *(const bf16x8*)(Qp + 16 * s);
        float sc[64];
#pragma unroll
        for (int kb = 0; kb < 4; ++kb) {
            const bf16* Kp = SK + (size_t)(side * PKEYS + kb * 32 + r32) * PHALF + 8 * hi;
            asm volatile("" : "+v"(Kp));
            f32x16 S;
#pragma unroll
            for (int r = 0; r < 16; ++r) S[r] = 0.f;
#pragma unroll
            for (int s = 0; s < 8; ++s) { const bf16x8 kf = *(const bf16x8*)(Kp + 16 * s); S = __builtin_amdgcn_mfma_f32_32x32x16_bf16(kf, qf[s], S, 0, 0, 0); }
#pragma unroll
            for (int r = 0; r < 16; ++r) { const unsigned key = (unsigned)(kb * 32 + crow(r, hi)); sc[kb * 16 + r] = __uint_as_float((__float_as_uint(S[r]) & ~127u) | (127u - key)); }
            asm volatile("" ::: "memory");
        }
#pragma unroll
        for (int k = 0; k < 16; ++k) top[side][k] = take_max<64>(sc);
        asm volatile("" ::: "memory");
    }
    asm volatile("" ::: "memory");
    float cv[25]; int ci[25];
#pragma unroll
    for (int k = 0; k < 25; ++k) {
        constexpr_ij c0 = cand_ij(k), c1 = cand_ij(k + 25);
        const float a = hi ? top[0][c1.i] : top[0][c0.i], b = hi ? top[1][c1.j] : top[1][c0.j];
        const float s = a + b;
        cv[k] = __uint_as_float((__float_as_uint(s) & ~63u) | (unsigned)(hi ? 63 - (k + 25) : 63 - k));
        ci[k] = (int)(127u - (__float_as_uint(a) & 127u)) * PKEYS + (int)(127u - (__float_as_uint(b) & 127u));
    }
    float sv[16]; int si[16];
#pragma unroll
    for (int k = 0; k < 16; ++k) {
        const float m = tree_max<25>(cv);
        const float g = fmaxf(m, partner32(m));
        int id = 0;
#pragma unroll
        for (int i = 0; i < 25; ++i) { const bool hit = (cv[i] == g); id = hit ? ci[i] : id; cv[i] = hit ? -INFINITY : cv[i]; }
        const int pid = partner32i(id);
        sv[k] = g; si[k] = id > pid ? id : pid;
    }
    float ex[16], sum = 0.f;
#pragma unroll
    for (int k = 0; k < 16; ++k) { ex[k] = __expf(sv[k] - sv[0]); sum += ex[k]; }
    const float rs = 1.f / sum;
    if (!hi) {
        int* ip = IDX + (size_t)t * NPAIR + h * PTOPK;
#pragma unroll
        for (int k = 0; k < 16; k += 4) *(int4*)(ip + k) = make_int4(si[k], si[k + 1], si[k + 2], si[k + 3]);
    } else {
        float* gp = GATE + (size_t)t * NPAIR + h * PTOPK;
#pragma unroll
        for (int k = 0; k < 16; k += 4) *(f32x4*)(gp + k) = (f32x4){ex[k] * rs, ex[k + 1] * rs, ex[k + 2] * rs, ex[k + 3] * rs};
    }
}

struct SortIn { int id0, id1; float g0, g1; v4u x[4]; float ssq; };
__device__ __forceinline__ void sortq_load(SortIn& in, const bf16* X1B, const float* SSQ, const int* IDX, const float* GATE, int t, int lane) {
    in.id0 = IDX[(size_t)t * NPAIR + lane]; in.id1 = IDX[(size_t)t * NPAIR + 64 + lane];
    in.g0 = GATE[(size_t)t * NPAIR + lane]; in.g1 = GATE[(size_t)t * NPAIR + 64 + lane];
    const v4u* xr = (const v4u*)(X1B + (size_t)t * D) + lane;
#pragma unroll
    for (int j = 0; j < 4; ++j) in.x[j] = xr[64 * j];
    in.ssq = SSQ[t];
}
__device__ __forceinline__ void sortq_token(const SortIn& in, unsigned short* ES, unsigned short* ESG, float* GS, unsigned short* OFFN, float* SXS, unsigned char* XQ, int t, int lane) {
    const int id0 = in.id0, id1 = in.id1; const float g0 = in.g0, g1 = in.g1;
    const int k0 = egroup(id0), k1 = egroup(id1);
    int off = 0, pos0 = 0, pos1 = 0, myoffn = 0, rk0 = 0, rk1 = 0;
#pragma unroll
    for (int g = 0; g < NG; ++g) {
        const unsigned long long m0 = __ballot(k0 == g), m1 = __ballot(k1 == g);
        const int c0 = __popcll(m0), c1 = __popcll(m1);
        const int r0 = __builtin_amdgcn_mbcnt_hi((unsigned)(m0 >> 32), __builtin_amdgcn_mbcnt_lo((unsigned)m0, 0));
        const int r1 = __builtin_amdgcn_mbcnt_hi((unsigned)(m1 >> 32), __builtin_amdgcn_mbcnt_lo((unsigned)m1, 0));
        if (k0 == g) { pos0 = off + r0; rk0 = r0; }
        if (k1 == g) { pos1 = off + c0 + r1; rk1 = c0 + r1; }
        if (lane == g) myoffn = off | ((c0 + c1) << 8);
        off += c0 + c1;
    }
    ES[(size_t)t * NPAIR + pos0] = (unsigned short)id0; ES[(size_t)t * NPAIR + pos1] = (unsigned short)id1;
    if (rk0 < 16) ESG[((size_t)t * NG + k0) * 16 + rk0] = (unsigned short)id0;
    if (rk1 < 16) ESG[((size_t)t * NG + k1) * 16 + rk1] = (unsigned short)id1;
    GS[(size_t)t * NPAIR + pos0] = g0; GS[(size_t)t * NPAIR + pos1] = g1;
    if (lane < NG) OFFN[(size_t)t * NG + lane] = (unsigned short)myoffn;
    const float inv_rms = 1.0f / sqrtf(in.ssq * (1.f / D) + RMS_EPS);
#pragma unroll
    for (int j = 0; j < 4; ++j) {
        const v4u xv = in.x[j];
        float f[8] = {bflo(xv.x), bfhi(xv.x), bflo(xv.y), bfhi(xv.y), bflo(xv.z), bfhi(xv.z), bflo(xv.w), bfhi(xv.w)};
        float m = 0.f;
#pragma unroll
        for (int i = 0; i < 8; ++i) m = fmaxf(m, fabsf(f[i]));
        m = fmaxf(m, __shfl_xor(m, 1)); m = fmaxf(m, __shfl_xor(m, 2)); m = fmaxf(m, __shfl_xor(m, 4)); m = fmaxf(m, __shfl_xor(m, 8));
        const float inv = m > 0.f ? 127.f / m : 0.f;
        unsigned w0 = 0, w1 = 0;
#pragma unroll
        for (int i = 0; i < 4; ++i) { w0 |= ((unsigned)((int)rintf(f[i] * inv) & 255)) << (8 * i); w1 |= ((unsigned)((int)rintf(f[4 + i] * inv) & 255)) << (8 * i); }
        *(u32x2*)(XQ + (size_t)t * D + 512 * j + 8 * lane) = (u32x2){w0, w1};
        if ((lane & 15) == 0) SXS[(size_t)t * NS + 4 * j + (lane >> 4)] = m * (1.f / 127.f) * inv_rms;
    }
}

#define U_DPPDOT(C) asm volatile("v_dot4c_i32_i8_dpp %0, %4, %8 row_ror:" #C " row_mask:0xf bank_mask:0xf\n\tv_dot4c_i32_i8_dpp %1, %5, %9 row_ror:" #C " row_mask:0xf bank_mask:0xf\n\t" \
        "v_dot4c_i32_i8_dpp %2, %6, %10 row_ror:" #C " row_mask:0xf bank_mask:0xf\n\tv_dot4c_i32_i8_dpp %3, %7, %11 row_ror:" #C " row_mask:0xf bank_mask:0xf" \
        : "+v"(a0_), "+v"(a1_), "+v"(a2_), "+v"(a3_) : "v"(xv_.x), "v"(xv_.y), "v"(xv_.z), "v"(xv_.w), "v"(tb_[C].x), "v"(tb_[C].y), "v"(tb_[C].z), "v"(tb_[C].w))
__device__ __forceinline__ void peer_u_role(const unsigned char* UQ, const float* SU, const unsigned char* XQ, const float* SXS, const unsigned short* ES, const unsigned short* ESG, const unsigned short* OFFN, float* PART,
                                            LAS unsigned char* lds, int role, int wave, int lane, int tid) {
    const int s = role & (NS - 1), g = role >> 4;
    __syncthreads();
    {
        const v4u* src = (const v4u*)(UQ + (size_t)role * EG * DW);
#pragma unroll 4
        for (int i = tid; i < EG * DW / 16; i += NWAVES * 64) *(LAS v4u*)(lds + (size_t)i * 16) = src[i];
        const float* ssrc = SU + (size_t)role * EG;
        for (int i = tid; i < EG; i += NWAVES * 64) *(LAS float*)(lds + LDS_SU_OFF + i * 4) = ssrc[i];
    }
    __syncthreads();
    STAMP(20);
    const int ts = lane >> 4, k = lane & 15, cid = lane & 7;
    float* part = PART + (size_t)s * T * NPAIR;
    int coff[8];
#pragma unroll
    for (int c_ = 0; c_ < 8; ++c_) coff[c_] = ((cid - c_) & 7) * 16;
    const unsigned tt0 = (unsigned)(4 * wave + ts);
    unsigned o_of = (tt0 * NG + g) * 2u, o_e = ((tt0 * NG + g) * 16u + k) * 2u, o_x = tt0 * D + s * DW + 16u * cid, o_s = (tt0 * NS + s) * 4u;
    const unsigned char* bOF = (const unsigned char*)OFFN; const unsigned char* bE = (const unsigned char*)ESG; const unsigned char* bS = (const unsigned char*)SXS;
#define U_TQ(I) (wave + NWAVES * (I))
#define U_LOAD(I, OF, E, XV, SX) do { OF = *(const unsigned short*)(bOF + o_of); E = *(const unsigned short*)(bE + o_e); XV = *(const v4u*)(XQ + o_x); SX = *(const float*)(bS + o_s); \
        o_of += 4 * NWAVES * NG * 2; o_e += 4 * NWAVES * NG * 32; o_x += 4 * NWAVES * D; o_s += 4 * NWAVES * NS * 4; } while (0)
#define U_DOT(ACC, EV, XV, ACTIVE) do { LAS const unsigned char* rowp_ = lds + erow((int)(EV)) * DW; v4u tb_[8]; const v4u xv_ = (XV); \
        _Pragma("unroll") for (int c_ = 0; c_ < 8; ++c_) tb_[c_] = (v4u){0u, 0u, 0u, 0u}; \
        if (ACTIVE) { _Pragma("unroll") for (int c_ = 0; c_ < 8; ++c_) tb_[c_] = *(const LAS v4u*)(rowp_ + coff[c_]); } \
        int a0_ = 0, a1_ = 0, a2_ = 0, a3_ = 0; \
        asm volatile("s_nop 4\n\tv_dot4c_i32_i8 %0, %4, %8\n\tv_dot4c_i32_i8 %1, %5, %9\n\tv_dot4c_i32_i8 %2, %6, %10\n\tv_dot4c_i32_i8 %3, %7, %11" \
            : "+v"(a0_), "+v"(a1_), "+v"(a2_), "+v"(a3_) : "v"(xv_.x), "v"(xv_.y), "v"(xv_.z), "v"(xv_.w), "v"(tb_[0].x), "v"(tb_[0].y), "v"(tb_[0].z), "v"(tb_[0].w)); \
        U_DPPDOT(1); U_DPPDOT(2); U_DPPDOT(3); U_DPPDOT(4); U_DPPDOT(5); U_DPPDOT(6); U_DPPDOT(7); ACC = (a0_ + a1_) + (a2_ + a3_); } while (0)
#define U_COMP(I, OF, E, XV, SX) do { const int t_ = 4 * U_TQ(I) + ts; const int j0_ = (OF) & 255, n_ = (OF) >> 8; int acc_; U_DOT(acc_, E, XV, k < n_); \
        const float su_ = *(const LAS float*)(lds + LDS_SU_OFF + erow((int)(E)) * 4); \
        if (k < n_) part[(size_t)t_ * NPAIR + j0_ + k] = (float)acc_ * su_ * (SX); } while (0)
    unsigned of0, of1, of2, of3, of4, of5, of6, of7, e0, e1, e2, e3, e4, e5, e6, e7; v4u x0, x1, x2, x3, x4, x5, x6, x7; float s0, s1, s2, s3, s4, s5, s6, s7;
    U_LOAD(0, of0, e0, x0, s0); U_LOAD(1, of1, e1, x1, s1); U_LOAD(2, of2, e2, x2, s2); U_LOAD(3, of3, e3, x3, s3);
#pragma unroll 1
    for (int it = 0; it < T / 4 / NWAVES; it += 8) {
        U_LOAD(it + 4, of4, e4, x4, s4); U_COMP(it, of0, e0, x0, s0); __builtin_amdgcn_sched_barrier(0);
        U_LOAD(it + 5, of5, e5, x5, s5); U_COMP(it + 1, of1, e1, x1, s1); __builtin_amdgcn_sched_barrier(0);
        U_LOAD(it + 6, of6, e6, x6, s6); U_COMP(it + 2, of2, e2, x2, s2); __builtin_amdgcn_sched_barrier(0);
        U_LOAD(it + 7, of7, e7, x7, s7); U_COMP(it + 3, of3, e3, x3, s3); __builtin_amdgcn_sched_barrier(0);
        U_LOAD(it + 8, of0, e0, x0, s0); U_COMP(it + 4, of4, e4, x4, s4); __builtin_amdgcn_sched_barrier(0);
        U_LOAD(it + 9, of1, e1, x1, s1); U_COMP(it + 5, of5, e5, x5, s5); __builtin_amdgcn_sched_barrier(0);
        U_LOAD(it + 10, of2, e2, x2, s2); U_COMP(it + 6, of6, e6, x6, s6); __builtin_amdgcn_sched_barrier(0);
        U_LOAD(it + 11, of3, e3, x3, s3); U_COMP(it + 7, of7, e7, x7, s7); __builtin_amdgcn_sched_barrier(0);
    }
    STAMP(21);
    {
        unsigned ofl[16];
#pragma unroll
        for (int b16 = 0; b16 < 16; ++b16) { const int i_ = b16 * 64 + lane; const int t_l = 4 * (wave + NWAVES * (i_ >> 2)) + (i_ & 3); ofl[b16] = OFFN[(size_t)t_l * NG + g]; }
#pragma unroll
        for (int b16 = 0; b16 < 16; ++b16) {
            const int i_ = b16 * 64 + lane; const int t_l = 4 * (wave + NWAVES * (i_ >> 2)) + (i_ & 3);
            const unsigned of_l = ofl[b16];
            unsigned long long mask = __ballot((of_l >> 8) > 16u);
            while (mask) {
                const int b = __builtin_ctzll(mask); mask &= mask - 1;
                const int t_o = __builtin_amdgcn_readlane(t_l, b); const unsigned of_o = (unsigned)__builtin_amdgcn_readlane((int)of_l, b);
                const int j0_ = of_o & 255, n_ = of_o >> 8;
                const v4u xo = *(const v4u*)(XQ + (size_t)t_o * D + s * DW + 16 * cid); const float so = SXS[(size_t)t_o * NS + s];
                for (int kk = 16 + 16 * ts + k; __any(kk < n_); kk += 64) {
                    const unsigned e2 = (kk < n_) ? ES[(size_t)t_o * NPAIR + j0_ + kk] : 0u; int a2; U_DOT(a2, e2, xo, kk < n_);
                    const float su2 = *(const LAS float*)(lds + LDS_SU_OFF + erow((int)e2) * 4);
                    if (kk < n_) part[(size_t)t_o * NPAIR + j0_ + kk] = (float)a2 * su2 * so;
                }
            }
        }
    }
    STAMP(23);
#undef U_LOAD
#undef U_TQ
#undef U_DOT
#undef U_COMP
}

__device__ __forceinline__ void peer_reduce_tile(const float* PART, const float* GS, const unsigned short* ES, unsigned* LIST, LAS unsigned char* lds, int tile, int tid) {
    const int t0 = tile * 32;
    const int tloc = tid >> 4, jb = (tid & 15) * 8; const size_t base = (size_t)(t0 + tloc) * NPAIR + jb;
    f32x4 h0 = (f32x4){0.f, 0.f, 0.f, 0.f}, h1 = h0;
#pragma unroll
    for (int sl = 0; sl < NS; ++sl) { const float* p = PART + (size_t)sl * T * NPAIR + base; h0 += *(const f32x4*)p; h1 += *(const f32x4*)(p + 4); }
    const f32x4 ga = *(const f32x4*)(GS + base), gb = *(const f32x4*)(GS + base + 4);
    const v4u ev = *(const v4u*)(ES + base);
    const float hh[8] = {h0.x, h0.y, h0.z, h0.w, h1.x, h1.y, h1.z, h1.w}; const float gg[8] = {ga.x, ga.y, ga.z, ga.w, gb.x, gb.y, gb.z, gb.w};
    const unsigned ee[8] = {ev.x & 0xffffu, ev.x >> 16, ev.y & 0xffffu, ev.y >> 16, ev.z & 0xffffu, ev.z >> 16, ev.w & 0xffffu, ev.w >> 16};
    unsigned w[8];
#pragma unroll
    for (int i = 0; i < 8; ++i) { const float h = hh[i]; const float act = 0.5f * h * (1.f + erff(h * 0.70710678118654752f)) * gg[i]; w[i] = (ee[i] << 16) | f2bf(act); }
    unsigned* dst = LIST + ((size_t)(jb >> 2) * T + (t0 + tloc)) * 4;
    *(v4u*)dst = (v4u){w[0], w[1], w[2], w[3]}; *(v4u*)(dst + (size_t)T * 4) = (v4u){w[4], w[5], w[6], w[7]};
}

__device__ __forceinline__ void peer_v_role(const unsigned char* VQ, const unsigned* LIST, const bf16* X1B, float* X  , float* SSQ2, LAS unsigned char* lds, int c, int wave, int lane, int tid) {
    __syncthreads();
    {
        const v4u* src = (const v4u*)(VQ + (size_t)c * NEXP * 8);
#pragma unroll 4
        for (int i = tid; i < NEXP * 8 / 16; i += NWAVES * 64) *(LAS v4u*)(lds + (size_t)i * 16) = src[i];
    }
    __syncthreads();
    STAMP(22);
    for (int tgi = 0; tgi < T / 64 / NWAVES; ++tgi) {
        const int tg = wave + NWAVES * ((tgi + c) & (T / 64 / NWAVES - 1));
        const int t = tg * 64 + lane;
        f32x2 a01 = (f32x2){0.f, 0.f}, a23 = a01, a45 = a01, a67 = a01;
        const unsigned voff = (unsigned)t * 16u;
        const char* lbase = (const char*)LIST;
#define V_LOAD8(W, J0) do { W[0] = *(const v4u*)(lbase + (size_t)((J0) >> 2) * (T * 16) + voff); W[1] = *(const v4u*)(lbase + (size_t)(((J0) >> 2) + 1) * (T * 16) + voff); } while (0)
#define V_RD1(Q, WW) Q = *(const LAS u32x2*)(lds + (((WW) >> 13) & 0x7fff8u))
#define V_DSRD8(Q, W) do { V_RD1(Q[0], W[0].x); V_RD1(Q[1], W[0].y); V_RD1(Q[2], W[0].z); V_RD1(Q[3], W[0].w); V_RD1(Q[4], W[1].x); V_RD1(Q[5], W[1].y); V_RD1(Q[6], W[1].z); V_RD1(Q[7], W[1].w); } while (0)
#define V_ONE(QQ, WW) do { const u32x2 q_ = (QQ); const float a_ = __uint_as_float((WW) << 16); const f32x2 aa_ = (f32x2){a_, a_}; \
            a01 = __builtin_elementwise_fma(aa_, __builtin_amdgcn_cvt_pk_f32_fp8((int)q_.x, false), a01); a23 = __builtin_elementwise_fma(aa_, __builtin_amdgcn_cvt_pk_f32_fp8((int)q_.x, true), a23); \
            a45 = __builtin_elementwise_fma(aa_, __builtin_amdgcn_cvt_pk_f32_fp8((int)q_.y, false), a45); a67 = __builtin_elementwise_fma(aa_, __builtin_amdgcn_cvt_pk_f32_fp8((int)q_.y, true), a67); } while (0)
#define V_COMP8(Q, W) do { V_ONE(Q[0], W[0].x); V_ONE(Q[1], W[0].y); V_ONE(Q[2], W[0].z); V_ONE(Q[3], W[0].w); V_ONE(Q[4], W[1].x); V_ONE(Q[5], W[1].y); V_ONE(Q[6], W[1].z); V_ONE(Q[7], W[1].w); } while (0)
        v4u w0[2], w1[2], w2[2], w3[2]; u32x2 qa[8], qb[8];
        V_LOAD8(w0, 0); V_LOAD8(w1, 8); V_LOAD8(w2, 16);
        V_DSRD8(qa, w0);
#pragma unroll 1
        for (int j0 = 0; j0 < NPAIR; j0 += 32) {
            V_LOAD8(w3, j0 + 24); V_DSRD8(qb, w1); __builtin_amdgcn_sched_barrier(0); V_COMP8(qa, w0); __builtin_amdgcn_sched_barrier(0);
            V_LOAD8(w0, j0 + 32); V_DSRD8(qa, w2); __builtin_amdgcn_sched_barrier(0); V_COMP8(qb, w1); __builtin_amdgcn_sched_barrier(0);
            V_LOAD8(w1, j0 + 40); V_DSRD8(qb, w3); __builtin_amdgcn_sched_barrier(0); V_COMP8(qa, w2); __builtin_amdgcn_sched_barrier(0);
            V_LOAD8(w2, j0 + 48); V_DSRD8(qa, w0); __builtin_amdgcn_sched_barrier(0); V_COMP8(qb, w3); __builtin_amdgcn_sched_barrier(0);
        }
#undef V_RD1
#undef V_DSRD8
#undef V_LOAD8
#undef V_COMP8
#undef V_ONE
        float acc[8] = {a01.x, a01.y, a23.x, a23.y, a45.x, a45.y, a67.x, a67.y};
        float* xp = X + (size_t)t * D + 8 * c;
        const v4u xb = *(const v4u*)(X1B + (size_t)t * D + 8 * c);
        const f32x4 x0 = (f32x4){bflo(xb.x), bfhi(xb.x), bflo(xb.y), bfhi(xb.y)}, x1 = (f32x4){bflo(xb.z), bfhi(xb.z), bflo(xb.w), bfhi(xb.w)};
        const f32x4 y0 = (f32x4){acc[0] + x0.x, acc[1] + x0.y, acc[2] + x0.z, acc[3] + x0.w}, y1 = (f32x4){acc[4] + x1.x, acc[5] + x1.y, acc[6] + x1.z, acc[7] + x1.w};
        *(f32x4*)xp = y0; *(f32x4*)(xp + 4) = y1;
        const float ss = (y0.x * y0.x + y0.y * y0.y) + (y0.z * y0.z + y0.w * y0.w) + (y1.x * y1.x + y1.y * y1.y) + (y1.z * y1.z + y1.w * y1.w);
        atomicAdd(SSQ2 + t, ss);
    }
    STAMP(24);
}
__device__ __forceinline__ void final_norm_row(float* X, const float* SSQ2, const float* gfin, int t, int lane) {
    const float inv = 1.0f / sqrtf(SSQ2[t] * (1.f / D) + RMS_EPS);
    f32x4* xr = (f32x4*)(X + (size_t)t * D) + lane; const f32x4* gr = (const f32x4*)gfin + lane;
    f32x4 v[8];
#pragma unroll
    for (int j = 0; j < 8; ++j) v[j] = xr[64 * j];
#pragma unroll
    for (int j = 0; j < 8; ++j) { const f32x4 g = gr[64 * j]; xr[64 * j] = (f32x4){v[j].x * inv * g.x, v[j].y * inv * g.y, v[j].z * inv * g.z, v[j].w * inv * g.w}; }
}

#ifndef PHASE_MASK
#define PHASE_MASK 0x1ff
#endif
#define PH_ON(k) ((PHASE_MASK >> (k)) & 1)
#ifndef REP_MASK
#define REP_MASK 0
#endif
#define PH_REP(k) (1 + ((REP_MASK >> (k)) & 1))
__device__ __forceinline__ Ptrs load_args() {
#if defined(__HIP_DEVICE_COMPILE__)
    const __attribute__((address_space(4))) Ptrs* pp = (const __attribute__((address_space(4))) Ptrs*)__builtin_amdgcn_kernarg_segment_ptr();
    asm volatile("" : "+s"(pp));
    Ptrs r;
    r.x = pp->x; r.norm_mix = pp->norm_mix; r.w_in = pp->w_in; r.conv_w = pp->conv_w; r.w_conv_out = pp->w_conv_out; r.w_attn_out = pp->w_attn_out; r.w_out = pp->w_out; r.norm_ffn = pp->norm_ffn;
    r.peer_wq = pp->peer_wq; r.peer_sk = pp->peer_sk; r.peer_u = pp->peer_u; r.peer_v = pp->peer_v; r.norm_final = pp->norm_final; r.out = pp->out; r.ws = pp->ws;
    return r;
#else
    return Ptrs{};
#endif
}
__global__ void __launch_bounds__(NWAVES * 64, 2) hyb_fwd(Ptrs Punused) {
    extern __shared__ __attribute__((aligned(16))) unsigned char lds_raw[];
    LAS unsigned char* lds = (LAS unsigned char*)lds_raw;
    const int G = gridDim.x; const int bx = blockIdx.x; const int vcu = (G % 8 == 0) ? (bx % 8) * (G / 8) + bx / 8 : bx;
#define TIDV int tid_ = threadIdx.x; asm volatile("" : "+v"(tid_)); const int tid = tid_, lane = tid & 63, wave = __builtin_amdgcn_readfirstlane(tid >> 6); const int gw = vcu * NWAVES + wave, NGW = G * NWAVES; (void)gw; (void)NGW; (void)lane;
    XcdBarrier bar;
    {
        TIDV; const Ptrs P = load_args();
        volatile LAS unsigned* MISC = (volatile LAS unsigned*)(lds + MISC_OFF);
        for (int u = tid; u < 128; u += NWAVES * 64) ((LAS unsigned*)(lds + LDSCTL_OFF))[u] = 0u;
        __syncthreads();
        bar = xcd_barrier_post((unsigned*)(P.ws + WS_CTL) + CW_BAR, MISC + 8);
    }
#define CTLP ((unsigned*)(P.ws + WS_CTL))
    STAMP(0);

    if (PH_ON(0)) { TIDV; const Ptrs P = load_args(); p0_prologue(P, lds, vcu, G, wave, lane, tid); }
    xcd_barrier(bar);
    { TIDV; const Ptrs P = load_args(); p0_win_i8(P, lds, vcu, G, wave, lane); }
    xcd_barrier(bar);
    STAMP(1);

    if (PH_ON(1)) {
        const Ptrs P = load_args();
        pg8::Gemm g{(const pg8::bf16_t*)(P.ws + WS_XN), (const pg8::bf16_t*)(P.ws + WS_WIN), T, INW, D}; pg8::StaticOrder S; S.init(T, INW, G, bx);
        pg8::EpiStoreI8 E{(pg8::bf16_t*)(P.ws + WS_PROJ), INW, (const float*)(P.ws + WS_SA), (const float*)(CTLP + CW_COLMAX)};
        pg8::gemm_phase<pg8::EpiStoreI8, pg8::StaticOrder, true, true, true>(lds + RING_OFF, g, S, E);
    }
    xcd_barrier(bar);
    STAMP(2);

    if (PH_ON(2)) {
        TIDV; const Ptrs P = load_args();
        p2_conv(P, gw * 64 + lane, NGW * 64);
        const bf16* PROJ = (const bf16*)(P.ws + WS_PROJ); bf16* YA = (bf16*)(P.ws + WS_YA);
        LAS unsigned char* vl = lds + RING_OFF + wave * 4096;
        constexpr int NTASK = (T / 32) * NH;
        for (int it = gw; it < NTASK; it += NGW) { const int task = NTASK - 1 - it; attn_task(PROJ, YA, vl, task / NH, task % NH, lane); }
    }
    xcd_barrier(bar);
    STAMP(3);

    if (PH_ON(3)) {
        pg8::StaticOrder S; S.init(T, D, G, bx);
        { const Ptrs P = load_args();
          pg8::Gemm g{(const pg8::bf16_t*)(P.ws + WS_YC), (const pg8::bf16_t*)(P.ws + WS_WCO), T, D, CW};
          pg8::EpiGate<0> E{(const pg8::bf16_t*)(P.ws + WS_PROJ) + C_GC, INW, (pg8::bf16_t*)(P.ws + WS_XN), D};
          pg8::gemm_phase<pg8::EpiGate<0>, pg8::StaticOrder, true, true>(lds + RING_OFF, g, S, E); }
        { const Ptrs P = load_args();
          pg8::Gemm g{(const pg8::bf16_t*)(P.ws + WS_YA), (const pg8::bf16_t*)(P.ws + WS_WAO), T, D, AW};
          pg8::EpiGate<1> E{(const pg8::bf16_t*)(P.ws + WS_PROJ) + C_GA, INW, (pg8::bf16_t*)(P.ws + WS_XN), D};
          pg8::gemm_phase<pg8::EpiGate<1>, pg8::StaticOrder, true, true>(lds + RING_OFF, g, S, E); }
    }
    xcd_barrier(bar);
    STAMP(4);

    if (PH_ON(4)) {
        const Ptrs P = load_args();
        pg8::Gemm g{(const pg8::bf16_t*)(P.ws + WS_XN), (const pg8::bf16_t*)(P.ws + WS_WO), T, D, D}; pg8::StaticOrder S; S.init(T, D, G, bx);
        pg8::EpiX1 E{P.x, (pg8::bf16_t*)(P.ws + WS_X1B), (float*)(CTLP + CW_SSQ), D};
        pg8::gemm_phase<pg8::EpiX1, pg8::StaticOrder, true, true>(lds + RING_OFF, g, S, E);
    }
    xcd_barrier(bar);
    STAMP(5);

    if (PH_ON(5)) {
        const Ptrs P = load_args();
        pg8::Gemm g{(const pg8::bf16_t*)(P.ws + WS_X1B), (const pg8::bf16_t*)(P.ws + WS_WQ), T, D, D}; pg8::StaticOrder S; S.init(T, D, G, bx);
        pg8::EpiQP E{(const float*)(CTLP + CW_SSQ), (pg8::bf16_t*)(P.ws + WS_QP), D, 1.f / D, RMS_EPS};
        pg8::gemm_phase<pg8::EpiQP, pg8::StaticOrder, true, true>(lds + RING_OFF, g, S, E);
    }
    xcd_barrier(bar);
    STAMP(6);

    if (PH_ON(6)) {
        TIDV; const Ptrs P = load_args();
        constexpr int NTASK = (T / 32) * PH;
        for (int it = gw; it < NTASK; it += NGW) topk_task((const bf16*)(P.ws + WS_QP), (const bf16*)(P.ws + WS_SK), (int*)(P.ws + WS_IDX), (float*)(P.ws + WS_GATE), it / PH, it % PH, lane);
    }
    xcd_barrier(bar);
    STAMP(7);

    {
        TIDV; const Ptrs P = load_args();
        const bf16* X1B_ = (const bf16*)(P.ws + WS_X1B); const float* SSQ_ = (const float*)(CTLP + CW_SSQ); const int* IDX_ = (const int*)(P.ws + WS_IDX); const float* GATE_ = (const float*)(P.ws + WS_GATE);
        SortIn i0, i1, i2, i3;
        const int t0 = gw, t1 = gw + NGW, t2 = gw + 2 * NGW, t3 = gw + 3 * NGW;
        if (t0 < T) sortq_load(i0, X1B_, SSQ_, IDX_, GATE_, t0, lane); if (t1 < T) sortq_load(i1, X1B_, SSQ_, IDX_, GATE_, t1, lane);
        if (t2 < T) sortq_load(i2, X1B_, SSQ_, IDX_, GATE_, t2, lane); if (t3 < T) sortq_load(i3, X1B_, SSQ_, IDX_, GATE_, t3, lane);
#define SQ_DO(IN, TT) if ((TT) < T) sortq_token(IN, (unsigned short*)(P.ws + WS_ES), (unsigned short*)(P.ws + WS_ESG), (float*)(P.ws + WS_GS), (unsigned short*)(P.ws + WS_OFFN), (float*)(P.ws + WS_SXS), P.ws + WS_XQ, TT, lane)
        SQ_DO(i0, t0); SQ_DO(i1, t1); SQ_DO(i2, t2); SQ_DO(i3, t3);
        for (int t = gw + 4 * NGW; t < T; t += NGW) { SortIn in; sortq_load(in, X1B_, SSQ_, IDX_, GATE_, t, lane); SQ_DO(in, t); }
#undef SQ_DO
    }
    xcd_barrier(bar);
    STAMP(8);
    {
        TIDV; const Ptrs P = load_args();
        for (int role = bx; role < NS * NG; role += G) peer_u_role(P.ws + WS_UQ, (const float*)(P.ws + WS_SU), P.ws + WS_XQ, (const float*)(P.ws + WS_SXS), (const unsigned short*)(P.ws + WS_ES), (const unsigned short*)(P.ws + WS_ESG),
                                                                  (const unsigned short*)(P.ws + WS_OFFN), (float*)(P.ws + WS_PART), lds, role, wave, lane, tid);
    }
    xcd_barrier(bar);
    STAMP(9);
    {
        TIDV; const Ptrs P = load_args();
        for (int tile = vcu; tile < T / 32; tile += G) peer_reduce_tile((const float*)(P.ws + WS_PART), (const float*)(P.ws + WS_GS), (const unsigned short*)(P.ws + WS_ES), (unsigned*)(P.ws + WS_LIST), lds, tile, tid);
    }
    xcd_barrier(bar);
    STAMP(10);

    if (PH_ON(8)) {
        TIDV; const Ptrs P = load_args();
        for (int c = vcu; c < D / 8; c += G) peer_v_role(P.ws + WS_VQ, (const unsigned*)(P.ws + WS_LIST), (const bf16*)(P.ws + WS_X1B), P.out, (float*)(CTLP + CW_SSQ2), lds, c, wave, lane, tid);
    }
    xcd_barrier(bar);
    STAMP(11);

    {
        TIDV; const Ptrs P = load_args();
        for (int t = gw; t < T; t += NGW) final_norm_row(P.out, (const float*)(CTLP + CW_SSQ2), P.norm_final, t, lane);
    }
    if (PROBE_PHASE >= 0 && blockIdx.x == 0 && threadIdx.x == 0) {
        const unsigned long long now = __builtin_amdgcn_s_memrealtime();
        *(volatile LAS unsigned long long*)(lds + LDSCTL_OFF + 64 + 8 * 12) = now;
        const unsigned long long a = *(volatile LAS unsigned long long*)(lds + LDSCTL_OFF + 64 + 8 * PROBE_A);
        const unsigned long long b = *(volatile LAS unsigned long long*)(lds + LDSCTL_OFF + 64 + 8 * PROBE_B);
        const unsigned long long dt = (b - a) * 8ull;
        while (__builtin_amdgcn_s_memrealtime() - now < dt) __builtin_amdgcn_s_sleep(8);
    }
}

extern "C" void kernel_launch(void* const* d_in, const int* in_sizes, int n_in, void* d_out, int out_size, void* d_ws, size_t ws_size, hipStream_t stream) {
    static int grid = 0;
    if (grid == 0) {
        if (n_in != 13 || out_size != T * D || ws_size < WS_END) { fprintf(stderr, "kernel_launch: unexpected shapes (n_in %d out %d ws %zu)\n", n_in, out_size, ws_size); grid = -1; return; }
        int dev = 0, cus = 0, per_cu = 0;
        if (hipGetDevice(&dev) != hipSuccess || hipDeviceGetAttribute(&cus, hipDeviceAttributeMultiprocessorCount, dev) != hipSuccess) { grid = -1; return; }
        if (hipFuncSetAttribute((const void*)hyb_fwd, hipFuncAttributeMaxDynamicSharedMemorySize, LDS_BYTES) != hipSuccess) { fprintf(stderr, "kernel_launch: hipFuncSetAttribute failed\n"); grid = -1; return; }
        if (hipOccupancyMaxActiveBlocksPerMultiprocessor(&per_cu, (const void*)hyb_fwd, NWAVES * 64, LDS_BYTES) != hipSuccess || per_cu < 1) { fprintf(stderr, "kernel_launch: occupancy query says %d\n", per_cu); per_cu = 1; }
        (void)hipGetLastError();
        grid = cus;
    }
    if (grid < 0) return;
    (void)hipMemsetAsync((char*)d_ws + WS_CTL, 0, CTL_ZERO_BYTES, stream);
    Ptrs p{};
    p.x = (const float*)d_in[0]; p.norm_mix = (const float*)d_in[1]; p.w_in = (const float*)d_in[2]; p.conv_w = (const float*)d_in[3];
    p.w_conv_out = (const float*)d_in[4]; p.w_attn_out = (const float*)d_in[5]; p.w_out = (const float*)d_in[6]; p.norm_ffn = (const float*)d_in[7];
    p.peer_wq = (const float*)d_in[8]; p.peer_sk = (const float*)d_in[9]; p.peer_u = (const float*)d_in[10]; p.peer_v = (const float*)d_in[11]; p.norm_final = (const float*)d_in[12];
    p.out = (float*)d_out; p.ws = (unsigned char*)d_ws;
    void* args[] = {&p};
    hipError_t e = hipLaunchCooperativeKernel((const void*)hyb_fwd, dim3(grid), dim3(NWAVES * 64), args, LDS_BYTES, stream);
    if (e != hipSuccess) fprintf(stderr, "kernel_launch: cooperative launch failed: %s (grid %d)\n", hipGetErrorString(e), grid);
}
```

```cpp
#include <hip/hip_runtime.h>
#include <cstdio>
#include <cstdint>
namespace pg8 {
#define PG8_LAS __attribute__((address_space(3)))
typedef unsigned short bf16_t;
typedef short bf16x8 __attribute__((ext_vector_type(8)));
typedef float f32x4 __attribute__((ext_vector_type(4)));
typedef unsigned u32x4 __attribute__((ext_vector_type(4)));
constexpr int BM = 256, BK = 64, HALF = 128, HTB = HALF * BK * 2  , STAGE_BYTES = 8 * HTB, NXCD = 8, WGM = 8;

__host__ __device__ __forceinline__ int lds_byte(int r, int c) { const int st = (r >> 4) * 2 + (c >> 5), rr = r & 15, cc = c & 31, ob = rr * 64 + cc * 2; return st * 1024 + (ob ^ (((ob >> 9) & 1) << 5)); }
__host__ __device__ __forceinline__ void stage_rc(int b, int& R, int& C) { const int st = b / 1024, sb = b % 1024, swz = sb ^ (((sb >> 9) & 1) << 5); R = (st >> 1) * 16 + swz / 64; C = (st & 1) * 32 + (swz % 64) / 2; }
__host__ __device__ __forceinline__ int perm32(int rho) { const int n = rho >> 4, i = rho & 15; return 8 * (i >> 2) + 4 * n + (i & 3); }

struct Unit { int pm, pn; };
struct Gemm { const bf16_t* A; const bf16_t* Bt; int M, N, K; };

struct StaticOrder {
    int nM, nN, nwg, G, c;
    __host__ __device__ void init(int M, int N, int G_, int c_) { nM = M / BM; nN = N / BM; nwg = nM * nN; G = G_; c = c_; }
    __host__ __device__ bool next(int i, Unit& u) const {
        const long L = (long)i * G + c; if (L >= nwg) return false;
        int wgid = (int)L; { const int q = nwg / NXCD, r = nwg % NXCD, xcd = wgid % NXCD, off = wgid / NXCD; wgid = (xcd < r ? xcd * (q + 1) : r * (q + 1) + (xcd - r) * q) + off; }
        const int nig = WGM * nN, gid = wgid / nig, fm = gid * WGM, gsz = (nM - fm) < WGM ? (nM - fm) : WGM;
        u.pm = fm + ((wgid % nig) % gsz); u.pn = (wgid % nig) / gsz; return true;
    }
    __device__ __forceinline__ void a_ready(const Unit&) const {}
    __device__ __forceinline__ void done(const Unit&) const {}
};


typedef int i32x4 __attribute__((ext_vector_type(4)));
__device__ __forceinline__ unsigned cvt_pk_bf16(float lo, float hi) { unsigned r; asm volatile("v_cvt_pk_bf16_f32 %0, %1, %2" : "=v"(r) : "v"(lo), "v"(hi)); return r; }
__device__ __forceinline__ float bf_lo(unsigned w) { return __uint_as_float(w << 16); }
__device__ __forceinline__ float bf_hi(unsigned w) { return __uint_as_float(w & 0xffff0000u); }
__device__ __forceinline__ float sigmoidf_fast(float x) { return __builtin_amdgcn_rcpf(1.0f + __builtin_amdgcn_exp2f(-1.4426950408889634f * x)); }

struct EpiStore {
    static constexpr bool PERM = true, AFTER_DRAIN = false;
    bf16_t* O; int ldc;
    __device__ __forceinline__ void operator()(const f32x4 (&acc)[2][2][4][2], const Unit& u, int wr, int wc, int fr, int fq) const {
        const int row0 = u.pm * BM + wr * 64 + fr, col0 = u.pn * BM + wc * 32 + 8 * fq;
#pragma unroll
        for (int ai = 0; ai < 2; ++ai)
#pragma unroll
            for (int m = 0; m < 4; ++m) { bf16_t* rowp = O + (size_t)(row0 + ai * HALF + m * 16) * ldc + col0;
#pragma unroll
                for (int bj = 0; bj < 2; ++bj) { const f32x4 v0 = acc[ai][bj][m][0], v1 = acc[ai][bj][m][1];
                    u32x4 w; w.x = cvt_pk_bf16(v0[0], v0[1]); w.y = cvt_pk_bf16(v0[2], v0[3]); w.z = cvt_pk_bf16(v1[0], v1[1]); w.w = cvt_pk_bf16(v1[2], v1[3]);
                    *(u32x4*)(rowp + bj * HALF) = w; } }
    }
};
struct EpiStoreI8 {
    static constexpr bool PERM = true, AFTER_DRAIN = false;
    bf16_t* O; int ldc; const float* SA; const float* SB;
    __device__ __forceinline__ void operator()(const f32x4 (&acc)[2][2][4][2], const Unit& u, int wr, int wc, int fr, int fq) const {
        const int row0 = u.pm * BM + wr * 64 + fr, col0 = u.pn * BM + wc * 32 + 8 * fq;
        f32x4 sb[2][2];
#pragma unroll
        for (int bj = 0; bj < 2; ++bj) { sb[bj][0] = *(const f32x4*)(SB + col0 + bj * HALF) * (1.f / 127.f); sb[bj][1] = *(const f32x4*)(SB + col0 + bj * HALF + 4) * (1.f / 127.f); }
#pragma unroll
        for (int ai = 0; ai < 2; ++ai)
#pragma unroll
            for (int m = 0; m < 4; ++m) { const int row = row0 + ai * HALF + m * 16; const float sa = SA[row]; bf16_t* rowp = O + (size_t)row * ldc + col0;
#pragma unroll
                for (int bj = 0; bj < 2; ++bj) { const i32x4 i0 = __builtin_bit_cast(i32x4, acc[ai][bj][m][0]), i1 = __builtin_bit_cast(i32x4, acc[ai][bj][m][1]);
                    const f32x4 v0 = (f32x4){(float)i0.x, (float)i0.y, (float)i0.z, (float)i0.w} * sb[bj][0] * sa, v1 = (f32x4){(float)i1.x, (float)i1.y, (float)i1.z, (float)i1.w} * sb[bj][1] * sa;
                    u32x4 w; w.x = cvt_pk_bf16(v0[0], v0[1]); w.y = cvt_pk_bf16(v0[2], v0[3]); w.z = cvt_pk_bf16(v1[0], v1[1]); w.w = cvt_pk_bf16(v1[2], v1[3]);
                    *(u32x4*)(rowp + bj * HALF) = w; } }
    }
};
template <int PASS> struct EpiGate {
    static constexpr bool PERM = true, AFTER_DRAIN = false;
    const bf16_t* G; int ldg; bf16_t* O; int ldc;
    __device__ __forceinline__ void operator()(const f32x4 (&acc)[2][2][4][2], const Unit& u, int wr, int wc, int fr, int fq) const {
        const int row0 = u.pm * BM + wr * 64 + fr, col0 = u.pn * BM + wc * 32 + 8 * fq;
#pragma unroll
        for (int ai = 0; ai < 2; ++ai)
#pragma unroll
            for (int m = 0; m < 4; ++m) { const size_t row = (size_t)(row0 + ai * HALF + m * 16);
#pragma unroll
                for (int bj = 0; bj < 2; ++bj) { const f32x4 v0 = acc[ai][bj][m][0], v1 = acc[ai][bj][m][1];
                    const u32x4 g = *(const u32x4*)(G + row * ldg + col0 + bj * HALF);
                    float r[8];
                    r[0] = v0[0] * sigmoidf_fast(bf_lo(g.x)); r[1] = v0[1] * sigmoidf_fast(bf_hi(g.x)); r[2] = v0[2] * sigmoidf_fast(bf_lo(g.y)); r[3] = v0[3] * sigmoidf_fast(bf_hi(g.y));
                    r[4] = v1[0] * sigmoidf_fast(bf_lo(g.z)); r[5] = v1[1] * sigmoidf_fast(bf_hi(g.z)); r[6] = v1[2] * sigmoidf_fast(bf_lo(g.w)); r[7] = v1[3] * sigmoidf_fast(bf_hi(g.w));
                    bf16_t* op = O + row * ldc + col0 + bj * HALF;
                    if (PASS == 1) { const u32x4 p = *(const u32x4*)op;
                        r[0] += bf_lo(p.x); r[1] += bf_hi(p.x); r[2] += bf_lo(p.y); r[3] += bf_hi(p.y); r[4] += bf_lo(p.z); r[5] += bf_hi(p.z); r[6] += bf_lo(p.w); r[7] += bf_hi(p.w); }
                    u32x4 w; w.x = cvt_pk_bf16(r[0], r[1]); w.y = cvt_pk_bf16(r[2], r[3]); w.z = cvt_pk_bf16(r[4], r[5]); w.w = cvt_pk_bf16(r[6], r[7]);
                    *(u32x4*)op = w; }
                asm volatile("" ::: "memory"); }
    }
};
struct EpiX1 {
    static constexpr bool PERM = true, AFTER_DRAIN = false;
    const float* X; bf16_t* X1B; float* SSQ; int ldc;
    __device__ __forceinline__ void operator()(const f32x4 (&acc)[2][2][4][2], const Unit& u, int wr, int wc, int fr, int fq) const {
        const int row0 = u.pm * BM + wr * 64 + fr, col0 = u.pn * BM + wc * 32 + 8 * fq;
#pragma unroll
        for (int ai = 0; ai < 2; ++ai)
#pragma unroll
            for (int m = 0; m < 4; ++m) { const size_t row = (size_t)(row0 + ai * HALF + m * 16); float ss = 0.f;
#pragma unroll
                for (int bj = 0; bj < 2; ++bj) { const size_t off = row * ldc + col0 + bj * HALF;
                    const f32x4 x0 = *(const f32x4*)(X + off), x1 = *(const f32x4*)(X + off + 4);
                    const f32x4 v0 = acc[ai][bj][m][0] + x0, v1 = acc[ai][bj][m][1] + x1;
                    u32x4 w; w.x = cvt_pk_bf16(v0[0], v0[1]); w.y = cvt_pk_bf16(v0[2], v0[3]); w.z = cvt_pk_bf16(v1[0], v1[1]); w.w = cvt_pk_bf16(v1[2], v1[3]);
                    *(u32x4*)(X1B + off) = w;
                    ss += (v0[0] * v0[0] + v0[1] * v0[1]) + (v0[2] * v0[2] + v0[3] * v0[3]) + (v1[0] * v1[0] + v1[1] * v1[1]) + (v1[2] * v1[2] + v1[3] * v1[3]); }
                ss += __shfl_xor(ss, 16); ss += __shfl_xor(ss, 32);
                if (fq == 0) atomicAdd(SSQ + row, ss);
                asm volatile("" ::: "memory"); }
    }
};
struct EpiQP {
    static constexpr bool PERM = true, AFTER_DRAIN = false;
    const float* SSQ; bf16_t* O; int ldc; float inv_n, eps;
    __device__ __forceinline__ void operator()(const f32x4 (&acc)[2][2][4][2], const Unit& u, int wr, int wc, int fr, int fq) const {
        const int row0 = u.pm * BM + wr * 64 + fr, col0 = u.pn * BM + wc * 32 + 8 * fq;
#pragma unroll
        for (int ai = 0; ai < 2; ++ai)
#pragma unroll
            for (int m = 0; m < 4; ++m) { const size_t row = (size_t)(row0 + ai * HALF + m * 16); const float inv = 1.0f / sqrtf(SSQ[row] * inv_n + eps);
                bf16_t* rowp = O + row * ldc + col0;
#pragma unroll
                for (int bj = 0; bj < 2; ++bj) { const f32x4 v0 = acc[ai][bj][m][0] * inv, v1 = acc[ai][bj][m][1] * inv;
                    u32x4 w; w.x = cvt_pk_bf16(v0[0], v0[1]); w.y = cvt_pk_bf16(v0[2], v0[3]); w.z = cvt_pk_bf16(v1[0], v1[1]); w.w = cvt_pk_bf16(v1[2], v1[3]);
                    *(u32x4*)(rowp + bj * HALF) = w; } }
    }
};


template <bool I8> __device__ __forceinline__ f32x4 mma16(bf16x8 a, bf16x8 b, f32x4 c) {
    if constexpr (I8) return __builtin_bit_cast(f32x4, __builtin_amdgcn_mfma_i32_16x16x64_i8(__builtin_bit_cast(i32x4, a), __builtin_bit_cast(i32x4, b), __builtin_bit_cast(i32x4, c), 0, 0, 0));
    else return __builtin_amdgcn_mfma_f32_16x16x32_bf16(a, b, c, 0, 0, 0);
}
template <class Epi, class Sched, bool ALIGN_EPI = false, bool SP2 = false, bool I8 = false>
__device__ __forceinline__ void gemm_phase(PG8_LAS unsigned char* lds, const Gemm g, const Sched& S, const Epi& E) {
    const int tid = threadIdx.x, wid = __builtin_amdgcn_readfirstlane(tid >> 6), lane = tid & 63, wr = wid >> 2, wc = wid & 3, fr = lane & 15, fq = lane >> 4;
    const int K = I8 ? g.K / 2 : g.K, nt = K / BK;
    unsigned voffA[2], voffB[2];
#pragma unroll
    for (int i = 0; i < 2; ++i) { int R, C; stage_rc(tid * 16 + i * 8192, R, C); const int Rb = Epi::PERM ? ((R & ~31) + perm32(R & 31)) : R;
        voffA[i] = (unsigned)(R * K + C) * 2u; voffB[i] = (unsigned)(Rb * K + C) * 2u; }
    const size_t kstep = (size_t)(BK * 2);
    const size_t hstep = (size_t)HALF * K * 2;
    const size_t tstep = 2 * hstep;
    const unsigned ldsw = (unsigned)wid * 1024u;
    const int aoff = lds_byte(wr * 64 + fr, fq * 8), boff = lds_byte(wc * 32 + fr, fq * 8);
#define PG8_SA(b, h) (((b) * 2 + (h)) * HTB)
#define PG8_SB(b, h) ((4 + (b) * 2 + (h)) * HTB)
#define PG8_STAGE(bufoff, gbase, voff) do { _Pragma("unroll") for (int _i = 0; _i < 2; ++_i) \
        __builtin_amdgcn_global_load_lds((const unsigned*)((const char*)(gbase) + (voff)[_i]), (PG8_LAS unsigned*)(lds + (bufoff) + ldsw + _i * 8192), 16, 0, 0); } while (0)
#define PG8_LDA(dst, b, h) do { _Pragma("unroll") for (int m = 0; m < 4; ++m) _Pragma("unroll") for (int k = 0; k < 2; ++k) dst[m][k] = *(const PG8_LAS bf16x8*)(lds + PG8_SA(b, h) + aoff + m * 2048 + k * 1024); } while (0)
#define PG8_LDB(dst, b, h) do { _Pragma("unroll") for (int n = 0; n < 2; ++n) _Pragma("unroll") for (int k = 0; k < 2; ++k) dst[n][k] = *(const PG8_LAS bf16x8*)(lds + PG8_SB(b, h) + boff + n * 2048 + k * 1024); } while (0)
#define PG8_MMA(ai, bj, At, Bt) do { __builtin_amdgcn_s_setprio(1); _Pragma("unroll") for (int m = 0; m < 4; ++m) _Pragma("unroll") for (int n = 0; n < 2; ++n) _Pragma("unroll") for (int k = 0; k < 2; ++k) \
        acc[ai][bj][m][n] = mma16<I8>(Bt[n][k], At[m][k], acc[ai][bj][m][n]); __builtin_amdgcn_s_setprio(0); } while (0)
#define PG8_WAIT_V(n) asm volatile("s_waitcnt vmcnt(" #n ")" ::: "memory")
#define PG8_WAIT_L(n) asm volatile("s_waitcnt lgkmcnt(" #n ")" ::: "memory")
#define PG8_BAR __builtin_amdgcn_s_barrier()
#define PG8_SCHED __builtin_amdgcn_sched_barrier(0)
    Unit cur, nxt; int ui = 0;
    if (!S.next(0, cur)) return;
    f32x4 acc[2][2][4][2];
#pragma unroll
    for (int a = 0; a < 2; ++a)
#pragma unroll
        for (int b = 0; b < 2; ++b)
#pragma unroll
            for (int m = 0; m < 4; ++m)
#pragma unroll
                for (int n = 0; n < 2; ++n) acc[a][b][m][n] = (f32x4){0.f, 0.f, 0.f, 0.f};
    bf16x8 At[4][2], B0[2][2], B1[2][2];
    const char* cA = (const char*)g.A + (size_t)cur.pm * tstep; const char* cB = (const char*)g.Bt + (size_t)cur.pn * tstep;
    S.a_ready(cur);
    if constexpr (SP2) {
        PG8_STAGE(PG8_SB(0, 0), cB, voffB); PG8_STAGE(PG8_SB(0, 1), cB + hstep, voffB); PG8_STAGE(PG8_SA(0, 0), cA, voffA); PG8_STAGE(PG8_SA(0, 1), cA + hstep, voffA);
        if (wr == 1) PG8_BAR;
        PG8_WAIT_V(2); PG8_BAR;
        PG8_STAGE(PG8_SB(1, 0), cB + kstep, voffB); PG8_STAGE(PG8_SA(1, 0), cA + kstep, voffA); PG8_STAGE(PG8_SB(1, 1), cB + hstep + kstep, voffB);
        PG8_WAIT_V(6); PG8_BAR;
    } else {
        PG8_STAGE(PG8_SB(0, 0), cB, voffB); PG8_STAGE(PG8_SA(0, 0), cA, voffA); PG8_STAGE(PG8_SB(0, 1), cB + hstep, voffB); PG8_STAGE(PG8_SA(0, 1), cA + hstep, voffA);
        if (wr == 1) PG8_BAR;
        PG8_WAIT_V(4); PG8_BAR;
        PG8_STAGE(PG8_SB(1, 0), cB + kstep, voffB); PG8_STAGE(PG8_SA(1, 0), cA + kstep, voffA); PG8_STAGE(PG8_SB(1, 1), cB + hstep + kstep, voffB);
        PG8_WAIT_V(6); PG8_BAR;
    }
    for (;;) {
        const bool has_next = S.next(ui + 1, nxt);
        const char* nA = has_next ? (const char*)g.A + (size_t)nxt.pm * tstep : cA; const char* nB = has_next ? (const char*)g.Bt + (size_t)nxt.pn * tstep : cB;
        for (int t = 0; t < nt; t += 2) {
            const bool last = (t == nt - 2);
            const char* a1 = cA + (size_t)(t + 1) * kstep;
            const char* a2 = last ? nA : cA + (size_t)(t + 2) * kstep; const char* b2 = last ? nB : cB + (size_t)(t + 2) * kstep;
            const char* a3 = a2 + kstep; const char* b3 = b2 + kstep;
            if (last && has_next) S.a_ready(nxt);
            if constexpr (SP2) {
            PG8_LDB(B0, 0, 0); PG8_LDB(B1, 0, 1); PG8_SCHED; PG8_LDA(At, 0, 0); PG8_STAGE(PG8_SA(1, 1), a1 + hstep, voffA);
            PG8_WAIT_V(8); PG8_WAIT_L(0); PG8_BAR; PG8_MMA(0, 0, At, B0); PG8_MMA(0, 1, At, B1); PG8_BAR; PG8_SCHED;
            PG8_LDA(At, 0, 1); PG8_STAGE(PG8_SB(0, 0), b2, voffB); PG8_STAGE(PG8_SB(0, 1), b2 + hstep, voffB); PG8_STAGE(PG8_SA(0, 0), a2, voffA);
            PG8_WAIT_V(8); PG8_WAIT_L(0); PG8_BAR; PG8_MMA(1, 0, At, B0); PG8_MMA(1, 1, At, B1); PG8_BAR; PG8_SCHED;
            PG8_LDB(B0, 1, 0); PG8_LDB(B1, 1, 1); PG8_SCHED; PG8_LDA(At, 1, 0); PG8_STAGE(PG8_SA(0, 1), a2 + hstep, voffA);
            PG8_WAIT_V(8); PG8_WAIT_L(0); PG8_BAR; PG8_MMA(0, 0, At, B0); PG8_MMA(0, 1, At, B1); PG8_BAR; PG8_SCHED;
            PG8_LDA(At, 1, 1); PG8_STAGE(PG8_SB(1, 0), b3, voffB); PG8_STAGE(PG8_SB(1, 1), b3 + hstep, voffB); PG8_STAGE(PG8_SA(1, 0), a3, voffA);
            PG8_WAIT_V(8); PG8_WAIT_L(0); PG8_BAR; PG8_MMA(1, 0, At, B0); PG8_MMA(1, 1, At, B1); PG8_BAR; PG8_SCHED;
            } else {
            PG8_LDB(B0, 0, 0); PG8_SCHED; PG8_LDA(At, 0, 0); PG8_STAGE(PG8_SA(1, 1), a1 + hstep, voffA);
            PG8_WAIT_L(8); PG8_BAR; PG8_WAIT_L(0); PG8_MMA(0, 0, At, B0); PG8_BAR; PG8_SCHED;
            PG8_LDB(B1, 0, 1); PG8_STAGE(PG8_SB(0, 0), b2, voffB);
            PG8_BAR; PG8_WAIT_L(0); PG8_MMA(0, 1, At, B1); PG8_BAR;
            PG8_LDA(At, 0, 1); PG8_STAGE(PG8_SA(0, 0), a2, voffA);
            PG8_BAR; PG8_WAIT_L(0); PG8_MMA(1, 0, At, B0); PG8_BAR; PG8_SCHED;
            PG8_STAGE(PG8_SB(0, 1), b2 + hstep, voffB);
            PG8_WAIT_V(6); PG8_BAR; PG8_MMA(1, 1, At, B1); PG8_BAR;
            PG8_LDB(B0, 1, 0); PG8_SCHED; PG8_LDA(At, 1, 0); PG8_STAGE(PG8_SA(0, 1), a2 + hstep, voffA);
            PG8_WAIT_L(8); PG8_BAR; PG8_WAIT_L(0); PG8_MMA(0, 0, At, B0); PG8_BAR; PG8_SCHED;
            PG8_LDB(B1, 1, 1); PG8_STAGE(PG8_SB(1, 0), b3, voffB);
            PG8_BAR; PG8_WAIT_L(0); PG8_MMA(0, 1, At, B1); PG8_BAR;
            PG8_LDA(At, 1, 1); PG8_STAGE(PG8_SA(1, 0), a3, voffA);
            PG8_BAR; PG8_WAIT_L(0); PG8_MMA(1, 0, At, B0); PG8_BAR; PG8_SCHED;
            PG8_STAGE(PG8_SB(1, 1), b3 + hstep, voffB);
            PG8_WAIT_V(6); PG8_BAR; PG8_MMA(1, 1, At, B1); PG8_BAR;
            }
        }
        if constexpr (ALIGN_EPI) { if (wr == 0) PG8_BAR; }
        if constexpr (!Epi::AFTER_DRAIN) { E(acc, cur, wr, wc, fr, fq); S.done(cur); }
        if (!has_next) break;
#pragma unroll
        for (int a = 0; a < 2; ++a)
#pragma unroll
            for (int b = 0; b < 2; ++b)
#pragma unroll
                for (int m = 0; m < 4; ++m)
#pragma unroll
                    for (int n = 0; n < 2; ++n) acc[a][b][m][n] = (f32x4){0.f, 0.f, 0.f, 0.f};
        cur = nxt; cA = nA; cB = nB; ++ui;
        if constexpr (ALIGN_EPI) { if (wr == 1) PG8_BAR; }
    }
    PG8_WAIT_V(0);
    if constexpr (!ALIGN_EPI) { if (wr == 0) PG8_BAR; }
    PG8_BAR;
    if constexpr (Epi::AFTER_DRAIN) { E.fused(acc, cur, wr, wc, fr, fq, lds, wid, lane); S.done(cur); }
#undef PG8_SA
#undef PG8_SB
#undef PG8_STAGE
#undef PG8_LDA
#undef PG8_LDB
#undef PG8_MMA
#undef PG8_WAIT_V
#undef PG8_WAIT_L
#undef PG8_BAR
#undef PG8_SCHED
}
}


constexpr int NWAVES = 8;
constexpr int T = 8192, D = 2048, CW = 1024, AW = 1024, NH = 16, HD = 64, INW = 10240;
constexpr int C_CB = 0, C_CC = 1024, C_CH = 2048, C_Q = 3072, C_K = 4096, C_V = 5120, C_GC = 6144, C_GA = 8192;
constexpr int NS = 16, DW = 128, NG = 16, EG = 1024;
__host__ __device__ constexpr int egroup(int e) { return ((e >> 7) ^ e) & 15; }
__host__ __device__ constexpr int erow(int e) { return ((e >> 7) << 3) | ((e >> 4) & 7); }
constexpr int PH = 8, PKEYS = 128, PHALF = 128, PQD = 256, PTOPK = 16, NEXP = 16384, NPAIR = PH * PTOPK;
constexpr float RMS_EPS = 1e-6f;

constexpr size_t MiB = 1u << 20;
constexpr size_t WS_CTL = 0, CTL_ZERO_BYTES = 1 * MiB;
constexpr size_t WS_WIN = 1 * MiB;
constexpr size_t WS_SA = 22 * MiB;
constexpr size_t WS_WCO = 41 * MiB;
constexpr size_t WS_WAO = 45 * MiB;
constexpr size_t WS_WO = 49 * MiB;
constexpr size_t WS_WQ = 57 * MiB;
constexpr size_t WS_SK = 65 * MiB;
constexpr size_t WS_XN = 66 * MiB;
constexpr size_t WS_YC = 98 * MiB;
constexpr size_t WS_YA = 114 * MiB;
constexpr size_t WS_UQ = 130 * MiB;
constexpr size_t WS_SU = 162 * MiB;
constexpr size_t WS_SV = 163 * MiB;
constexpr size_t WS_VQ = 194 * MiB;
constexpr size_t WS_PROJ = 258 * MiB;
constexpr size_t WS_X1B = WS_PROJ;
constexpr size_t WS_QP = WS_PROJ + 32 * MiB;
constexpr size_t WS_IDX = WS_PROJ + 64 * MiB;
constexpr size_t WS_GATE = WS_PROJ + 68 * MiB;
constexpr size_t WS_ACT = WS_PROJ + 72 * MiB;
constexpr size_t WS_E32 = WS_PROJ + 172 * MiB;
constexpr size_t WS_A8 = WS_PROJ + 78 * MiB;
constexpr size_t WS_TS = WS_PROJ + 79 * MiB;
constexpr size_t WS_ES = WS_PROJ + 80 * MiB;
constexpr size_t WS_GS = WS_PROJ + 82 * MiB;
constexpr size_t WS_OFFN = WS_PROJ + 86 * MiB;
constexpr size_t WS_SXS = WS_PROJ + 87 * MiB;
constexpr size_t WS_XQ = WS_PROJ + 88 * MiB;
constexpr size_t WS_PART = WS_PROJ + 104 * MiB;
constexpr size_t WS_ESG = WS_PROJ + 168 * MiB;
constexpr size_t WS_SSQP = WS_PROJ + 176 * MiB;
constexpr size_t WS_END = 444 * MiB;
constexpr int CW_BAR = 4096;
constexpr int CW_SSQ = 65536;
constexpr int CW_COLMAX = CW_SSQ + 16384;
constexpr int CW_SSQ2 = CW_SSQ + 8192;
static_assert((CW_COLMAX + INW) * 4 <= (int)CTL_ZERO_BYTES, "ctl");

constexpr int RING_OFF = 0, RING_BYTES = 131072;
constexpr int LDSCTL_OFF = RING_BYTES, MISC_OFF = LDSCTL_OFF + 320;
constexpr int LDS_BYTES = 163840;
constexpr int LDS_SU_OFF = 132096;

#define GAS __attribute__((address_space(1)))
#define LAS __attribute__((address_space(3)))
typedef unsigned short bf16;
typedef unsigned v4u __attribute__((ext_vector_type(4)));
typedef float f32x4 __attribute__((ext_vector_type(4)));
typedef short bf16x8 __attribute__((ext_vector_type(8)));
typedef GAS unsigned gu32;
typedef GAS unsigned long long gu64;
#define RLX_AGENT __ATOMIC_RELAXED, __HIP_MEMORY_SCOPE_AGENT
#define LDS_WAIT() asm volatile("s_waitcnt lgkmcnt(0)" ::: "memory")
#define VM_WAIT() asm volatile("s_waitcnt vmcnt(0)" ::: "memory")
__device__ __forceinline__ unsigned long long rt() { return __builtin_amdgcn_s_memrealtime(); }
__device__ __forceinline__ unsigned f2bf(float f) { unsigned u = __builtin_bit_cast(unsigned, f); return (u + 0x7fffu + ((u >> 16) & 1u)) >> 16; }
__device__ __forceinline__ unsigned pk2(float lo, float hi) { return f2bf(lo) | (f2bf(hi) << 16); }

#define XB_TMO      128
#define XB_XCNT(j)  (256  + 64 * (j))
#define XB_XSUB(j)  (1280 + 64 * (j))
#define XB_XGEN(j)  (2304 + 64 * (j))
#define XB_TOP      3328
#define XB_TOPGEN   3392
#define XCD_BAR_WORDS 3456
#define XB_SPIN_CAP (1u << 18)

__device__ __forceinline__ unsigned xb_ld(unsigned* p)              { return __hip_atomic_load(p, __ATOMIC_RELAXED, __HIP_MEMORY_SCOPE_AGENT); }
__device__ __forceinline__ unsigned xb_add(unsigned* p, unsigned v) { return __hip_atomic_fetch_add(p, v, __ATOMIC_RELAXED, __HIP_MEMORY_SCOPE_AGENT); }
__device__ __forceinline__ unsigned xb_xcc_id() { return (unsigned)__builtin_amdgcn_s_getreg((3 << 11) | 20) & 0xFu; }
#define XB_SPIN(cond, bar) do { unsigned _sp = 0; while (cond) { __builtin_amdgcn_s_sleep(1); \
    if ((++_sp & 255u) == 0u) { if (xb_ld(&(bar)[XB_TMO])) break; if (_sp > XB_SPIN_CAP) { atomicAdd(&(bar)[XB_TMO], 1u); break; } } } } while (0)

struct XcdBarrier {
    unsigned* bar; unsigned x;
    volatile LAS unsigned* st;
};

__device__ __forceinline__ XcdBarrier xcd_barrier_post(unsigned* bar, volatile LAS unsigned* st) {
    XcdBarrier b; b.bar = bar; b.x = xb_xcc_id(); b.st = st;
    if (threadIdx.x == 0) (void)xb_add(&bar[XB_XCNT(b.x)], 1u);
    return b;
}
__device__ __forceinline__ void xcd_barrier_complete(unsigned* bar, unsigned x, unsigned& nloc, unsigned& nx) {
    const unsigned G = gridDim.x * gridDim.y * gridDim.z;
    unsigned sum, cnt, mine, sp = 0u;
    for (;;) {
        sum = 0u; cnt = 0u; mine = 0u;
#pragma unroll
        for (unsigned j = 0; j < 16; ++j) { const unsigned c = xb_ld(&bar[XB_XCNT(j)]); sum += c; cnt += (c > 0u) ? 1u : 0u; mine = (j == x) ? c : mine; }
        if (sum == G) break;
        __builtin_amdgcn_s_sleep(1);
        if ((++sp & 255u) == 0u) { if (xb_ld(&bar[XB_TMO])) break; if (sp > XB_SPIN_CAP) { atomicAdd(&bar[XB_TMO], 1u); break; } }
    }
    nloc = mine > 0u ? mine : 1u; nx = cnt > 0u ? cnt : 1u;
}

__device__ __forceinline__ void xcd_barrier(const XcdBarrier& b) {
    asm volatile("s_waitcnt vmcnt(0)" ::: "memory");
    __syncthreads();
    if (threadIdx.x == 0) {
        unsigned* bar = b.bar;
        __builtin_amdgcn_s_waitcnt(0);
        unsigned nloc = b.st[0], nx = b.st[1];
        if (nloc == 0u) { xcd_barrier_complete(bar, b.x, nloc, nx); b.st[0] = nloc; b.st[1] = nx; }
        const unsigned old = xb_add(&bar[XB_XSUB(b.x)], 1u);
        const unsigned gen = old / nloc;
        if (old + 1u == (gen + 1u) * nloc) {
            __builtin_amdgcn_fence(__ATOMIC_RELEASE, "agent");
            asm volatile("s_waitcnt vmcnt(0)" ::: "memory");
            const unsigned og = xb_add(&bar[XB_TOP], 1u);
            const unsigned tg = og / nx;
            if (og + 1u == (tg + 1u) * nx) xb_add(&bar[XB_TOPGEN], 1u);
            else XB_SPIN(xb_ld(&bar[XB_TOPGEN]) == tg, bar);
            __builtin_amdgcn_fence(__ATOMIC_ACQUIRE, "agent");
            xb_add(&bar[XB_XGEN(b.x)], 1u);
            asm volatile("s_waitcnt vmcnt(0)" ::: "memory");
        } else {
            XB_SPIN(xb_ld(&bar[XB_XGEN(b.x)]) == gen, bar);
            __builtin_amdgcn_fence(__ATOMIC_ACQUIRE, "agent");
            asm volatile("s_waitcnt vmcnt(0)" ::: "memory");
        }
    }
    __syncthreads();
}


#define PROBE_PHASE -1
#define PROBE_A 0
#define PROBE_B 1
#define STAMP(i) do { if (PROBE_PHASE >= 0 && blockIdx.x == 0 && threadIdx.x == 0) *(volatile LAS unsigned long long*)(lds + LDSCTL_OFF + 64 + 8 * (i)) = __builtin_amdgcn_s_memrealtime(); } while (0)
typedef float f32x16 __attribute__((ext_vector_type(16)));
typedef short s16x4 __attribute__((ext_vector_type(4)));
typedef unsigned u32x2 __attribute__((ext_vector_type(2)));
typedef float f32x2 __attribute__((ext_vector_type(2)));
__device__ __forceinline__ float wave_sum(float v) {
#pragma unroll
    for (int o = 1; o < 64; o <<= 1) v += __shfl_xor(v, o);
    return v;
}
__device__ __forceinline__ float partner32(float v) { return __shfl_xor(v, 32); }
__device__ __forceinline__ int partner32i(int v) { return __shfl_xor(v, 32); }
__device__ __forceinline__ int crow(int r, int hi) { return (r & 3) + 8 * (r >> 2) + 4 * hi; }
__device__ __forceinline__ float bflo(unsigned w) { return __uint_as_float(w << 16); }
__device__ __forceinline__ float bfhi(unsigned w) { return __uint_as_float(w & 0xffff0000u); }
__device__ __forceinline__ unsigned cvtpk(float lo, float hi) { unsigned r; asm volatile("v_cvt_pk_bf16_f32 %0, %1, %2" : "=v"(r) : "v"(lo), "v"(hi)); return r; }

struct TrItem { const float* W; bf16* WT; const float* kscale; int K, N, k0, n0; };
__device__ __forceinline__ void tr_load(const TrItem& it, f32x4 (&v)[8], int lane) {
    const int rr = lane >> 3, ch = lane & 7;
#pragma unroll
    for (int i = 0; i < 8; ++i) v[i] = *(const f32x4*)(it.W + (size_t)(it.k0 + rr + 8 * i) * it.N + it.n0 + 4 * ch);
}
__device__ __forceinline__ void tr_finish(const TrItem& it, f32x4 (&v)[8], LAS float* scr, int lane) {
    const int rr = lane >> 3, ch = lane & 7;
    if (it.kscale) {
#pragma unroll
        for (int i = 0; i < 8; ++i) v[i] = v[i] * it.kscale[it.k0 + rr + 8 * i];
    }
#pragma unroll
    for (int i = 0; i < 8; ++i) { LAS float* p = scr + (rr + 8 * i) * 33 + 4 * ch; p[0] = v[i].x; p[1] = v[i].y; p[2] = v[i].z; p[3] = v[i].w; }
    LDS_WAIT(); asm volatile("" ::: "memory");
    const int c = lane & 7;
#pragma unroll
    for (int j = 0; j < 4; ++j) { const int n = (lane >> 3) + 8 * j; const LAS float* s = scr + (8 * c) * 33 + n;
        v4u o; o.x = pk2(s[0 * 33], s[1 * 33]); o.y = pk2(s[2 * 33], s[3 * 33]); o.z = pk2(s[4 * 33], s[5 * 33]); o.w = pk2(s[6 * 33], s[7 * 33]);
        *(v4u*)(it.WT + (size_t)(it.n0 + n) * it.K + it.k0 + 8 * c) = o; }
    LDS_WAIT(); asm volatile("" ::: "memory");
}
__device__ __forceinline__ float wave_max(float v) {
#pragma unroll
    for (int o = 1; o < 64; o <<= 1) v = fmaxf(v, __shfl_xor(v, o));
    return v;
}
__device__ __forceinline__ void rms_rows2_to_i8(const float* x0, const float* x1, const float* gain, unsigned char* o0, unsigned char* o1, float* sa0, float* sa1, int lane) {
    const f32x4* xa = (const f32x4*)x0 + lane; const f32x4* xb = (const f32x4*)x1 + lane; const f32x4* gr = (const f32x4*)gain + lane;
    f32x4 va[8], vb[8]; float sa = 0.f, sb = 0.f;
#pragma unroll
    for (int j = 0; j < 8; ++j) { va[j] = xa[64 * j]; vb[j] = xb[64 * j]; }
#pragma unroll
    for (int j = 0; j < 8; ++j) { sa += (va[j].x * va[j].x + va[j].y * va[j].y) + (va[j].z * va[j].z + va[j].w * va[j].w); sb += (vb[j].x * vb[j].x + vb[j].y * vb[j].y) + (vb[j].z * vb[j].z + vb[j].w * vb[j].w); }
    const float ia = 1.f / sqrtf(wave_sum(sa) * (1.f / D) + RMS_EPS), ib = 1.f / sqrtf(wave_sum(sb) * (1.f / D) + RMS_EPS);
    float ma = 0.f, mb = 0.f;
#pragma unroll
    for (int j = 0; j < 8; ++j) { const f32x4 g = gr[64 * j]; va[j] = va[j] * g * ia; vb[j] = vb[j] * g * ib;
        ma = fmaxf(ma, fmaxf(fmaxf(fabsf(va[j].x), fabsf(va[j].y)), fmaxf(fabsf(va[j].z), fabsf(va[j].w)))); mb = fmaxf(mb, fmaxf(fmaxf(fabsf(vb[j].x), fabsf(vb[j].y)), fmaxf(fabsf(vb[j].z), fabsf(vb[j].w)))); }
    ma = wave_max(ma); mb = wave_max(mb);
    const float qa = ma > 0.f ? 127.f / ma : 0.f, qb = mb > 0.f ? 127.f / mb : 0.f;
    unsigned* pa = (unsigned*)o0 + lane; unsigned* pb = (unsigned*)o1 + lane;
#pragma unroll
    for (int j = 0; j < 8; ++j) {
        pa[64 * j] = (unsigned)((int)rintf(va[j].x * qa) & 255) | ((unsigned)((int)rintf(va[j].y * qa) & 255) << 8) | ((unsigned)((int)rintf(va[j].z * qa) & 255) << 16) | ((unsigned)((int)rintf(va[j].w * qa) & 255) << 24);
        pb[64 * j] = (unsigned)((int)rintf(vb[j].x * qb) & 255) | ((unsigned)((int)rintf(vb[j].y * qb) & 255) << 8) | ((unsigned)((int)rintf(vb[j].z * qb) & 255) << 16) | ((unsigned)((int)rintf(vb[j].w * qb) & 255) << 24); }
    if (lane == 0) { *sa0 = ma * (1.f / 127.f); *sa1 = mb * (1.f / 127.f); }
}
__device__ __forceinline__ void tr_finish_i8(const TrItem& it, f32x4 (&v)[8], const float* colmax, LAS float* scr, int lane) {
    const int rr = lane >> 3, ch = lane & 7;
#pragma unroll
    for (int i = 0; i < 8; ++i) { LAS float* p = scr + (rr + 8 * i) * 33 + 4 * ch; p[0] = v[i].x; p[1] = v[i].y; p[2] = v[i].z; p[3] = v[i].w; }
    LDS_WAIT(); asm volatile("" ::: "memory");
    const int c = lane & 3;
#pragma unroll
    for (int j = 0; j < 2; ++j) { const int n = (lane >> 2) + 16 * j; const LAS float* s = scr + (16 * c) * 33 + n;
        const float cm = colmax[it.n0 + n]; const float q = cm > 0.f ? 127.f / cm : 0.f;
        unsigned w[4];
#pragma unroll
        for (int d = 0; d < 4; ++d) w[d] = (unsigned)((int)rintf(s[(4 * d) * 33] * q) & 255) | ((unsigned)((int)rintf(s[(4 * d + 1) * 33] * q) & 255) << 8) | ((unsigned)((int)rintf(s[(4 * d + 2) * 33] * q) & 255) << 16) | ((unsigned)((int)rintf(s[(4 * d + 3) * 33] * q) & 255) << 24);
        *(v4u*)((unsigned char*)it.WT + (size_t)(it.n0 + n) * it.K + it.k0 + 16 * c) = (v4u){w[0], w[1], w[2], w[3]}; }
    LDS_WAIT(); asm volatile("" ::: "memory");
}

struct Ptrs {
    const float *x, *norm_mix, *w_in, *conv_w, *w_conv_out, *w_attn_out, *w_out, *norm_ffn, *peer_wq, *peer_sk, *peer_u, *peer_v, *norm_final;
    float* out; unsigned char* ws;
};

__device__ __forceinline__ void p0_prologue(const Ptrs& P, LAS unsigned char* lds, int vcu, int G, int wave, int lane, int tid) {
    LAS float* scr = (LAS float*)(lds + RING_OFF + wave * 16384);
    const int gw = vcu * NWAVES + wave, NGW = G * NWAVES;
    bf16* WCO = (bf16*)(P.ws + WS_WCO); bf16* WAO = (bf16*)(P.ws + WS_WAO); bf16* WO = (bf16*)(P.ws + WS_WO); bf16* WQ = (bf16*)(P.ws + WS_WQ);
    constexpr int I_CO = (CW / 64) * (D / 32), I_AO = (AW / 64) * (D / 32), I_O = (D / 64) * (D / 32), I_Q = I_O;
    constexpr int NITEMS = I_CO + I_AO + I_O + I_Q;
    auto mk = [&](int it) {
        TrItem t; int r = it, K, N;
        if (r < I_CO) { t.W = P.w_conv_out; t.WT = WCO; t.kscale = nullptr; K = CW; N = D; }
        else if ((r -= I_CO) < I_AO) { t.W = P.w_attn_out; t.WT = WAO; t.kscale = nullptr; K = AW; N = D; }
        else if ((r -= I_AO) < I_O) { t.W = P.w_out; t.WT = WO; t.kscale = nullptr; K = D; N = D; }
        else { r -= I_O; t.W = P.peer_wq; t.WT = WQ; t.kscale = P.norm_ffn; K = D; N = D; }
        const int nblk = N / 32; t.K = K; t.N = N; t.k0 = 64 * (r / nblk); t.n0 = 32 * (r % nblk); return t; };
    {
        f32x4 va[8], vb[8];
        int it = gw;
        if (it < NITEMS) { const TrItem a = mk(it); tr_load(a, va, lane); }
        for (; it < NITEMS; it += 2 * NGW) {
            const TrItem a = mk(it);
            const bool hb = it + NGW < NITEMS; TrItem b = a; if (hb) { b = mk(it + NGW); tr_load(b, vb, lane); }
            tr_finish(a, va, scr, lane);
            if (it + 2 * NGW < NITEMS) { const TrItem c = mk(it + 2 * NGW); tr_load(c, va, lane); }
            if (hb) tr_finish(b, vb, scr, lane);
        }
    }
    unsigned char* XN = P.ws + WS_XN; float* SA = (float*)(P.ws + WS_SA);
    for (int m = gw; m < T / 2; m += NGW) rms_rows2_to_i8(P.x + (size_t)(2 * m) * D, P.x + (size_t)(2 * m + 1) * D, P.norm_mix, XN + (size_t)(2 * m) * D, XN + (size_t)(2 * m + 1) * D, SA + 2 * m, SA + 2 * m + 1, lane);
    {
        unsigned char* UQ = P.ws + WS_UQ; float* SU = (float*)(P.ws + WS_SU);
        const float* gr = P.norm_ffn + 4 * lane;
        for (int e2 = gw; e2 < NEXP / 2; e2 += NGW) {
            f32x4 v[2][8];
#pragma unroll
            for (int h = 0; h < 2; ++h)
#pragma unroll
                for (int j = 0; j < 8; ++j) v[h][j] = *(const f32x4*)(P.peer_u + (size_t)(2 * e2 + h) * D + 4 * lane + 256 * j);
#pragma unroll
            for (int j = 0; j < 8; ++j) { const f32x4 gg = *(const f32x4*)(gr + 256 * j); v[0][j] = v[0][j] * gg; v[1][j] = v[1][j] * gg; }
#pragma unroll
            for (int h = 0; h < 2; ++h) {
                const int e = 2 * e2 + h, g = egroup(e), r = erow(e);
#pragma unroll
                for (int j = 0; j < 8; ++j) {
                    float m = fmaxf(fmaxf(fabsf(v[h][j].x), fabsf(v[h][j].y)), fmaxf(fabsf(v[h][j].z), fabsf(v[h][j].w)));
                    m = fmaxf(m, __shfl_xor(m, 1)); m = fmaxf(m, __shfl_xor(m, 2)); m = fmaxf(m, __shfl_xor(m, 4)); m = fmaxf(m, __shfl_xor(m, 8)); m = fmaxf(m, __shfl_xor(m, 16));
                    const float inv = m > 0.f ? 127.f / m : 0.f;
                    const int q0 = (int)rintf(v[h][j].x * inv), q1 = (int)rintf(v[h][j].y * inv), q2 = (int)rintf(v[h][j].z * inv), q3 = (int)rintf(v[h][j].w * inv);
                    const unsigned w = (unsigned)(q0 & 255) | ((unsigned)(q1 & 255) << 8) | ((unsigned)(q2 & 255) << 16) | ((unsigned)(q3 & 255) << 24);
                    const int sl = 2 * j + (lane >> 5), role = g * NS + sl;
                    *(unsigned*)(UQ + ((size_t)role * EG + r) * DW + 4 * (lane & 31)) = w;
                    if ((lane & 31) == 0) SU[role * EG + r] = m * (1.f / 127.f);
                }
            }
        }
    }
    {
        const int gt = (vcu * NWAVES + wave) * 64 + lane, NGT = G * NWAVES * 64;
        bf16* SK = (bf16*)(P.ws + WS_SK);
        for (int it = gt; it < 2 * PKEYS * PHALF; it += NGT) SK[it] = (bf16)f2bf(P.peer_sk[it]);
    }
    {
        LAS unsigned char* tile = lds + RING_OFF;
        unsigned char* VQ = P.ws + WS_VQ; float* SV = (float*)(P.ws + WS_SV);
        __syncthreads();
        for (int b = vcu; b < NEXP / 32; b += G) {
            const int e0 = b * 32;
            f32x4 vv[4][8];
#pragma unroll
            for (int i = 0; i < 4; ++i) { const float* vr = P.peer_v + (size_t)(e0 + wave * 4 + i) * D + 4 * lane;
#pragma unroll
                for (int j = 0; j < 8; ++j) vv[i][j] = *(const f32x4*)(vr + 256 * j); }
#pragma unroll
            for (int i = 0; i < 4; ++i) {
                const int er = wave * 4 + i;
                float m = 0.f;
#pragma unroll
                for (int j = 0; j < 8; ++j) m = fmaxf(m, fmaxf(fmaxf(fabsf(vv[i][j].x), fabsf(vv[i][j].y)), fmaxf(fabsf(vv[i][j].z), fabsf(vv[i][j].w))));
                m = wave_max(m);
                const float inv = m > 0.f ? 127.f / m : 0.f;
                if (lane == 0) SV[e0 + er] = m * (1.f / 127.f);
#pragma unroll
                for (int j = 0; j < 8; ++j) {
                    const f32x4 v = vv[i][j];
                    const int w = (int)((unsigned)((int)rintf(v.x * inv) & 255) | ((unsigned)((int)rintf(v.y * inv) & 255) << 8) | ((unsigned)((int)rintf(v.z * inv) & 255) << 16) | ((unsigned)((int)rintf(v.w * inv) & 255) << 24));
                    const int c = (lane >> 1) + 32 * j;
                    *(LAS int*)(tile + (c * 33 + er) * 8 + 4 * (lane & 1)) = w;
                }
            }
            __syncthreads();
#pragma unroll 4
            for (int k = 0; k < 16; ++k) {
                const int c = wave * 32 + 2 * k + (lane >> 5), er = lane & 31;
                const u32x2 q = *(const LAS u32x2*)(tile + (c * 33 + er) * 8);
                *(u32x2*)(VQ + ((size_t)c * NEXP + e0 + er) * 8) = q;
            }
            __syncthreads();
        }
    }
    {
        unsigned* CM = (unsigned*)(P.ws + WS_CTL) + CW_COLMAX;
        constexpr int NCB = INW / 256;
        for (int it = gw; it < (D / 64) * NCB; it += NGW) {
            const int kb = it / NCB, cb = it % NCB; const float* src = P.w_in + (size_t)(64 * kb) * INW + 256 * cb + 4 * lane;
            f32x4 m = (f32x4){0.f, 0.f, 0.f, 0.f};
#pragma unroll 16
            for (int r = 0; r < 64; ++r) { const f32x4 v = *(const f32x4*)(src + (size_t)r * INW); m.x = fmaxf(m.x, fabsf(v.x)); m.y = fmaxf(m.y, fabsf(v.y)); m.z = fmaxf(m.z, fabsf(v.z)); m.w = fmaxf(m.w, fabsf(v.w)); }
            unsigned* d = CM + 256 * cb + 4 * lane;
            atomicMax(d, __float_as_uint(m.x)); atomicMax(d + 1, __float_as_uint(m.y)); atomicMax(d + 2, __float_as_uint(m.z)); atomicMax(d + 3, __float_as_uint(m.w));
        }
    }
}

__device__ __forceinline__ void p0_win_i8(const Ptrs& P, LAS unsigned char* lds, int vcu, int G, int wave, int lane) {
    LAS float* scr = (LAS float*)(lds + RING_OFF + wave * 16384);
    const int gw = vcu * NWAVES + wave, NGW = G * NWAVES;
    const float* CM = (const float*)((const unsigned*)(P.ws + WS_CTL) + CW_COLMAX);
    constexpr int NITEMS = (D / 64) * (INW / 32);
    auto mk = [&](int it) { TrItem t; t.W = P.w_in; t.WT = (bf16*)(P.ws + WS_WIN); t.kscale = nullptr; t.K = D; t.N = INW; t.k0 = 64 * (it & 31); t.n0 = 32 * (it >> 5); return t; };
    f32x4 va[8], vb[8];
    int it = gw;
    if (it < NITEMS) { const TrItem a = mk(it); tr_load(a, va, lane); }
    for (; it < NITEMS; it += 2 * NGW) {
        const TrItem a = mk(it);
        const bool hb = it + NGW < NITEMS; TrItem b = a; if (hb) { b = mk(it + NGW); tr_load(b, vb, lane); }
        tr_finish_i8(a, va, CM, scr, lane);
        if (it + 2 * NGW < NITEMS) { const TrItem c = mk(it + 2 * NGW); tr_load(c, va, lane); }
        if (hb) tr_finish_i8(b, vb, CM, scr, lane);
    }
}

__device__ __forceinline__ void p2_conv(const Ptrs& P, int gt, int NGT) {
    const bf16* PROJ = (const bf16*)(P.ws + WS_PROJ); bf16* YC = (bf16*)(P.ws + WS_YC);
    constexpr int NIT = (T / 8) * (CW / 8);
    for (int it = gt; it < NIT; it += NGT) {
        const int ch = it % (CW / 8), tb = it / (CW / 8), c0 = ch * 8, t0 = tb * 8;
        float w0[8], w1[8], w2[8];
#pragma unroll
        for (int i = 0; i < 8; ++i) { w0[i] = P.conv_w[c0 + i]; w1[i] = P.conv_w[CW + c0 + i]; w2[i] = P.conv_w[2 * CW + c0 + i]; }
        float zm2[8], zm1[8];
#pragma unroll
        for (int i = 0; i < 8; ++i) { zm2[i] = 0.f; zm1[i] = 0.f; }
#pragma unroll
        for (int dt = -2; dt < 8; ++dt) {
            const int t = t0 + dt; if (t < 0) continue;
            const v4u cc = *(const v4u*)(PROJ + (size_t)t * INW + C_CC + c0), hh = *(const v4u*)(PROJ + (size_t)t * INW + C_CH + c0);
            float z[8];
            z[0] = bflo(cc.x) * bflo(hh.x); z[1] = bfhi(cc.x) * bfhi(hh.x); z[2] = bflo(cc.y) * bflo(hh.y); z[3] = bfhi(cc.y) * bfhi(hh.y);
            z[4] = bflo(cc.z) * bflo(hh.z); z[5] = bfhi(cc.z) * bfhi(hh.z); z[6] = bflo(cc.w) * bflo(hh.w); z[7] = bfhi(cc.w) * bfhi(hh.w);
            if (dt >= 0) {
                const v4u cb = *(const v4u*)(PROJ + (size_t)t * INW + C_CB + c0);
                float b[8] = {bflo(cb.x), bfhi(cb.x), bflo(cb.y), bfhi(cb.y), bflo(cb.z), bfhi(cb.z), bflo(cb.w), bfhi(cb.w)};
                float y[8];
#pragma unroll
                for (int i = 0; i < 8; ++i) y[i] = b[i] * (w0[i] * zm2[i] + w1[i] * zm1[i] + w2[i] * z[i]);
                v4u o; o.x = pk2(y[0], y[1]); o.y = pk2(y[2], y[3]); o.z = pk2(y[4], y[5]); o.w = pk2(y[6], y[7]);
                *(v4u*)(YC + (size_t)t * CW + c0) = o;
            }
#pragma unroll
            for (int i = 0; i < 8; ++i) { zm2[i] = zm1[i]; zm1[i] = z[i]; }
        }
    }
}

__device__ __forceinline__ s16x4 vtr(LAS const unsigned char* p) { typedef short v4i16_t __attribute__((ext_vector_type(4))); return __builtin_bit_cast(s16x4, __builtin_amdgcn_ds_read_tr16_b64_v4i16((LAS v4i16_t*)p)); }

__device__ __forceinline__ void attn_task(const bf16* PROJ, bf16* YA, LAS unsigned char* vl  , int qt, int h, int lane) {
    const int r32 = lane & 31, hi = lane >> 5, q0 = qt * 32;
    const bf16* Qp = PROJ + (size_t)(q0 + r32) * INW + C_Q + h * HD + 8 * hi;
    bf16x8 qf[4];
#pragma unroll
    for (int s = 0; s < 4; ++s) qf[s] = *(const bf16x8*)(Qp + 16 * s);
    float carry = 1.f;
    f32x16 o0, o1;
#pragma unroll
    for (int r = 0; r < 16; ++r) { o0[r] = 0.f; o1[r] = 0.f; }
    const int g1 = (lane >> 4) & 1, qq = (lane & 15) >> 2, pp = lane & 3;
    LAS const unsigned char* vrd = vl + (4 * hi + qq) * 128 + g1 * 32 + pp * 8;
    for (int kt = qt; kt >= 0; --kt) {
        const int k0 = kt * 32;
        const bf16* Kp = PROJ + (size_t)(k0 + r32) * INW + C_K + h * HD + 8 * hi;
        bf16x8 kf[4];
#pragma unroll
        for (int s = 0; s < 4; ++s) kf[s] = *(const bf16x8*)(Kp + 16 * s);
        v4u vv[4];
#pragma unroll
        for (int i = 0; i < 4; ++i) { const int c = lane + 64 * i, row = c >> 3, chn = c & 7; vv[i] = *(const v4u*)(PROJ + (size_t)(k0 + row) * INW + C_V + h * HD + chn * 8); }
        f32x16 S;
#pragma unroll
        for (int r = 0; r < 16; ++r) S[r] = 0.f;
#pragma unroll
        for (int s = 0; s < 4; ++s) S = __builtin_amdgcn_mfma_f32_32x32x16_bf16(kf[s], qf[s], S, 0, 0, 0);
#pragma unroll
        for (int i = 0; i < 4; ++i) { const int c = lane + 64 * i, row = c >> 3, chn = c & 7; *(LAS v4u*)(vl + row * 128 + chn * 16) = vv[i]; }
        float kp[16], bt[16];
        const float cs = 0.125f * 1.4426950408889634f;
#pragma unroll
        for (int r = 0; r < 16; ++r) { const float a = fminf(S[r] * cs, 126.f); const float e = __builtin_amdgcn_exp2f(a); const float ri = __builtin_amdgcn_rcpf(1.f + e); kp[r] = ri; bt[r] = e * ri; }
        if (kt == qt) {
#pragma unroll
            for (int r = 0; r < 16; ++r) { if (crow(r, hi) >= r32) { kp[r] = 1.f; bt[r] = 0.f; } }
        }
        float Pm[4], Qm[4], Tt[4];
#pragma unroll
        for (int i = 0; i < 4; ++i) { Pm[i] = (kp[4 * i] * kp[4 * i + 1]) * (kp[4 * i + 2] * kp[4 * i + 3]); Qm[i] = partner32(Pm[i]); Tt[i] = Pm[i] * Qm[i]; }
        float R[4]; R[3] = 1.f; R[2] = Tt[3]; R[1] = Tt[3] * Tt[2]; R[0] = R[1] * Tt[1];
        const float total = R[0] * Tt[0];
        float w[16];
#pragma unroll
        for (int i = 0; i < 4; ++i) {
            const float base = carry * R[i] * (hi ? 1.f : Qm[i]);
            const float x3 = base, x2 = x3 * kp[4 * i + 3], x1 = x2 * kp[4 * i + 2], x0 = x1 * kp[4 * i + 1];
            w[4 * i + 3] = bt[4 * i + 3] * x3; w[4 * i + 2] = bt[4 * i + 2] * x2; w[4 * i + 1] = bt[4 * i + 1] * x1; w[4 * i] = bt[4 * i] * x0;
        }
        carry *= total;
        v4u wa0, wa1;
        wa0.x = cvtpk(w[0], w[1]); wa0.y = cvtpk(w[2], w[3]); wa0.z = cvtpk(w[4], w[5]); wa0.w = cvtpk(w[6], w[7]);
        wa1.x = cvtpk(w[8], w[9]); wa1.y = cvtpk(w[10], w[11]); wa1.z = cvtpk(w[12], w[13]); wa1.w = cvtpk(w[14], w[15]);
        asm volatile("s_waitcnt lgkmcnt(0)" ::: "memory");
        s16x4 l00 = vtr(vrd + 0 * 64 + 0 * 2048), h00 = vtr(vrd + 0 * 64 + 0 * 2048 + 1024);
        s16x4 l01 = vtr(vrd + 0 * 64 + 1 * 2048), h01 = vtr(vrd + 0 * 64 + 1 * 2048 + 1024);
        s16x4 l10 = vtr(vrd + 1 * 64 + 0 * 2048), h10 = vtr(vrd + 1 * 64 + 0 * 2048 + 1024);
        s16x4 l11 = vtr(vrd + 1 * 64 + 1 * 2048), h11 = vtr(vrd + 1 * 64 + 1 * 2048 + 1024);
        asm volatile("s_waitcnt lgkmcnt(0)" ::: "memory");
#define PKV(l, hh) (bf16x8){l[0], l[1], l[2], l[3], hh[0], hh[1], hh[2], hh[3]}
        o0 = __builtin_amdgcn_mfma_f32_32x32x16_bf16(__builtin_bit_cast(bf16x8, wa0), PKV(l00, h00), o0, 0, 0, 0);
        o0 = __builtin_amdgcn_mfma_f32_32x32x16_bf16(__builtin_bit_cast(bf16x8, wa1), PKV(l01, h01), o0, 0, 0, 0);
        o1 = __builtin_amdgcn_mfma_f32_32x32x16_bf16(__builtin_bit_cast(bf16x8, wa0), PKV(l10, h10), o1, 0, 0, 0);
        o1 = __builtin_amdgcn_mfma_f32_32x32x16_bf16(__builtin_bit_cast(bf16x8, wa1), PKV(l11, h11), o1, 0, 0, 0);
#undef PKV
        if (__all(carry < 1e-30f)) break;
    }
    bf16* Op = YA + (size_t)q0 * AW + h * HD + r32;
#pragma unroll
    for (int r = 0; r < 16; ++r) { const int qr = crow(r, hi); Op[(size_t)qr * AW] = (bf16)f2bf(o0[r]); Op[(size_t)qr * AW + 32] = (bf16)f2bf(o1[r]); }
}

template <int N> __device__ __forceinline__ float tree_max(const float (&v)[N]) {
    float t[N];
#pragma unroll
    for (int i = 0; i < N; ++i) t[i] = v[i];
#pragma unroll
    for (int w = N; w > 1; w = (w + 2) / 3) {
#pragma unroll
        for (int i = 0; i < (w + 2) / 3; ++i) { const float a = t[3 * i], b = (3 * i + 1 < w) ? t[3 * i + 1] : a, c = (3 * i + 2 < w) ? t[3 * i + 2] : a; t[i] = fmaxf(fmaxf(a, b), c); }
    }
    return t[0];
}
template <int N> __device__ __forceinline__ float take_max(float (&v)[N]) {
    const float m = tree_max<N>(v);
    const float g = fmaxf(m, partner32(m));
#pragma unroll
    for (int i = 0; i < N; ++i) v[i] = (v[i] == g) ? -INFINITY : v[i];
    return g;
}
#define CEX(a, b) do { const float hi_ = fmaxf(a, b), lo_ = fminf(a, b); a = hi_; b = lo_; } while (0)
__device__ __forceinline__ void sort16_desc(float (&v)[16]) {
#pragma unroll
    for (int k = 2; k <= 16; k <<= 1)
#pragma unroll
        for (int j = k >> 1; j > 0; j >>= 1)
#pragma unroll
            for (int i = 0; i < 16; ++i) { const int l = i ^ j; if (l > i) { if ((i & k) == 0) CEX(v[i], v[l]); else CEX(v[l], v[i]); } }
}
__device__ __forceinline__ void merge_top16(float (&a)[16], const float (&b)[16]) {
#pragma unroll
    for (int i = 0; i < 16; ++i) a[i] = fmaxf(a[i], b[15 - i]);
#pragma unroll
    for (int j = 8; j > 0; j >>= 1)
#pragma unroll
        for (int i = 0; i < 16; ++i) { const int l = i ^ j; if (l > i) CEX(a[i], a[l]); }
}
__device__ __forceinline__ void top16_of_pair(const float (&sc)[64], float (&out)[16]) {
    float g0[16], g1[16], g2[16], g3[16];
#pragma unroll
    for (int i = 0; i < 16; ++i) { g0[i] = sc[i]; g1[i] = sc[16 + i]; g2[i] = sc[32 + i]; g3[i] = sc[48 + i]; }
    sort16_desc(g0); sort16_desc(g1); sort16_desc(g2); sort16_desc(g3);
    merge_top16(g0, g1); merge_top16(g2, g3); merge_top16(g0, g2);
    float p[16];
#pragma unroll
    for (int i = 0; i < 16; ++i) p[i] = partner32(g0[i]);
    merge_top16(g0, p);
#pragma unroll
    for (int i = 0; i < 16; ++i) out[i] = g0[i];
}
struct constexpr_ij { int i, j; };
__host__ __device__ constexpr constexpr_ij cand_ij(int k) {
    int n = 0;
    for (int i = 0; i < 16; ++i) for (int j = 0; j < 16; ++j) if ((i + 1) * (j + 1) <= 16) { if (n == k) return constexpr_ij{i, j}; ++n; }
    return constexpr_ij{0, 0};
}
__device__ __forceinline__ void topk_task(const bf16* QP, const bf16* SK, int* IDX, float* GATE, int tt, int h, int lane) {
    const int r32 = lane & 31, hi = lane >> 5, t = tt * 32 + r32;
    float top[2][16];
#pragma unroll
    for (int side = 0; side < 2; ++side) {
        const bf16* Qp = QP + (size_t)t * D + h * PQD + side * PHALF + 8 * hi;
        bf16x8 qf[8];
#pragma unroll
        for (int s = 0; s < 8; ++s) qf[s] = *(const bf16x8*)(Qp + 16 * s);
        float sc[64];
#pragma unroll
        for (int kb = 0; kb < 4; ++kb) {
            const bf16* Kp = SK + (size_t)(side * PKEYS + kb * 32 + r32) * PHALF + 8 * hi;
            asm volatile("" : "+v"(Kp));
            f32x16 S;
#pragma unroll
            for (int r = 0; r < 16; ++r) S[r] = 0.f;
#pragma unroll
            for (int s = 0; s < 8; ++s) { const bf16x8 kf = *(const bf16x8*)(Kp + 16 * s); S = __builtin_amdgcn_mfma_f32_32x32x16_bf16(kf, qf[s], S, 0, 0, 0); }
#pragma unroll
            for (int r = 0; r < 16; ++r) { const unsigned key = (unsigned)(kb * 32 + crow(r, hi)); sc[kb * 16 + r] = __uint_as_float((__float_as_uint(S[r]) & ~127u) | (127u - key)); }
            asm volatile("" ::: "memory");
        }
        top16_of_pair(sc, top[side]);
        asm volatile("" ::: "memory");
    }
    asm volatile("" ::: "memory");
    float cv[25]; int ci[25];
#pragma unroll
    for (int k = 0; k < 25; ++k) {
        constexpr_ij c0 = cand_ij(k), c1 = cand_ij(k + 25);
        const float a = hi ? top[0][c1.i] : top[0][c0.i], b = hi ? top[1][c1.j] : top[1][c0.j];
        const float s = a + b;
        cv[k] = __uint_as_float((__float_as_uint(s) & ~63u) | (unsigned)(hi ? 63 - (k + 25) : 63 - k));
        ci[k] = (int)(127u - (__float_as_uint(a) & 127u)) * PKEYS + (int)(127u - (__float_as_uint(b) & 127u));
    }
    float sv[16]; int si[16];
#pragma unroll
    for (int k = 0; k < 16; ++k) {
        const float m = tree_max<25>(cv);
        const float g = fmaxf(m, partner32(m));
        int id = 0;
#pragma unroll
        for (int i = 0; i < 25; ++i) { const bool hit = (cv[i] == g); id = hit ? ci[i] : id; cv[i] = hit ? -INFINITY : cv[i]; }
        const int pid = partner32i(id);
        sv[k] = g; si[k] = id > pid ? id : pid;
    }
    float ex[16], sum = 0.f;
#pragma unroll
    for (int k = 0; k < 16; ++k) { ex[k] = __expf(sv[k] - sv[0]); sum += ex[k]; }
    const float rs = 1.f / sum;
    if (!hi) {
        int* ip = IDX + (size_t)t * NPAIR + h * PTOPK;
#pragma unroll
        for (int k = 0; k < 16; k += 4) *(int4*)(ip + k) = make_int4(si[k], si[k + 1], si[k + 2], si[k + 3]);
    } else {
        float* gp = GATE + (size_t)t * NPAIR + h * PTOPK;
#pragma unroll
        for (int k = 0; k < 16; k += 4) *(f32x4*)(gp + k) = (f32x4){ex[k] * rs, ex[k + 1] * rs, ex[k + 2] * rs, ex[k + 3] * rs};
    }
}

struct SortIn { int id0, id1; float g0, g1; v4u x[4]; float ssq; };
__device__ __forceinline__ void sortq_load(SortIn& in, const bf16* X1B, const float* SSQ, const int* IDX, const float* GATE, int t, int lane) {
    in.id0 = IDX[(size_t)t * NPAIR + lane]; in.id1 = IDX[(size_t)t * NPAIR + 64 + lane];
    in.g0 = GATE[(size_t)t * NPAIR + lane]; in.g1 = GATE[(size_t)t * NPAIR + 64 + lane];
    const v4u* xr = (const v4u*)(X1B + (size_t)t * D) + lane;
#pragma unroll
    for (int j = 0; j < 4; ++j) in.x[j] = xr[64 * j];
    in.ssq = SSQ[t];
}
__device__ __forceinline__ void sortq_token(const SortIn& in, unsigned short* ES, unsigned short* ESG, float* GS, unsigned short* OFFN, float* SXS, unsigned char* XQ, int t, int lane) {
    const int id0 = in.id0, id1 = in.id1; const float g0 = in.g0, g1 = in.g1;
    const int k0 = egroup(id0), k1 = egroup(id1);
    int off = 0, pos0 = 0, pos1 = 0, myoffn = 0, rk0 = 0, rk1 = 0;
#pragma unroll
    for (int g = 0; g < NG; ++g) {
        const unsigned long long m0 = __ballot(k0 == g), m1 = __ballot(k1 == g);
        const int c0 = __popcll(m0), c1 = __popcll(m1);
        const int r0 = __builtin_amdgcn_mbcnt_hi((unsigned)(m0 >> 32), __builtin_amdgcn_mbcnt_lo((unsigned)m0, 0));
        const int r1 = __builtin_amdgcn_mbcnt_hi((unsigned)(m1 >> 32), __builtin_amdgcn_mbcnt_lo((unsigned)m1, 0));
        if (k0 == g) { pos0 = off + r0; rk0 = r0; }
        if (k1 == g) { pos1 = off + c0 + r1; rk1 = c0 + r1; }
        if (lane == g) myoffn = off | ((c0 + c1) << 8);
        off += c0 + c1;
    }
    ES[(size_t)t * NPAIR + pos0] = (unsigned short)id0; ES[(size_t)t * NPAIR + pos1] = (unsigned short)id1;
    if (rk0 < 16) ESG[((size_t)t * NG + k0) * 16 + rk0] = (unsigned short)id0;
    if (rk1 < 16) ESG[((size_t)t * NG + k1) * 16 + rk1] = (unsigned short)id1;
    GS[(size_t)t * NPAIR + pos0] = g0; GS[(size_t)t * NPAIR + pos1] = g1;
    if (lane < NG) OFFN[(size_t)t * NG + lane] = (unsigned short)myoffn;
    const float inv_rms = 1.0f / sqrtf(in.ssq * (1.f / D) + RMS_EPS);
#pragma unroll
    for (int j = 0; j < 4; ++j) {
        const v4u xv = in.x[j];
        float f[8] = {bflo(xv.x), bfhi(xv.x), bflo(xv.y), bfhi(xv.y), bflo(xv.z), bfhi(xv.z), bflo(xv.w), bfhi(xv.w)};
        float m = 0.f;
#pragma unroll
        for (int i = 0; i < 8; ++i) m = fmaxf(m, fabsf(f[i]));
        m = fmaxf(m, __shfl_xor(m, 1)); m = fmaxf(m, __shfl_xor(m, 2)); m = fmaxf(m, __shfl_xor(m, 4)); m = fmaxf(m, __shfl_xor(m, 8));
        const float inv = m > 0.f ? 127.f / m : 0.f;
        unsigned w0 = 0, w1 = 0;
#pragma unroll
        for (int i = 0; i < 4; ++i) { w0 |= ((unsigned)((int)rintf(f[i] * inv) & 255)) << (8 * i); w1 |= ((unsigned)((int)rintf(f[4 + i] * inv) & 255)) << (8 * i); }
        *(u32x2*)(XQ + (size_t)t * D + 512 * j + 8 * lane) = (u32x2){w0, w1};
        if ((lane & 15) == 0) SXS[(size_t)t * NS + 4 * j + (lane >> 4)] = m * (1.f / 127.f) * inv_rms;
    }
}

#define U_DPPDOT(C) asm volatile("v_dot4c_i32_i8_dpp %0, %4, %8 row_ror:" #C " row_mask:0xf bank_mask:0xf\n\tv_dot4c_i32_i8_dpp %1, %5, %9 row_ror:" #C " row_mask:0xf bank_mask:0xf\n\t" \
        "v_dot4c_i32_i8_dpp %2, %6, %10 row_ror:" #C " row_mask:0xf bank_mask:0xf\n\tv_dot4c_i32_i8_dpp %3, %7, %11 row_ror:" #C " row_mask:0xf bank_mask:0xf" \
        : "+v"(a0_), "+v"(a1_), "+v"(a2_), "+v"(a3_) : "v"(xv_.x), "v"(xv_.y), "v"(xv_.z), "v"(xv_.w), "v"(tb_[C].x), "v"(tb_[C].y), "v"(tb_[C].z), "v"(tb_[C].w))
__device__ __forceinline__ void peer_u_role(const unsigned char* UQ, const float* SU, const unsigned char* XQ, const float* SXS, const unsigned short* ES, const unsigned short* ESG, const unsigned short* OFFN, float* PART,
                                            LAS unsigned char* lds, int role, int wave, int lane, int tid) {
    const int s = role & (NS - 1), g = role >> 4;
    __syncthreads();
    {
        const v4u* src = (const v4u*)(UQ + (size_t)role * EG * DW);
#pragma unroll 4
        for (int i = tid; i < EG * DW / 16; i += NWAVES * 64) *(LAS v4u*)(lds + (size_t)i * 16) = src[i];
        const float* ssrc = SU + (size_t)role * EG;
        for (int i = tid; i < EG; i += NWAVES * 64) *(LAS float*)(lds + LDS_SU_OFF + i * 4) = ssrc[i];
    }
    __syncthreads();
    STAMP(20);
    const int ts = lane >> 4, k = lane & 15, cid = lane & 7;
    float* part = PART + (size_t)s * T * NPAIR;
    int coff[8];
#pragma unroll
    for (int c_ = 0; c_ < 8; ++c_) coff[c_] = ((cid - c_) & 7) * 16;
    const unsigned tt0 = (unsigned)(4 * wave + ts);
    unsigned o_of = (tt0 * NG + g) * 2u, o_e = ((tt0 * NG + g) * 16u + k) * 2u, o_x = tt0 * D + s * DW + 16u * cid, o_s = (tt0 * NS + s) * 4u;
    const unsigned char* bOF = (const unsigned char*)OFFN; const unsigned char* bE = (const unsigned char*)ESG; const unsigned char* bS = (const unsigned char*)SXS;
#define U_TQ(I) (wave + NWAVES * (I))
#define U_LOAD(I, OF, E, XV, SX) do { OF = *(const unsigned short*)(bOF + o_of); E = *(const unsigned short*)(bE + o_e); XV = *(const v4u*)(XQ + o_x); SX = *(const float*)(bS + o_s); \
        o_of += 4 * NWAVES * NG * 2; o_e += 4 * NWAVES * NG * 32; o_x += 4 * NWAVES * D; o_s += 4 * NWAVES * NS * 4; } while (0)
#define U_DOT(ACC, EV, XV, ACTIVE) do { LAS const unsigned char* rowp_ = lds + erow((int)(EV)) * DW; v4u tb_[8]; const v4u xv_ = (XV); \
        _Pragma("unroll") for (int c_ = 0; c_ < 8; ++c_) tb_[c_] = (v4u){0u, 0u, 0u, 0u}; \
        if (ACTIVE) { _Pragma("unroll") for (int c_ = 0; c_ < 8; ++c_) tb_[c_] = *(const LAS v4u*)(rowp_ + coff[c_]); } \
        int a0_ = 0, a1_ = 0, a2_ = 0, a3_ = 0; \
        asm volatile("s_nop 4\n\tv_dot4c_i32_i8 %0, %4, %8\n\tv_dot4c_i32_i8 %1, %5, %9\n\tv_dot4c_i32_i8 %2, %6, %10\n\tv_dot4c_i32_i8 %3, %7, %11" \
            : "+v"(a0_), "+v"(a1_), "+v"(a2_), "+v"(a3_) : "v"(xv_.x), "v"(xv_.y), "v"(xv_.z), "v"(xv_.w), "v"(tb_[0].x), "v"(tb_[0].y), "v"(tb_[0].z), "v"(tb_[0].w)); \
        U_DPPDOT(1); U_DPPDOT(2); U_DPPDOT(3); U_DPPDOT(4); U_DPPDOT(5); U_DPPDOT(6); U_DPPDOT(7); ACC = (a0_ + a1_) + (a2_ + a3_); } while (0)
#define U_COMP(I, OF, E, XV, SX) do { const int t_ = 4 * U_TQ(I) + ts; const int j0_ = (OF) & 255, n_ = (OF) >> 8; int acc_; U_DOT(acc_, E, XV, k < n_); \
        const float su_ = *(const LAS float*)(lds + LDS_SU_OFF + erow((int)(E)) * 4); \
        if (k < n_) part[(size_t)t_ * NPAIR + j0_ + k] = (float)acc_ * su_ * (SX); } while (0)
    unsigned of0, of1, of2, of3, of4, of5, of6, of7, e0, e1, e2, e3, e4, e5, e6, e7; v4u x0, x1, x2, x3, x4, x5, x6, x7; float s0, s1, s2, s3, s4, s5, s6, s7;
    U_LOAD(0, of0, e0, x0, s0); U_LOAD(1, of1, e1, x1, s1); U_LOAD(2, of2, e2, x2, s2); U_LOAD(3, of3, e3, x3, s3);
#pragma unroll 1
    for (int it = 0; it < T / 4 / NWAVES; it += 8) {
        U_LOAD(it + 4, of4, e4, x4, s4); U_COMP(it, of0, e0, x0, s0); __builtin_amdgcn_sched_barrier(0);
        U_LOAD(it + 5, of5, e5, x5, s5); U_COMP(it + 1, of1, e1, x1, s1); __builtin_amdgcn_sched_barrier(0);
        U_LOAD(it + 6, of6, e6, x6, s6); U_COMP(it + 2, of2, e2, x2, s2); __builtin_amdgcn_sched_barrier(0);
        U_LOAD(it + 7, of7, e7, x7, s7); U_COMP(it + 3, of3, e3, x3, s3); __builtin_amdgcn_sched_barrier(0);
        U_LOAD(it + 8, of0, e0, x0, s0); U_COMP(it + 4, of4, e4, x4, s4); __builtin_amdgcn_sched_barrier(0);
        U_LOAD(it + 9, of1, e1, x1, s1); U_COMP(it + 5, of5, e5, x5, s5); __builtin_amdgcn_sched_barrier(0);
        U_LOAD(it + 10, of2, e2, x2, s2); U_COMP(it + 6, of6, e6, x6, s6); __builtin_amdgcn_sched_barrier(0);
        U_LOAD(it + 11, of3, e3, x3, s3); U_COMP(it + 7, of7, e7, x7, s7); __builtin_amdgcn_sched_barrier(0);
    }
    STAMP(21);
    {
        unsigned ofl[16];
#pragma unroll
        for (int b16 = 0; b16 < 16; ++b16) { const int i_ = b16 * 64 + lane; const int t_l = 4 * (wave + NWAVES * (i_ >> 2)) + (i_ & 3); ofl[b16] = OFFN[(size_t)t_l * NG + g]; }
#pragma unroll
        for (int b16 = 0; b16 < 16; ++b16) {
            const int i_ = b16 * 64 + lane; const int t_l = 4 * (wave + NWAVES * (i_ >> 2)) + (i_ & 3);
            const unsigned of_l = ofl[b16];
            unsigned long long mask = __ballot((of_l >> 8) > 16u);
            while (mask) {
                const int b = __builtin_ctzll(mask); mask &= mask - 1;
                const int t_o = __builtin_amdgcn_readlane(t_l, b); const unsigned of_o = (unsigned)__builtin_amdgcn_readlane((int)of_l, b);
                const int j0_ = of_o & 255, n_ = of_o >> 8;
                const v4u xo = *(const v4u*)(XQ + (size_t)t_o * D + s * DW + 16 * cid); const float so = SXS[(size_t)t_o * NS + s];
                for (int kk = 16 + 16 * ts + k; __any(kk < n_); kk += 64) {
                    const unsigned e2 = (kk < n_) ? ES[(size_t)t_o * NPAIR + j0_ + kk] : 0u; int a2; U_DOT(a2, e2, xo, kk < n_);
                    const float su2 = *(const LAS float*)(lds + LDS_SU_OFF + erow((int)e2) * 4);
                    if (kk < n_) part[(size_t)t_o * NPAIR + j0_ + kk] = (float)a2 * su2 * so;
                }
            }
        }
    }
    STAMP(23);
#undef U_LOAD
#undef U_TQ
#undef U_DOT
#undef U_COMP
}

__device__ __forceinline__ void peer_reduce_tile(const float* PART, const float* GS, const unsigned short* ES, const float* SV, unsigned* E32, unsigned char* A8, float* TS, int tile, int tid) {
    const int t = tile * 32 + (tid >> 4), sidx = tid & 15, jb = sidx * 8; const size_t base = (size_t)t * NPAIR + jb;
    f32x4 h0 = (f32x4){0.f, 0.f, 0.f, 0.f}, h1 = h0;
#pragma unroll
    for (int sl = 0; sl < NS; ++sl) { const float* p = PART + (size_t)sl * T * NPAIR + base; h0 += *(const f32x4*)p; h1 += *(const f32x4*)(p + 4); }
    const f32x4 ga = *(const f32x4*)(GS + base), gb = *(const f32x4*)(GS + base + 4);
    const v4u ev = *(const v4u*)(ES + base);
    const float hh[8] = {h0.x, h0.y, h0.z, h0.w, h1.x, h1.y, h1.z, h1.w}; const float gg[8] = {ga.x, ga.y, ga.z, ga.w, gb.x, gb.y, gb.z, gb.w};
    const unsigned ee[8] = {ev.x & 0xffffu, ev.x >> 16, ev.y & 0xffffu, ev.y >> 16, ev.z & 0xffffu, ev.z >> 16, ev.w & 0xffffu, ev.w >> 16};
    float a[8]; float m = 0.f;
#pragma unroll
    for (int i = 0; i < 8; ++i) { const float h = hh[i]; a[i] = 0.5f * h * (1.f + erff(h * 0.70710678118654752f)) * gg[i] * SV[ee[i]]; m = fmaxf(m, fabsf(a[i])); }
    m = fmaxf(m, __shfl_xor(m, 1)); m = fmaxf(m, __shfl_xor(m, 2)); m = fmaxf(m, __shfl_xor(m, 4)); m = fmaxf(m, __shfl_xor(m, 8));
    const float inv = m > 0.f ? 127.f / m : 0.f;
    unsigned w0 = 0, w1 = 0;
#pragma unroll
    for (int i = 0; i < 4; ++i) { w0 |= ((unsigned)((int)rintf(a[i] * inv) & 255)) << (8 * i); w1 |= ((unsigned)((int)rintf(a[4 + i] * inv) & 255)) << (8 * i); }
    *(u32x2*)(A8 + base) = (u32x2){w0, w1};
    if (sidx == 0) TS[t] = m * (1.f / 127.f);
#pragma unroll
    for (int q = 0; q < 8; ++q) E32[(size_t)t * NPAIR + q * 16 + sidx] = ee[q] * 8u;
}

#ifndef TR_MAP
#define TR_MAP 0
#endif
typedef int v2i_t __attribute__((ext_vector_type(2)));
__device__ __forceinline__ void peer_v_role(const unsigned char* VQ, const unsigned* E32, const unsigned char* A8, const float* TS, const bf16* X1B, float* X  , float* SSQ2,
                                            LAS unsigned char* lds, int c, int wave, int lane, int tid) {
    __syncthreads();
    {
        const v4u* src = (const v4u*)(VQ + (size_t)c * NEXP * 8);
#pragma unroll 4
        for (int i = tid; i < NEXP * 8 / 16; i += NWAVES * 64) *(LAS v4u*)(lds + (size_t)i * 16) = src[i];
    }
    __syncthreads();
    STAMP(22);
    const int G16 = lane >> 4, L = lane & 15;
    const int sq = (TR_MAP == 0) ? (L >> 1) : (L & 7), sp = (TR_MAP == 0) ? (L & 1) : (L >> 3);
    const int rp = L >> 3, rd = L & 7;
    LAS unsigned char* stg = lds + LDS_SU_OFF + wave * 2304;
    LAS unsigned char* stw = stg + (lane >> 3) * 144 + (lane & 7) * 16;
    LAS const unsigned char* str = stg + (2 * G16 + rp) * 144;
    const unsigned char* bE = (const unsigned char*)E32; const unsigned char* bX = (const unsigned char*)X1B; const unsigned char* bT = (const unsigned char*)TS;
    const unsigned oE0 = ((unsigned)(2 * G16 + sp) * NPAIR + sq * 16) * 4u, oA0 = (unsigned)(lane >> 3) * NPAIR + (lane & 7) * 16u, oX0 = ((unsigned)(2 * G16 + rp) * D + 8 * c + rd) * 2u, oT0 = (unsigned)(2 * G16 + rp) * 4u;
#define V_LD(IT, ES, AV, XS, SS) do { const unsigned it_ = (unsigned)(IT); \
        const v4u* ep_ = (const v4u*)(bE + (oE0 + it_ * (8u * NPAIR * 4u))); ES[0] = ep_[0]; ES[1] = ep_[1]; ES[2] = ep_[2]; ES[3] = ep_[3]; \
        AV = *(const v4u*)(A8 + (oA0 + it_ * (8u * NPAIR))); \
        XS = *(const unsigned short*)(bX + (oX0 + it_ * (8u * D * 2u))); SS = *(const float*)(bT + (oT0 + it_ * 32u)); } while (0)
#define V_TR(EO) __builtin_amdgcn_ds_read_tr8_b64_v2i32((LAS v2i_t*)(unsigned)(EO))
#define V_DO(IT, ES, AV, XS, SS, BUF) do { *(LAS v4u*)(stw + (BUF) * 1152) = AV; \
        v2i_t r_[16]; v4u a_[8]; \
        r_[0] = V_TR(ES[0].x); r_[1] = V_TR(ES[0].y); r_[2] = V_TR(ES[0].z); r_[3] = V_TR(ES[0].w); r_[4] = V_TR(ES[1].x); r_[5] = V_TR(ES[1].y); r_[6] = V_TR(ES[1].z); r_[7] = V_TR(ES[1].w); \
        r_[8] = V_TR(ES[2].x); r_[9] = V_TR(ES[2].y); r_[10] = V_TR(ES[2].z); r_[11] = V_TR(ES[2].w); r_[12] = V_TR(ES[3].x); r_[13] = V_TR(ES[3].y); r_[14] = V_TR(ES[3].z); r_[15] = V_TR(ES[3].w); \
        _Pragma("unroll") for (int k_ = 0; k_ < 8; ++k_) a_[k_] = *(const LAS v4u*)(str + (BUF) * 1152 + k_ * 16); \
        __builtin_amdgcn_sched_barrier(0); \
        int acc = 0, acc2 = 0; \
        _Pragma("unroll") for (int k_ = 0; k_ < 8; ++k_) { acc = __builtin_amdgcn_sdot4((int)a_[k_].x, r_[2 * k_].x, acc, false); acc2 = __builtin_amdgcn_sdot4((int)a_[k_].y, r_[2 * k_].y, acc2, false); \
            acc = __builtin_amdgcn_sdot4((int)a_[k_].z, r_[2 * k_ + 1].x, acc, false); acc2 = __builtin_amdgcn_sdot4((int)a_[k_].w, r_[2 * k_ + 1].y, acc2, false); } \
        const float y_ = __uint_as_float((unsigned)(XS) << 16) + (float)(acc + acc2) * (SS); \
        *(float*)((unsigned char*)X + (oX0 * 2u + (unsigned)(IT) * (8u * D * 4u))) = y_; float ss_ = y_ * y_; ss_ += __int_as_float(__builtin_amdgcn_mov_dpp(__float_as_int(ss_), 0xB1, 0xf, 0xf, false)); ss_ += __int_as_float(__builtin_amdgcn_mov_dpp(__float_as_int(ss_), 0x4E, 0xf, 0xf, false)); \
        ss_ += __int_as_float(__builtin_amdgcn_mov_dpp(__float_as_int(ss_), 0x141, 0xf, 0xf, false)); \
        *(float*)((unsigned char*)SSQ2 + (((unsigned)(2 * G16 + rp) * (D / 8) + c) * 4u + (unsigned)(IT) * (8u * (D / 8) * 4u))) = ss_; } while (0)
    v4u eA[4], eB[4], eC[4], eD[4], aA, aB, aC, aD; unsigned short xA, xB, xC, xD; float sA, sB, sC, sD;
#define V_IT(I) ((I) < T / 8 ? (I) : T / 8 - 1)
    V_LD(V_IT(wave), eA, aA, xA, sA); V_LD(V_IT(wave + NWAVES), eB, aB, xB, sB); V_LD(V_IT(wave + 2 * NWAVES), eC, aC, xC, sC);
#pragma unroll 1
    for (int it = wave; it < T / 8; it += 4 * NWAVES) {
        V_LD(V_IT(it + 3 * NWAVES), eD, aD, xD, sD); V_DO(it, eA, aA, xA, sA, 0);
        V_LD(V_IT(it + 4 * NWAVES), eA, aA, xA, sA); V_DO(it + NWAVES, eB, aB, xB, sB, 1);
        V_LD(V_IT(it + 5 * NWAVES), eB, aB, xB, sB); V_DO(it + 2 * NWAVES, eC, aC, xC, sC, 0);
        V_LD(V_IT(it + 6 * NWAVES), eC, aC, xC, sC); V_DO(it + 3 * NWAVES, eD, aD, xD, sD, 1);
    }
#undef V_IT
#undef V_LD
#undef V_TR
#undef V_DO
    STAMP(24);
}
__device__ __forceinline__ void final_norm_row(float* X, const float* SSQP, const float* gfin, int t, int lane) {
    const f32x4 pp = *((const f32x4*)(SSQP + (size_t)t * (D / 8)) + lane);
    const float inv = 1.0f / sqrtf(wave_sum((pp.x + pp.y) + (pp.z + pp.w)) * (1.f / D) + RMS_EPS);
    f32x4* xr = (f32x4*)(X + (size_t)t * D) + lane; const f32x4* gr = (const f32x4*)gfin + lane;
    f32x4 v[8];
#pragma unroll
    for (int j = 0; j < 8; ++j) v[j] = xr[64 * j];
#pragma unroll
    for (int j = 0; j < 8; ++j) { const f32x4 g = gr[64 * j]; xr[64 * j] = (f32x4){v[j].x * inv * g.x, v[j].y * inv * g.y, v[j].z * inv * g.z, v[j].w * inv * g.w}; }
}

#ifndef PHASE_MASK
#define PHASE_MASK 0x1ff
#endif
#define PH_ON(k) ((PHASE_MASK >> (k)) & 1)
#ifndef REP_MASK
#define REP_MASK 0
#endif
#define PH_REP(k) (1 + ((REP_MASK >> (k)) & 1))
__device__ __forceinline__ Ptrs load_args() {
#if defined(__HIP_DEVICE_COMPILE__)
    const __attribute__((address_space(4))) Ptrs* pp = (const __attribute__((address_space(4))) Ptrs*)__builtin_amdgcn_kernarg_segment_ptr();
    asm volatile("" : "+s"(pp));
    Ptrs r;
    r.x = pp->x; r.norm_mix = pp->norm_mix; r.w_in = pp->w_in; r.conv_w = pp->conv_w; r.w_conv_out = pp->w_conv_out; r.w_attn_out = pp->w_attn_out; r.w_out = pp->w_out; r.norm_ffn = pp->norm_ffn;
    r.peer_wq = pp->peer_wq; r.peer_sk = pp->peer_sk; r.peer_u = pp->peer_u; r.peer_v = pp->peer_v; r.norm_final = pp->norm_final; r.out = pp->out; r.ws = pp->ws;
    return r;
#else
    return Ptrs{};
#endif
}
__global__ void __launch_bounds__(NWAVES * 64, 2) hyb_fwd(Ptrs Punused) {
    extern __shared__ __attribute__((aligned(16))) unsigned char lds_raw[];
    LAS unsigned char* lds = (LAS unsigned char*)lds_raw;
    const int G = gridDim.x; const int bx = blockIdx.x; const int vcu = (G % 8 == 0) ? (bx % 8) * (G / 8) + bx / 8 : bx;
#define TIDV int tid_ = threadIdx.x; asm volatile("" : "+v"(tid_)); const int tid = tid_, lane = tid & 63, wave = __builtin_amdgcn_readfirstlane(tid >> 6); const int gw = vcu * NWAVES + wave, NGW = G * NWAVES; (void)gw; (void)NGW; (void)lane;
    XcdBarrier bar;
    {
        TIDV; const Ptrs P = load_args();
        volatile LAS unsigned* MISC = (volatile LAS unsigned*)(lds + MISC_OFF);
        for (int u = tid; u < 128; u += NWAVES * 64) ((LAS unsigned*)(lds + LDSCTL_OFF))[u] = 0u;
        __syncthreads();
        bar = xcd_barrier_post((unsigned*)(P.ws + WS_CTL) + CW_BAR, MISC + 8);
    }
#define CTLP ((unsigned*)(P.ws + WS_CTL))
    STAMP(0);

    if (PH_ON(0)) { TIDV; const Ptrs P = load_args(); p0_prologue(P, lds, vcu, G, wave, lane, tid); }
    xcd_barrier(bar);
    { TIDV; const Ptrs P = load_args(); p0_win_i8(P, lds, vcu, G, wave, lane); }
    xcd_barrier(bar);
    STAMP(1);

    if (PH_ON(1)) {
        const Ptrs P = load_args();
        pg8::Gemm g{(const pg8::bf16_t*)(P.ws + WS_XN), (const pg8::bf16_t*)(P.ws + WS_WIN), T, INW, D}; pg8::StaticOrder S; S.init(T, INW, G, bx);
        pg8::EpiStoreI8 E{(pg8::bf16_t*)(P.ws + WS_PROJ), INW, (const float*)(P.ws + WS_SA), (const float*)(CTLP + CW_COLMAX)};
        pg8::gemm_phase<pg8::EpiStoreI8, pg8::StaticOrder, true, true, true>(lds + RING_OFF, g, S, E);
    }
    xcd_barrier(bar);
    STAMP(2);

    if (PH_ON(2)) {
        TIDV; const Ptrs P = load_args();
        p2_conv(P, gw * 64 + lane, NGW * 64);
        const bf16* PROJ = (const bf16*)(P.ws + WS_PROJ); bf16* YA = (bf16*)(P.ws + WS_YA);
        LAS unsigned char* vl = lds + RING_OFF + wave * 4096;
        constexpr int NTASK = (T / 32) * NH;
        for (int it = gw; it < NTASK; it += NGW) { const int task = NTASK - 1 - it; attn_task(PROJ, YA, vl, task / NH, task % NH, lane); }
    }
    xcd_barrier(bar);
    STAMP(3);

    if (PH_ON(3)) {
        pg8::StaticOrder S; S.init(T, D, G, bx);
        { const Ptrs P = load_args();
          pg8::Gemm g{(const pg8::bf16_t*)(P.ws + WS_YC), (const pg8::bf16_t*)(P.ws + WS_WCO), T, D, CW};
          pg8::EpiGate<0> E{(const pg8::bf16_t*)(P.ws + WS_PROJ) + C_GC, INW, (pg8::bf16_t*)(P.ws + WS_XN), D};
          pg8::gemm_phase<pg8::EpiGate<0>, pg8::StaticOrder, true, true>(lds + RING_OFF, g, S, E); }
        { const Ptrs P = load_args();
          pg8::Gemm g{(const pg8::bf16_t*)(P.ws + WS_YA), (const pg8::bf16_t*)(P.ws + WS_WAO), T, D, AW};
          pg8::EpiGate<1> E{(const pg8::bf16_t*)(P.ws + WS_PROJ) + C_GA, INW, (pg8::bf16_t*)(P.ws + WS_XN), D};
          pg8::gemm_phase<pg8::EpiGate<1>, pg8::StaticOrder, true, true>(lds + RING_OFF, g, S, E); }
    }
    xcd_barrier(bar);
    STAMP(4);

    if (PH_ON(4)) {
        const Ptrs P = load_args();
        pg8::Gemm g{(const pg8::bf16_t*)(P.ws + WS_XN), (const pg8::bf16_t*)(P.ws + WS_WO), T, D, D}; pg8::StaticOrder S; S.init(T, D, G, bx);
        pg8::EpiX1 E{P.x, (pg8::bf16_t*)(P.ws + WS_X1B), (float*)(CTLP + CW_SSQ), D};
        pg8::gemm_phase<pg8::EpiX1, pg8::StaticOrder, true, true>(lds + RING_OFF, g, S, E);
    }
    xcd_barrier(bar);
    STAMP(5);

    if (PH_ON(5)) {
        const Ptrs P = load_args();
        pg8::Gemm g{(const pg8::bf16_t*)(P.ws + WS_X1B), (const pg8::bf16_t*)(P.ws + WS_WQ), T, D, D}; pg8::StaticOrder S; S.init(T, D, G, bx);
        pg8::EpiQP E{(const float*)(CTLP + CW_SSQ), (pg8::bf16_t*)(P.ws + WS_QP), D, 1.f / D, RMS_EPS};
        pg8::gemm_phase<pg8::EpiQP, pg8::StaticOrder, true, true>(lds + RING_OFF, g, S, E);
    }
    xcd_barrier(bar);
    STAMP(6);

    if (PH_ON(6)) {
        TIDV; const Ptrs P = load_args();
        constexpr int NTASK = (T / 32) * PH;
        for (int it = gw; it < NTASK; it += NGW) topk_task((const bf16*)(P.ws + WS_QP), (const bf16*)(P.ws + WS_SK), (int*)(P.ws + WS_IDX), (float*)(P.ws + WS_GATE), it / PH, it % PH, lane);
    }
    xcd_barrier(bar);
    STAMP(7);

    {
        TIDV; const Ptrs P = load_args();
        const bf16* X1B_ = (const bf16*)(P.ws + WS_X1B); const float* SSQ_ = (const float*)(CTLP + CW_SSQ); const int* IDX_ = (const int*)(P.ws + WS_IDX); const float* GATE_ = (const float*)(P.ws + WS_GATE);
        SortIn i0, i1, i2, i3;
        const int t0 = gw, t1 = gw + NGW, t2 = gw + 2 * NGW, t3 = gw + 3 * NGW;
        if (t0 < T) sortq_load(i0, X1B_, SSQ_, IDX_, GATE_, t0, lane); if (t1 < T) sortq_load(i1, X1B_, SSQ_, IDX_, GATE_, t1, lane);
        if (t2 < T) sortq_load(i2, X1B_, SSQ_, IDX_, GATE_, t2, lane); if (t3 < T) sortq_load(i3, X1B_, SSQ_, IDX_, GATE_, t3, lane);
#define SQ_DO(IN, TT) if ((TT) < T) sortq_token(IN, (unsigned short*)(P.ws + WS_ES), (unsigned short*)(P.ws + WS_ESG), (float*)(P.ws + WS_GS), (unsigned short*)(P.ws + WS_OFFN), (float*)(P.ws + WS_SXS), P.ws + WS_XQ, TT, lane)
        SQ_DO(i0, t0); SQ_DO(i1, t1); SQ_DO(i2, t2); SQ_DO(i3, t3);
        for (int t = gw + 4 * NGW; t < T; t += NGW) { SortIn in; sortq_load(in, X1B_, SSQ_, IDX_, GATE_, t, lane); SQ_DO(in, t); }
#undef SQ_DO
    }
    xcd_barrier(bar);
    STAMP(8);
    {
        TIDV; const Ptrs P = load_args();
        for (int role = bx; role < NS * NG; role += G) peer_u_role(P.ws + WS_UQ, (const float*)(P.ws + WS_SU), P.ws + WS_XQ, (const float*)(P.ws + WS_SXS), (const unsigned short*)(P.ws + WS_ES), (const unsigned short*)(P.ws + WS_ESG),
                                                                  (const unsigned short*)(P.ws + WS_OFFN), (float*)(P.ws + WS_PART), lds, role, wave, lane, tid);
    }
    xcd_barrier(bar);
    STAMP(9);
    {
        TIDV; const Ptrs P = load_args();
        for (int tile = vcu; tile < T / 32; tile += G) peer_reduce_tile((const float*)(P.ws + WS_PART), (const float*)(P.ws + WS_GS), (const unsigned short*)(P.ws + WS_ES), (const float*)(P.ws + WS_SV), (unsigned*)(P.ws + WS_E32), P.ws + WS_A8, (float*)(P.ws + WS_TS), tile, tid);
    }
    xcd_barrier(bar);
    STAMP(10);

    if (PH_ON(8)) {
        TIDV; const Ptrs P = load_args();
        for (int c = vcu; c < D / 8; c += G) peer_v_role(P.ws + WS_VQ, (const unsigned*)(P.ws + WS_E32), P.ws + WS_A8, (const float*)(P.ws + WS_TS), (const bf16*)(P.ws + WS_X1B), P.out, (float*)(P.ws + WS_SSQP), lds, c, wave, lane, tid);
    }
    xcd_barrier(bar);
    STAMP(11);

    {
        TIDV; const Ptrs P = load_args();
        for (int t = gw; t < T; t += NGW) final_norm_row(P.out, (const float*)(P.ws + WS_SSQP), P.norm_final, t, lane);
    }
    if (PROBE_PHASE >= 0 && blockIdx.x == 0 && threadIdx.x == 0) {
        const unsigned long long now = __builtin_amdgcn_s_memrealtime();
        *(volatile LAS unsigned long long*)(lds + LDSCTL_OFF + 64 + 8 * 12) = now;
        const unsigned long long a = *(volatile LAS unsigned long long*)(lds + LDSCTL_OFF + 64 + 8 * PROBE_A);
        const unsigned long long b = *(volatile LAS unsigned long long*)(lds + LDSCTL_OFF + 64 + 8 * PROBE_B);
        const unsigned long long dt = (b - a) * 8ull;
        while (__builtin_amdgcn_s_memrealtime() - now < dt) __builtin_amdgcn_s_sleep(8);
    }
}

extern "C" void kernel_launch(void* const* d_in, const int* in_sizes, int n_in, void* d_out, int out_size, void* d_ws, size_t ws_size, hipStream_t stream) {
    static int grid = 0;
    if (grid == 0) {
        if (n_in != 13 || out_size != T * D || ws_size < WS_END) { fprintf(stderr, "kernel_launch: unexpected shapes (n_in %d out %d ws %zu)\n", n_in, out_size, ws_size); grid = -1; return; }
        int dev = 0, cus = 0, per_cu = 0;
        if (hipGetDevice(&dev) != hipSuccess || hipDeviceGetAttribute(&cus, hipDeviceAttributeMultiprocessorCount, dev) != hipSuccess) { grid = -1; return; }
        if (hipFuncSetAttribute((const void*)hyb_fwd, hipFuncAttributeMaxDynamicSharedMemorySize, LDS_BYTES) != hipSuccess) { fprintf(stderr, "kernel_launch: hipFuncSetAttribute failed\n"); grid = -1; return; }
        if (hipOccupancyMaxActiveBlocksPerMultiprocessor(&per_cu, (const void*)hyb_fwd, NWAVES * 64, LDS_BYTES) != hipSuccess || per_cu < 1) { fprintf(stderr, "kernel_launch: occupancy query says %d\n", per_cu); per_cu = 1; }
        (void)hipGetLastError();
        grid = cus;
    }
    if (grid < 0) return;
    (void)hipMemsetAsync((char*)d_ws + WS_CTL, 0, CTL_ZERO_BYTES, stream);
    Ptrs p{};
    p.x = (const float*)d_in[0]; p.norm_mix = (const float*)d_in[1]; p.w_in = (const float*)d_in[2]; p.conv_w = (const float*)d_in[3];
    p.w_conv_out = (const float*)d_in[4]; p.w_attn_out = (const float*)d_in[5]; p.w_out = (const float*)d_in[6]; p.norm_ffn = (const float*)d_in[7];
    p.peer_wq = (const float*)d_in[8]; p.peer_sk = (const float*)d_in[9]; p.peer_u = (const float*)d_in[10]; p.peer_v = (const float*)d_in[11]; p.norm_final = (const float*)d_in[12];
    p.out = (float*)d_out; p.ws = (unsigned char*)d_ws;
    void* args[] = {&p};
    hipError_t e = hipLaunchCooperativeKernel((const void*)hyb_fwd, dim3(grid), dim3(NWAVES * 64), args, LDS_BYTES, stream);
    if (e != hipSuccess) fprintf(stderr, "kernel_launch: cooperative launch failed: %s (grid %d)\n", hipGetErrorString(e), grid);
}
```

```cpp
#include <hip/hip_runtime.h>
#include <cstdio>
#include <cstdint>
__device__ __forceinline__ int hw_lane() { return (int)__builtin_amdgcn_mbcnt_hi(~0u, __builtin_amdgcn_mbcnt_lo(~0u, 0u)); }
namespace pg8 {
#define PG8_LAS __attribute__((address_space(3)))
typedef unsigned short bf16_t;
typedef short bf16x8 __attribute__((ext_vector_type(8)));
typedef float f32x4 __attribute__((ext_vector_type(4)));
typedef unsigned u32x4 __attribute__((ext_vector_type(4)));
constexpr int BM = 256, BK = 64, HALF = 128, HTB = HALF * BK * 2  , STAGE_BYTES = 8 * HTB, NXCD = 8, WGM = 8;

__host__ __device__ __forceinline__ int lds_byte(int r, int c) { const int st = (r >> 4) * 2 + (c >> 5), rr = r & 15, cc = c & 31, ob = rr * 64 + cc * 2; return st * 1024 + (ob ^ (((ob >> 9) & 1) << 5)); }
__host__ __device__ __forceinline__ void stage_rc(int b, int& R, int& C) { const int st = b / 1024, sb = b % 1024, swz = sb ^ (((sb >> 9) & 1) << 5); R = (st >> 1) * 16 + swz / 64; C = (st & 1) * 32 + (swz % 64) / 2; }
__host__ __device__ __forceinline__ int perm32(int rho) { const int n = rho >> 4, i = rho & 15; return 8 * (i >> 2) + 4 * n + (i & 3); }

struct Unit { int pm, pn; };
struct Gemm { const bf16_t* A; const bf16_t* Bt; int M, N, K; };

struct StaticOrder {
    int nM, nN, nwg, G, c;
    __host__ __device__ void init(int M, int N, int G_, int c_) { nM = M / BM; nN = N / BM; nwg = nM * nN; G = G_; c = c_; }
    __host__ __device__ bool next(int i, Unit& u) const {
        const long L = (long)i * G + c; if (L >= nwg) return false;
        int wgid = (int)L; { const int q = nwg / NXCD, r = nwg % NXCD, xcd = wgid % NXCD, off = wgid / NXCD; wgid = (xcd < r ? xcd * (q + 1) : r * (q + 1) + (xcd - r) * q) + off; }
        const int nig = WGM * nN, gid = wgid / nig, fm = gid * WGM, gsz = (nM - fm) < WGM ? (nM - fm) : WGM;
        u.pm = fm + ((wgid % nig) % gsz); u.pn = (wgid % nig) / gsz; return true;
    }
    __device__ __forceinline__ void a_ready(const Unit&) const {}
    __device__ __forceinline__ void done(const Unit&) const {}
};


typedef int i32x4 __attribute__((ext_vector_type(4)));
__device__ __forceinline__ unsigned cvt_pk_bf16(float lo, float hi) { unsigned r; asm volatile("v_cvt_pk_bf16_f32 %0, %1, %2" : "=v"(r) : "v"(lo), "v"(hi)); return r; }
__device__ __forceinline__ float bf_lo(unsigned w) { return __uint_as_float(w << 16); }
__device__ __forceinline__ float bf_hi(unsigned w) { return __uint_as_float(w & 0xffff0000u); }
__device__ __forceinline__ float sigmoidf_fast(float x) { return __builtin_amdgcn_rcpf(1.0f + __builtin_amdgcn_exp2f(-1.4426950408889634f * x)); }

struct EpiStore {
    static constexpr bool PERM = true, AFTER_DRAIN = false;
    bf16_t* O; int ldc;
    __device__ __forceinline__ void operator()(const f32x4 (&acc)[2][2][4][2], const Unit& u, int wr, int wc, int fr, int fq) const {
        const int row0 = u.pm * BM + wr * 64 + fr, col0 = u.pn * BM + wc * 32 + 8 * fq;
#pragma unroll
        for (int ai = 0; ai < 2; ++ai)
#pragma unroll
            for (int m = 0; m < 4; ++m) { bf16_t* rowp = O + (size_t)(row0 + ai * HALF + m * 16) * ldc + col0;
#pragma unroll
                for (int bj = 0; bj < 2; ++bj) { const f32x4 v0 = acc[ai][bj][m][0], v1 = acc[ai][bj][m][1];
                    u32x4 w; w.x = cvt_pk_bf16(v0[0], v0[1]); w.y = cvt_pk_bf16(v0[2], v0[3]); w.z = cvt_pk_bf16(v1[0], v1[1]); w.w = cvt_pk_bf16(v1[2], v1[3]);
                    *(u32x4*)(rowp + bj * HALF) = w; } }
    }
};
struct EpiStoreI8 {
    static constexpr bool PERM = true, AFTER_DRAIN = false;
    bf16_t* O; int ldc; const float* SA; const float* SB;
    __device__ __forceinline__ void operator()(const f32x4 (&acc)[2][2][4][2], const Unit& u, int wr, int wc, int fr, int fq) const {
        const int row0 = u.pm * BM + wr * 64 + fr, col0 = u.pn * BM + wc * 32 + 8 * fq;
        f32x4 sb[2][2];
#pragma unroll
        for (int bj = 0; bj < 2; ++bj) { sb[bj][0] = *(const f32x4*)(SB + col0 + bj * HALF) * (1.f / 127.f); sb[bj][1] = *(const f32x4*)(SB + col0 + bj * HALF + 4) * (1.f / 127.f); }
#pragma unroll
        for (int ai = 0; ai < 2; ++ai)
#pragma unroll
            for (int m = 0; m < 4; ++m) { const int row = row0 + ai * HALF + m * 16; const float sa = SA[row]; bf16_t* rowp = O + (size_t)row * ldc + col0;
#pragma unroll
                for (int bj = 0; bj < 2; ++bj) { const i32x4 i0 = __builtin_bit_cast(i32x4, acc[ai][bj][m][0]), i1 = __builtin_bit_cast(i32x4, acc[ai][bj][m][1]);
                    const f32x4 v0 = (f32x4){(float)i0.x, (float)i0.y, (float)i0.z, (float)i0.w} * sb[bj][0] * sa, v1 = (f32x4){(float)i1.x, (float)i1.y, (float)i1.z, (float)i1.w} * sb[bj][1] * sa;
                    u32x4 w; w.x = cvt_pk_bf16(v0[0], v0[1]); w.y = cvt_pk_bf16(v0[2], v0[3]); w.z = cvt_pk_bf16(v1[0], v1[1]); w.w = cvt_pk_bf16(v1[2], v1[3]);
                    *(u32x4*)(rowp + bj * HALF) = w; } }
    }
};
template <int PASS> struct EpiGate {
    static constexpr bool PERM = true, AFTER_DRAIN = false;
    const bf16_t* G; int ldg; bf16_t* O; int ldc;
    __device__ __forceinline__ void operator()(const f32x4 (&acc)[2][2][4][2], const Unit& u, int wr, int wc, int fr, int fq) const {
        const int row0 = u.pm * BM + wr * 64 + fr, col0 = u.pn * BM + wc * 32 + 8 * fq;
#pragma unroll
        for (int ai = 0; ai < 2; ++ai)
#pragma unroll
            for (int m = 0; m < 4; ++m) { const size_t row = (size_t)(row0 + ai * HALF + m * 16);
#pragma unroll
                for (int bj = 0; bj < 2; ++bj) { const f32x4 v0 = acc[ai][bj][m][0], v1 = acc[ai][bj][m][1];
                    const u32x4 g = *(const u32x4*)(G + row * ldg + col0 + bj * HALF);
                    float r[8];
                    r[0] = v0[0] * sigmoidf_fast(bf_lo(g.x)); r[1] = v0[1] * sigmoidf_fast(bf_hi(g.x)); r[2] = v0[2] * sigmoidf_fast(bf_lo(g.y)); r[3] = v0[3] * sigmoidf_fast(bf_hi(g.y));
                    r[4] = v1[0] * sigmoidf_fast(bf_lo(g.z)); r[5] = v1[1] * sigmoidf_fast(bf_hi(g.z)); r[6] = v1[2] * sigmoidf_fast(bf_lo(g.w)); r[7] = v1[3] * sigmoidf_fast(bf_hi(g.w));
                    bf16_t* op = O + row * ldc + col0 + bj * HALF;
                    if (PASS == 1) { const u32x4 p = *(const u32x4*)op;
                        r[0] += bf_lo(p.x); r[1] += bf_hi(p.x); r[2] += bf_lo(p.y); r[3] += bf_hi(p.y); r[4] += bf_lo(p.z); r[5] += bf_hi(p.z); r[6] += bf_lo(p.w); r[7] += bf_hi(p.w); }
                    u32x4 w; w.x = cvt_pk_bf16(r[0], r[1]); w.y = cvt_pk_bf16(r[2], r[3]); w.z = cvt_pk_bf16(r[4], r[5]); w.w = cvt_pk_bf16(r[6], r[7]);
                    *(u32x4*)op = w; }
                asm volatile("" ::: "memory"); }
    }
};
struct EpiX1 {
    static constexpr bool PERM = true, AFTER_DRAIN = false;
    const float* X; bf16_t* X1B; float* SSQ; int ldc;
    __device__ __forceinline__ void operator()(const f32x4 (&acc)[2][2][4][2], const Unit& u, int wr, int wc, int fr, int fq) const {
        const int row0 = u.pm * BM + wr * 64 + fr, col0 = u.pn * BM + wc * 32 + 8 * fq;
#pragma unroll
        for (int ai = 0; ai < 2; ++ai)
#pragma unroll
            for (int m = 0; m < 4; ++m) { const size_t row = (size_t)(row0 + ai * HALF + m * 16); float ss = 0.f;
#pragma unroll
                for (int bj = 0; bj < 2; ++bj) { const size_t off = row * ldc + col0 + bj * HALF;
                    const f32x4 x0 = *(const f32x4*)(X + off), x1 = *(const f32x4*)(X + off + 4);
                    const f32x4 v0 = acc[ai][bj][m][0] + x0, v1 = acc[ai][bj][m][1] + x1;
                    u32x4 w; w.x = cvt_pk_bf16(v0[0], v0[1]); w.y = cvt_pk_bf16(v0[2], v0[3]); w.z = cvt_pk_bf16(v1[0], v1[1]); w.w = cvt_pk_bf16(v1[2], v1[3]);
                    *(u32x4*)(X1B + off) = w;
                    ss += (v0[0] * v0[0] + v0[1] * v0[1]) + (v0[2] * v0[2] + v0[3] * v0[3]) + (v1[0] * v1[0] + v1[1] * v1[1]) + (v1[2] * v1[2] + v1[3] * v1[3]); }
                ss += __shfl_xor(ss, 16); ss += __shfl_xor(ss, 32);
                if (fq == 0) atomicAdd(SSQ + row, ss);
                asm volatile("" ::: "memory"); }
    }
};
struct EpiQP {
    static constexpr bool PERM = true, AFTER_DRAIN = false;
    const float* SSQ; bf16_t* O; int ldc; float inv_n, eps;
    __device__ __forceinline__ void operator()(const f32x4 (&acc)[2][2][4][2], const Unit& u, int wr, int wc, int fr, int fq) const {
        const int row0 = u.pm * BM + wr * 64 + fr, col0 = u.pn * BM + wc * 32 + 8 * fq;
#pragma unroll
        for (int ai = 0; ai < 2; ++ai)
#pragma unroll
            for (int m = 0; m < 4; ++m) { const size_t row = (size_t)(row0 + ai * HALF + m * 16); const float inv = 1.0f / sqrtf(SSQ[row] * inv_n + eps);
                bf16_t* rowp = O + row * ldc + col0;
#pragma unroll
                for (int bj = 0; bj < 2; ++bj) { const f32x4 v0 = acc[ai][bj][m][0] * inv, v1 = acc[ai][bj][m][1] * inv;
                    u32x4 w; w.x = cvt_pk_bf16(v0[0], v0[1]); w.y = cvt_pk_bf16(v0[2], v0[3]); w.z = cvt_pk_bf16(v1[0], v1[1]); w.w = cvt_pk_bf16(v1[2], v1[3]);
                    *(u32x4*)(rowp + bj * HALF) = w; } }
    }
};


template <bool I8> __device__ __forceinline__ f32x4 mma16(bf16x8 a, bf16x8 b, f32x4 c) {
    if constexpr (I8) return __builtin_bit_cast(f32x4, __builtin_amdgcn_mfma_i32_16x16x64_i8(__builtin_bit_cast(i32x4, a), __builtin_bit_cast(i32x4, b), __builtin_bit_cast(i32x4, c), 0, 0, 0));
    else return __builtin_amdgcn_mfma_f32_16x16x32_bf16(a, b, c, 0, 0, 0);
}
template <class Epi, class Sched, bool ALIGN_EPI = false, bool SP2 = false, bool I8 = false>
__device__ __forceinline__ void gemm_phase(PG8_LAS unsigned char* lds, const Gemm g, const Sched& S, const Epi& E, int wid) {
    const int lane = hw_lane(), tid = wid * 64 + lane, wr = wid >> 2, wc = wid & 3, fr = lane & 15, fq = lane >> 4;
    const int K = I8 ? g.K / 2 : g.K, nt = K / BK;
    unsigned voffA[2], voffB[2];
#pragma unroll
    for (int i = 0; i < 2; ++i) { int R, C; stage_rc(tid * 16 + i * 8192, R, C); const int Rb = Epi::PERM ? ((R & ~31) + perm32(R & 31)) : R;
        voffA[i] = (unsigned)(R * K + C) * 2u; voffB[i] = (unsigned)(Rb * K + C) * 2u; }
    const size_t kstep = (size_t)(BK * 2);
    const size_t hstep = (size_t)HALF * K * 2;
    const size_t tstep = 2 * hstep;
    const unsigned ldsw = (unsigned)wid * 1024u;
    const int aoff = lds_byte(wr * 64 + fr, fq * 8), boff = lds_byte(wc * 32 + fr, fq * 8);
#define PG8_SA(b, h) (((b) * 2 + (h)) * HTB)
#define PG8_SB(b, h) ((4 + (b) * 2 + (h)) * HTB)
#define PG8_STAGE(bufoff, gbase, voff) do { _Pragma("unroll") for (int _i = 0; _i < 2; ++_i) \
        __builtin_amdgcn_global_load_lds((const unsigned*)((const char*)(gbase) + (voff)[_i]), (PG8_LAS unsigned*)(lds + (bufoff) + ldsw + _i * 8192), 16, 0, 0); } while (0)
#define PG8_LDA(dst, b, h) do { _Pragma("unroll") for (int m = 0; m < 4; ++m) _Pragma("unroll") for (int k = 0; k < 2; ++k) dst[m][k] = *(const PG8_LAS bf16x8*)(lds + PG8_SA(b, h) + aoff + m * 2048 + k * 1024); } while (0)
#define PG8_LDB(dst, b, h) do { _Pragma("unroll") for (int n = 0; n < 2; ++n) _Pragma("unroll") for (int k = 0; k < 2; ++k) dst[n][k] = *(const PG8_LAS bf16x8*)(lds + PG8_SB(b, h) + boff + n * 2048 + k * 1024); } while (0)
#define PG8_MMA(ai, bj, At, Bt) do { __builtin_amdgcn_s_setprio(1); _Pragma("unroll") for (int m = 0; m < 4; ++m) _Pragma("unroll") for (int n = 0; n < 2; ++n) _Pragma("unroll") for (int k = 0; k < 2; ++k) \
        acc[ai][bj][m][n] = mma16<I8>(Bt[n][k], At[m][k], acc[ai][bj][m][n]); __builtin_amdgcn_s_setprio(0); } while (0)
#define PG8_WAIT_V(n) asm volatile("s_waitcnt vmcnt(" #n ")" ::: "memory")
#define PG8_WAIT_L(n) asm volatile("s_waitcnt lgkmcnt(" #n ")" ::: "memory")
#define PG8_BAR __builtin_amdgcn_s_barrier()
#define PG8_SCHED __builtin_amdgcn_sched_barrier(0)
    Unit cur, nxt; int ui = 0;
    if (!S.next(0, cur)) return;
    f32x4 acc[2][2][4][2];
#pragma unroll
    for (int a = 0; a < 2; ++a)
#pragma unroll
        for (int b = 0; b < 2; ++b)
#pragma unroll
            for (int m = 0; m < 4; ++m)
#pragma unroll
                for (int n = 0; n < 2; ++n) acc[a][b][m][n] = (f32x4){0.f, 0.f, 0.f, 0.f};
    bf16x8 At[4][2], B0[2][2], B1[2][2];
    const char* cA = (const char*)g.A + (size_t)cur.pm * tstep; const char* cB = (const char*)g.Bt + (size_t)cur.pn * tstep;
    S.a_ready(cur);
    if constexpr (SP2) {
        PG8_STAGE(PG8_SB(0, 0), cB, voffB); PG8_STAGE(PG8_SB(0, 1), cB + hstep, voffB); PG8_STAGE(PG8_SA(0, 0), cA, voffA); PG8_STAGE(PG8_SA(0, 1), cA + hstep, voffA);
        if (wr == 1) PG8_BAR;
        PG8_WAIT_V(2); PG8_BAR;
        PG8_STAGE(PG8_SB(1, 0), cB + kstep, voffB); PG8_STAGE(PG8_SA(1, 0), cA + kstep, voffA); PG8_STAGE(PG8_SB(1, 1), cB + hstep + kstep, voffB);
        PG8_WAIT_V(6); PG8_BAR;
    } else {
        PG8_STAGE(PG8_SB(0, 0), cB, voffB); PG8_STAGE(PG8_SA(0, 0), cA, voffA); PG8_STAGE(PG8_SB(0, 1), cB + hstep, voffB); PG8_STAGE(PG8_SA(0, 1), cA + hstep, voffA);
        if (wr == 1) PG8_BAR;
        PG8_WAIT_V(4); PG8_BAR;
        PG8_STAGE(PG8_SB(1, 0), cB + kstep, voffB); PG8_STAGE(PG8_SA(1, 0), cA + kstep, voffA); PG8_STAGE(PG8_SB(1, 1), cB + hstep + kstep, voffB);
        PG8_WAIT_V(6); PG8_BAR;
    }
    for (;;) {
        const bool has_next = S.next(ui + 1, nxt);
        const char* nA = has_next ? (const char*)g.A + (size_t)nxt.pm * tstep : cA; const char* nB = has_next ? (const char*)g.Bt + (size_t)nxt.pn * tstep : cB;
        for (int t = 0; t < nt; t += 2) {
            const bool last = (t == nt - 2);
            const char* a1 = cA + (size_t)(t + 1) * kstep;
            const char* a2 = last ? nA : cA + (size_t)(t + 2) * kstep; const char* b2 = last ? nB : cB + (size_t)(t + 2) * kstep;
            const char* a3 = a2 + kstep; const char* b3 = b2 + kstep;
            if (last && has_next) S.a_ready(nxt);
            if constexpr (SP2) {
            PG8_LDB(B0, 0, 0); PG8_LDB(B1, 0, 1); PG8_SCHED; PG8_LDA(At, 0, 0); PG8_STAGE(PG8_SA(1, 1), a1 + hstep, voffA);
            PG8_WAIT_V(8); PG8_WAIT_L(0); PG8_BAR; PG8_MMA(0, 0, At, B0); PG8_MMA(0, 1, At, B1); PG8_BAR; PG8_SCHED;
            PG8_LDA(At, 0, 1); PG8_STAGE(PG8_SB(0, 0), b2, voffB); PG8_STAGE(PG8_SB(0, 1), b2 + hstep, voffB); PG8_STAGE(PG8_SA(0, 0), a2, voffA);
            PG8_WAIT_V(8); PG8_WAIT_L(0); PG8_BAR; PG8_MMA(1, 0, At, B0); PG8_MMA(1, 1, At, B1); PG8_BAR; PG8_SCHED;
            PG8_LDB(B0, 1, 0); PG8_LDB(B1, 1, 1); PG8_SCHED; PG8_LDA(At, 1, 0); PG8_STAGE(PG8_SA(0, 1), a2 + hstep, voffA);
            PG8_WAIT_V(8); PG8_WAIT_L(0); PG8_BAR; PG8_MMA(0, 0, At, B0); PG8_MMA(0, 1, At, B1); PG8_BAR; PG8_SCHED;
            PG8_LDA(At, 1, 1); PG8_STAGE(PG8_SB(1, 0), b3, voffB); PG8_STAGE(PG8_SB(1, 1), b3 + hstep, voffB); PG8_STAGE(PG8_SA(1, 0), a3, voffA);
            PG8_WAIT_V(8); PG8_WAIT_L(0); PG8_BAR; PG8_MMA(1, 0, At, B0); PG8_MMA(1, 1, At, B1); PG8_BAR; PG8_SCHED;
            } else {
            PG8_LDB(B0, 0, 0); PG8_SCHED; PG8_LDA(At, 0, 0); PG8_STAGE(PG8_SA(1, 1), a1 + hstep, voffA);
            PG8_WAIT_L(8); PG8_BAR; PG8_WAIT_L(0); PG8_MMA(0, 0, At, B0); PG8_BAR; PG8_SCHED;
            PG8_LDB(B1, 0, 1); PG8_STAGE(PG8_SB(0, 0), b2, voffB);
            PG8_BAR; PG8_WAIT_L(0); PG8_MMA(0, 1, At, B1); PG8_BAR;
            PG8_LDA(At, 0, 1); PG8_STAGE(PG8_SA(0, 0), a2, voffA);
            PG8_BAR; PG8_WAIT_L(0); PG8_MMA(1, 0, At, B0); PG8_BAR; PG8_SCHED;
            PG8_STAGE(PG8_SB(0, 1), b2 + hstep, voffB);
            PG8_WAIT_V(6); PG8_BAR; PG8_MMA(1, 1, At, B1); PG8_BAR;
            PG8_LDB(B0, 1, 0); PG8_SCHED; PG8_LDA(At, 1, 0); PG8_STAGE(PG8_SA(0, 1), a2 + hstep, voffA);
            PG8_WAIT_L(8); PG8_BAR; PG8_WAIT_L(0); PG8_MMA(0, 0, At, B0); PG8_BAR; PG8_SCHED;
            PG8_LDB(B1, 1, 1); PG8_STAGE(PG8_SB(1, 0), b3, voffB);
            PG8_BAR; PG8_WAIT_L(0); PG8_MMA(0, 1, At, B1); PG8_BAR;
            PG8_LDA(At, 1, 1); PG8_STAGE(PG8_SA(1, 0), a3, voffA);
            PG8_BAR; PG8_WAIT_L(0); PG8_MMA(1, 0, At, B0); PG8_BAR; PG8_SCHED;
            PG8_STAGE(PG8_SB(1, 1), b3 + hstep, voffB);
            PG8_WAIT_V(6); PG8_BAR; PG8_MMA(1, 1, At, B1); PG8_BAR;
            }
        }
        if constexpr (ALIGN_EPI) { if (wr == 0) PG8_BAR; }
        if constexpr (!Epi::AFTER_DRAIN) { E(acc, cur, wr, wc, fr, fq); S.done(cur); }
        if (!has_next) break;
#pragma unroll
        for (int a = 0; a < 2; ++a)
#pragma unroll
            for (int b = 0; b < 2; ++b)
#pragma unroll
                for (int m = 0; m < 4; ++m)
#pragma unroll
                    for (int n = 0; n < 2; ++n) acc[a][b][m][n] = (f32x4){0.f, 0.f, 0.f, 0.f};
        cur = nxt; cA = nA; cB = nB; ++ui;
        if constexpr (ALIGN_EPI) { if (wr == 1) PG8_BAR; }
    }
    PG8_WAIT_V(0);
    if constexpr (!ALIGN_EPI) { if (wr == 0) PG8_BAR; }
    PG8_BAR;
    if constexpr (Epi::AFTER_DRAIN) { E.fused(acc, cur, wr, wc, fr, fq, lds, wid, lane); S.done(cur); }
#undef PG8_SA
#undef PG8_SB
#undef PG8_STAGE
#undef PG8_LDA
#undef PG8_LDB
#undef PG8_MMA
#undef PG8_WAIT_V
#undef PG8_WAIT_L
#undef PG8_BAR
#undef PG8_SCHED
}
}


constexpr int NWAVES = 8;
constexpr int T = 8192, D = 2048, CW = 1024, AW = 1024, NH = 16, HD = 64, INW = 10240;
constexpr int C_CB = 0, C_CC = 1024, C_CH = 2048, C_Q = 3072, C_K = 4096, C_V = 5120, C_GC = 6144, C_GA = 8192;
constexpr int NS = 16, DW = 128, NG = 16, EG = 1024;
__host__ __device__ constexpr int egroup(int e) { return ((e >> 7) ^ e) & 15; }
__host__ __device__ constexpr int erow(int e) { return ((e >> 7) << 3) | ((e >> 4) & 7); }
constexpr int PH = 8, PKEYS = 128, PHALF = 128, PQD = 256, PTOPK = 16, NEXP = 16384, NPAIR = PH * PTOPK;
constexpr float RMS_EPS = 1e-6f;

constexpr size_t MiB = 1u << 20;
constexpr size_t WS_CTL = 0, CTL_ZERO_BYTES = 1 * MiB;
constexpr size_t WS_WIN = 1 * MiB;
constexpr size_t WS_SA = 22 * MiB;
constexpr size_t WS_WCO = 41 * MiB;
constexpr size_t WS_WAO = 45 * MiB;
constexpr size_t WS_WO = 49 * MiB;
constexpr size_t WS_WQ = 57 * MiB;
constexpr size_t WS_SK = 65 * MiB;
constexpr size_t WS_XN = 66 * MiB;
constexpr size_t WS_YC = 98 * MiB;
constexpr size_t WS_YA = 114 * MiB;
constexpr size_t WS_UQ = 130 * MiB;
constexpr size_t WS_SU = 162 * MiB;
constexpr size_t WS_SV = 163 * MiB;
constexpr size_t WS_VQ = 194 * MiB;
constexpr size_t WS_PROJ = 258 * MiB;
constexpr size_t WS_X1B = WS_PROJ;
constexpr size_t WS_QP = WS_PROJ + 32 * MiB;
constexpr size_t WS_IDX = WS_PROJ + 64 * MiB;
constexpr size_t WS_GATE = WS_PROJ + 68 * MiB;
constexpr size_t WS_ACT = WS_PROJ + 72 * MiB;
constexpr size_t WS_E32 = WS_PROJ + 172 * MiB;
constexpr size_t WS_A8 = WS_PROJ + 78 * MiB;
constexpr size_t WS_TS = WS_PROJ + 79 * MiB;
constexpr size_t WS_ES = WS_PROJ + 80 * MiB;
constexpr size_t WS_GS = WS_PROJ + 82 * MiB;
constexpr size_t WS_OFFN = WS_PROJ + 86 * MiB;
constexpr size_t WS_SXS = WS_PROJ + 87 * MiB;
constexpr size_t WS_XQ = WS_PROJ + 88 * MiB;
constexpr size_t WS_PART = WS_PROJ + 104 * MiB;
constexpr size_t WS_ESG = WS_PROJ + 168 * MiB;
constexpr size_t WS_SSQP = WS_PROJ + 176 * MiB;
constexpr size_t WS_END = 444 * MiB;
constexpr int CW_BAR = 4096;
constexpr int CW_SSQ = 65536;
constexpr int CW_COLMAX = CW_SSQ + 16384;
constexpr int CW_SSQ2 = CW_SSQ + 8192;
static_assert((CW_COLMAX + INW) * 4 <= (int)CTL_ZERO_BYTES, "ctl");

constexpr int RING_OFF = 0, RING_BYTES = 131072;
constexpr int LDSCTL_OFF = RING_BYTES, MISC_OFF = LDSCTL_OFF + 320;
constexpr int LDS_BYTES = 163840;
constexpr int LDS_SU_OFF = 132096;

#define GAS __attribute__((address_space(1)))
#define LAS __attribute__((address_space(3)))
typedef unsigned short bf16;
typedef unsigned v4u __attribute__((ext_vector_type(4)));
typedef float f32x4 __attribute__((ext_vector_type(4)));
typedef short bf16x8 __attribute__((ext_vector_type(8)));
typedef GAS unsigned gu32;
typedef GAS unsigned long long gu64;
#define RLX_AGENT __ATOMIC_RELAXED, __HIP_MEMORY_SCOPE_AGENT
#define LDS_WAIT() asm volatile("s_waitcnt lgkmcnt(0)" ::: "memory")
#define VM_WAIT() asm volatile("s_waitcnt vmcnt(0)" ::: "memory")
__device__ __forceinline__ unsigned long long rt() { return __builtin_amdgcn_s_memrealtime(); }
__device__ __forceinline__ unsigned f2bf(float f) { unsigned u = __builtin_bit_cast(unsigned, f); return (u + 0x7fffu + ((u >> 16) & 1u)) >> 16; }
__device__ __forceinline__ unsigned pk2(float lo, float hi) { return f2bf(lo) | (f2bf(hi) << 16); }

#define XB_TMO      128
#define XB_XCNT(j)  (256  + 64 * (j))
#define XB_XSUB(j)  (1280 + 64 * (j))
#define XB_XGEN(j)  (2304 + 64 * (j))
#define XB_TOP      3328
#define XB_TOPGEN   3392
#define XCD_BAR_WORDS 3456
#define XB_SPIN_CAP (1u << 18)

__device__ __forceinline__ unsigned xb_ld(unsigned* p)              { return __hip_atomic_load(p, __ATOMIC_RELAXED, __HIP_MEMORY_SCOPE_AGENT); }
__device__ __forceinline__ unsigned xb_add(unsigned* p, unsigned v) { return __hip_atomic_fetch_add(p, v, __ATOMIC_RELAXED, __HIP_MEMORY_SCOPE_AGENT); }
__device__ __forceinline__ unsigned xb_xcc_id() { return (unsigned)__builtin_amdgcn_s_getreg((3 << 11) | 20) & 0xFu; }
#define XB_SPIN(cond, bar) do { unsigned _sp = 0; while (cond) { __builtin_amdgcn_s_sleep(1); \
    if ((++_sp & 255u) == 0u) { if (xb_ld(&(bar)[XB_TMO])) break; if (_sp > XB_SPIN_CAP) { atomicAdd(&(bar)[XB_TMO], 1u); break; } } } } while (0)

struct XcdBarrier {
    unsigned* bar; unsigned x;
    volatile LAS unsigned* st;
};

__device__ __forceinline__ XcdBarrier xcd_barrier_post(unsigned* bar, volatile LAS unsigned* st, int wave) {
    XcdBarrier b; b.bar = bar; b.x = xb_xcc_id(); b.st = st;
    if (wave == 0 && hw_lane() == 0) (void)xb_add(&bar[XB_XCNT(b.x)], 1u);
    return b;
}
__device__ __forceinline__ void xcd_barrier_complete(unsigned* bar, unsigned x, unsigned& nloc, unsigned& nx) {
    const unsigned G = gridDim.x * gridDim.y * gridDim.z;
    unsigned sum, cnt, mine, sp = 0u;
    for (;;) {
        sum = 0u; cnt = 0u; mine = 0u;
#pragma unroll
        for (unsigned j = 0; j < 16; ++j) { const unsigned c = xb_ld(&bar[XB_XCNT(j)]); sum += c; cnt += (c > 0u) ? 1u : 0u; mine = (j == x) ? c : mine; }
        if (sum == G) break;
        __builtin_amdgcn_s_sleep(1);
        if ((++sp & 255u) == 0u) { if (xb_ld(&bar[XB_TMO])) break; if (sp > XB_SPIN_CAP) { atomicAdd(&bar[XB_TMO], 1u); break; } }
    }
    nloc = mine > 0u ? mine : 1u; nx = cnt > 0u ? cnt : 1u;
}

__device__ __forceinline__ void xcd_barrier_w(const XcdBarrier& b, int wave) {
    asm volatile("s_waitcnt vmcnt(0)" ::: "memory");
    __syncthreads();
    if (wave == 0 && hw_lane() == 0) {
        unsigned* bar = b.bar;
        __builtin_amdgcn_s_waitcnt(0);
        unsigned nloc = b.st[0], nx = b.st[1];
        if (nloc == 0u) { xcd_barrier_complete(bar, b.x, nloc, nx); b.st[0] = nloc; b.st[1] = nx; }
        const unsigned old = xb_add(&bar[XB_XSUB(b.x)], 1u);
        const unsigned gen = old / nloc;
        if (old + 1u == (gen + 1u) * nloc) {
            __builtin_amdgcn_fence(__ATOMIC_RELEASE, "agent");
            asm volatile("s_waitcnt vmcnt(0)" ::: "memory");
            const unsigned og = xb_add(&bar[XB_TOP], 1u);
            const unsigned tg = og / nx;
            if (og + 1u == (tg + 1u) * nx) xb_add(&bar[XB_TOPGEN], 1u);
            else XB_SPIN(xb_ld(&bar[XB_TOPGEN]) == tg, bar);
            __builtin_amdgcn_fence(__ATOMIC_ACQUIRE, "agent");
            xb_add(&bar[XB_XGEN(b.x)], 1u);
            asm volatile("s_waitcnt vmcnt(0)" ::: "memory");
        } else {
            XB_SPIN(xb_ld(&bar[XB_XGEN(b.x)]) == gen, bar);
            __builtin_amdgcn_fence(__ATOMIC_ACQUIRE, "agent");
            asm volatile("s_waitcnt vmcnt(0)" ::: "memory");
        }
    }
    __syncthreads();
}


#define PROBE_PHASE -1
#define PROBE_A 0
#define PROBE_B 1
#define STAMP(i) do { if (PROBE_PHASE >= 0 && blockIdx.x == 0 && wave == 0 && hw_lane() == 0) *(volatile LAS unsigned long long*)(lds + LDSCTL_OFF + 64 + 8 * (i)) = __builtin_amdgcn_s_memrealtime(); } while (0)
typedef float f32x16 __attribute__((ext_vector_type(16)));
typedef short s16x4 __attribute__((ext_vector_type(4)));
typedef unsigned u32x2 __attribute__((ext_vector_type(2)));
typedef float f32x2 __attribute__((ext_vector_type(2)));
__device__ __forceinline__ float wave_sum(float v) {
#pragma unroll
    for (int o = 1; o < 64; o <<= 1) v += __shfl_xor(v, o);
    return v;
}
__device__ __forceinline__ float partner32(float v) { return __shfl_xor(v, 32); }
__device__ __forceinline__ int partner32i(int v) { return __shfl_xor(v, 32); }
__device__ __forceinline__ int crow(int r, int hi) { return (r & 3) + 8 * (r >> 2) + 4 * hi; }
__device__ __forceinline__ float bflo(unsigned w) { return __uint_as_float(w << 16); }
__device__ __forceinline__ float bfhi(unsigned w) { return __uint_as_float(w & 0xffff0000u); }
__device__ __forceinline__ unsigned cvtpk(float lo, float hi) { unsigned r; asm volatile("v_cvt_pk_bf16_f32 %0, %1, %2" : "=v"(r) : "v"(lo), "v"(hi)); return r; }

struct TrItem { const float* W; bf16* WT; const float* kscale; int K, N, k0, n0; };
__device__ __forceinline__ void tr_load(const TrItem& it, f32x4 (&v)[8], int lane) {
    const int rr = lane >> 3, ch = lane & 7;
#pragma unroll
    for (int i = 0; i < 8; ++i) v[i] = *(const f32x4*)(it.W + (size_t)(it.k0 + rr + 8 * i) * it.N + it.n0 + 4 * ch);
}
__device__ __forceinline__ void tr_finish(const TrItem& it, f32x4 (&v)[8], LAS float* scr, int lane) {
    const int rr = lane >> 3, ch = lane & 7;
    if (it.kscale) {
#pragma unroll
        for (int i = 0; i < 8; ++i) v[i] = v[i] * it.kscale[it.k0 + rr + 8 * i];
    }
#pragma unroll
    for (int i = 0; i < 8; ++i) { LAS float* p = scr + (rr + 8 * i) * 33 + 4 * ch; p[0] = v[i].x; p[1] = v[i].y; p[2] = v[i].z; p[3] = v[i].w; }
    LDS_WAIT(); asm volatile("" ::: "memory");
    const int c = lane & 7;
#pragma unroll
    for (int j = 0; j < 4; ++j) { const int n = (lane >> 3) + 8 * j; const LAS float* s = scr + (8 * c) * 33 + n;
        v4u o; o.x = pk2(s[0 * 33], s[1 * 33]); o.y = pk2(s[2 * 33], s[3 * 33]); o.z = pk2(s[4 * 33], s[5 * 33]); o.w = pk2(s[6 * 33], s[7 * 33]);
        *(v4u*)(it.WT + (size_t)(it.n0 + n) * it.K + it.k0 + 8 * c) = o; }
    LDS_WAIT(); asm volatile("" ::: "memory");
}
__device__ __forceinline__ float wave_max(float v) {
#pragma unroll
    for (int o = 1; o < 64; o <<= 1) v = fmaxf(v, __shfl_xor(v, o));
    return v;
}
__device__ __forceinline__ void rms_rows2_to_i8(const float* x0, const float* x1, const float* gain, unsigned char* o0, unsigned char* o1, float* sa0, float* sa1, int lane) {
    const f32x4* xa = (const f32x4*)x0 + lane; const f32x4* xb = (const f32x4*)x1 + lane; const f32x4* gr = (const f32x4*)gain + lane;
    f32x4 va[8], vb[8]; float sa = 0.f, sb = 0.f;
#pragma unroll
    for (int j = 0; j < 8; ++j) { va[j] = xa[64 * j]; vb[j] = xb[64 * j]; }
#pragma unroll
    for (int j = 0; j < 8; ++j) { sa += (va[j].x * va[j].x + va[j].y * va[j].y) + (va[j].z * va[j].z + va[j].w * va[j].w); sb += (vb[j].x * vb[j].x + vb[j].y * vb[j].y) + (vb[j].z * vb[j].z + vb[j].w * vb[j].w); }
    const float ia = 1.f / sqrtf(wave_sum(sa) * (1.f / D) + RMS_EPS), ib = 1.f / sqrtf(wave_sum(sb) * (1.f / D) + RMS_EPS);
    float ma = 0.f, mb = 0.f;
#pragma unroll
    for (int j = 0; j < 8; ++j) { const f32x4 g = gr[64 * j]; va[j] = va[j] * g * ia; vb[j] = vb[j] * g * ib;
        ma = fmaxf(ma, fmaxf(fmaxf(fabsf(va[j].x), fabsf(va[j].y)), fmaxf(fabsf(va[j].z), fabsf(va[j].w)))); mb = fmaxf(mb, fmaxf(fmaxf(fabsf(vb[j].x), fabsf(vb[j].y)), fmaxf(fabsf(vb[j].z), fabsf(vb[j].w)))); }
    ma = wave_max(ma); mb = wave_max(mb);
    const float qa = ma > 0.f ? 127.f / ma : 0.f, qb = mb > 0.f ? 127.f / mb : 0.f;
    unsigned* pa = (unsigned*)o0 + lane; unsigned* pb = (unsigned*)o1 + lane;
#pragma unroll
    for (int j = 0; j < 8; ++j) {
        pa[64 * j] = (unsigned)((int)rintf(va[j].x * qa) & 255) | ((unsigned)((int)rintf(va[j].y * qa) & 255) << 8) | ((unsigned)((int)rintf(va[j].z * qa) & 255) << 16) | ((unsigned)((int)rintf(va[j].w * qa) & 255) << 24);
        pb[64 * j] = (unsigned)((int)rintf(vb[j].x * qb) & 255) | ((unsigned)((int)rintf(vb[j].y * qb) & 255) << 8) | ((unsigned)((int)rintf(vb[j].z * qb) & 255) << 16) | ((unsigned)((int)rintf(vb[j].w * qb) & 255) << 24); }
    if (lane == 0) { *sa0 = ma * (1.f / 127.f); *sa1 = mb * (1.f / 127.f); }
}
__device__ __forceinline__ void tr_finish_i8(const TrItem& it, f32x4 (&v)[8], const float* colmax, LAS float* scr, int lane) {
    const int rr = lane >> 3, ch = lane & 7;
#pragma unroll
    for (int i = 0; i < 8; ++i) { LAS float* p = scr + (rr + 8 * i) * 33 + 4 * ch; p[0] = v[i].x; p[1] = v[i].y; p[2] = v[i].z; p[3] = v[i].w; }
    LDS_WAIT(); asm volatile("" ::: "memory");
    const int c = lane & 3;
#pragma unroll
    for (int j = 0; j < 2; ++j) { const int n = (lane >> 2) + 16 * j; const LAS float* s = scr + (16 * c) * 33 + n;
        const float cm = colmax[it.n0 + n]; const float q = cm > 0.f ? 127.f / cm : 0.f;
        unsigned w[4];
#pragma unroll
        for (int d = 0; d < 4; ++d) w[d] = (unsigned)((int)rintf(s[(4 * d) * 33] * q) & 255) | ((unsigned)((int)rintf(s[(4 * d + 1) * 33] * q) & 255) << 8) | ((unsigned)((int)rintf(s[(4 * d + 2) * 33] * q) & 255) << 16) | ((unsigned)((int)rintf(s[(4 * d + 3) * 33] * q) & 255) << 24);
        *(v4u*)((unsigned char*)it.WT + (size_t)(it.n0 + n) * it.K + it.k0 + 16 * c) = (v4u){w[0], w[1], w[2], w[3]}; }
    LDS_WAIT(); asm volatile("" ::: "memory");
}

struct Ptrs {
    const float *x, *norm_mix, *w_in, *conv_w, *w_conv_out, *w_attn_out, *w_out, *norm_ffn, *peer_wq, *peer_sk, *peer_u, *peer_v, *norm_final;
    float* out; unsigned char* ws;
};

__device__ __forceinline__ void p0_prologue(const Ptrs& P, LAS unsigned char* lds, int vcu, int G, int wave, int lane, int tid) {
    LAS float* scr = (LAS float*)(lds + RING_OFF + wave * 16384);
    const int gw = vcu * NWAVES + wave, NGW = G * NWAVES;
    bf16* WCO = (bf16*)(P.ws + WS_WCO); bf16* WAO = (bf16*)(P.ws + WS_WAO); bf16* WO = (bf16*)(P.ws + WS_WO); bf16* WQ = (bf16*)(P.ws + WS_WQ);
    constexpr int I_CO = (CW / 64) * (D / 32), I_AO = (AW / 64) * (D / 32), I_O = (D / 64) * (D / 32), I_Q = I_O;
    constexpr int NITEMS = I_CO + I_AO + I_O + I_Q;
    auto mk = [&](int it) {
        TrItem t; int r = it, K, N;
        if (r < I_CO) { t.W = P.w_conv_out; t.WT = WCO; t.kscale = nullptr; K = CW; N = D; }
        else if ((r -= I_CO) < I_AO) { t.W = P.w_attn_out; t.WT = WAO; t.kscale = nullptr; K = AW; N = D; }
        else if ((r -= I_AO) < I_O) { t.W = P.w_out; t.WT = WO; t.kscale = nullptr; K = D; N = D; }
        else { r -= I_O; t.W = P.peer_wq; t.WT = WQ; t.kscale = P.norm_ffn; K = D; N = D; }
        const int nblk = N / 32; t.K = K; t.N = N; t.k0 = 64 * (r / nblk); t.n0 = 32 * (r % nblk); return t; };
    {
        f32x4 va[8], vb[8];
        int it = gw;
        if (it < NITEMS) { const TrItem a = mk(it); tr_load(a, va, lane); }
        for (; it < NITEMS; it += 2 * NGW) {
            const TrItem a = mk(it);
            const bool hb = it + NGW < NITEMS; TrItem b = a; if (hb) { b = mk(it + NGW); tr_load(b, vb, lane); }
            tr_finish(a, va, scr, lane);
            if (it + 2 * NGW < NITEMS) { const TrItem c = mk(it + 2 * NGW); tr_load(c, va, lane); }
            if (hb) tr_finish(b, vb, scr, lane);
        }
    }
    unsigned char* XN = P.ws + WS_XN; float* SA = (float*)(P.ws + WS_SA);
    for (int m = gw; m < T / 2; m += NGW) rms_rows2_to_i8(P.x + (size_t)(2 * m) * D, P.x + (size_t)(2 * m + 1) * D, P.norm_mix, XN + (size_t)(2 * m) * D, XN + (size_t)(2 * m + 1) * D, SA + 2 * m, SA + 2 * m + 1, lane);
    {
        const int gt = (vcu * NWAVES + wave) * 64 + lane, NGT = G * NWAVES * 64;
        bf16* SK = (bf16*)(P.ws + WS_SK);
        for (int it = gt; it < 2 * PKEYS * PHALF; it += NGT) SK[it] = (bf16)f2bf(P.peer_sk[it]);
    }
    {
        LAS unsigned char* tile = lds + RING_OFF;
        unsigned char* VQ = P.ws + WS_VQ; float* SV = (float*)(P.ws + WS_SV);
        __syncthreads();
        for (int b = vcu; b < NEXP / 32; b += G) {
            const int e0 = b * 32;
            f32x4 vv[4][8];
#pragma unroll
            for (int i = 0; i < 4; ++i) { const float* vr = P.peer_v + (size_t)(e0 + wave * 4 + i) * D + 4 * lane;
#pragma unroll
                for (int j = 0; j < 8; ++j) vv[i][j] = *(const f32x4*)(vr + 256 * j); }
#pragma unroll
            for (int i = 0; i < 4; ++i) {
                const int er = wave * 4 + i;
                float m = 0.f;
#pragma unroll
                for (int j = 0; j < 8; ++j) m = fmaxf(m, fmaxf(fmaxf(fabsf(vv[i][j].x), fabsf(vv[i][j].y)), fmaxf(fabsf(vv[i][j].z), fabsf(vv[i][j].w))));
                m = wave_max(m);
                const float inv = m > 0.f ? 127.f / m : 0.f;
                if (lane == 0) SV[e0 + er] = m * (1.f / 127.f);
#pragma unroll
                for (int j = 0; j < 8; ++j) {
                    const f32x4 v = vv[i][j];
                    const int w = (int)((unsigned)((int)rintf(v.x * inv) & 255) | ((unsigned)((int)rintf(v.y * inv) & 255) << 8) | ((unsigned)((int)rintf(v.z * inv) & 255) << 16) | ((unsigned)((int)rintf(v.w * inv) & 255) << 24));
                    const int c = (lane >> 1) + 32 * j;
                    *(LAS int*)(tile + (c * 33 + er) * 8 + 4 * (lane & 1)) = w;
                }
            }
            __syncthreads();
#pragma unroll 4
            for (int k = 0; k < 16; ++k) {
                const int c = wave * 32 + 2 * k + (lane >> 5), er = lane & 31;
                const u32x2 q = *(const LAS u32x2*)(tile + (c * 33 + er) * 8);
                *(u32x2*)(VQ + ((size_t)c * NEXP + e0 + er) * 8) = q;
            }
            __syncthreads();
        }
    }
    {
        unsigned* CM = (unsigned*)(P.ws + WS_CTL) + CW_COLMAX;
        constexpr int NCB = INW / 256;
        for (int it = gw; it < (D / 64) * NCB; it += NGW) {
            const int kb = it / NCB, cb = it % NCB; const float* src = P.w_in + (size_t)(64 * kb) * INW + 256 * cb + 4 * lane;
            f32x4 m = (f32x4){0.f, 0.f, 0.f, 0.f};
#pragma unroll 16
            for (int r = 0; r < 64; ++r) { const f32x4 v = *(const f32x4*)(src + (size_t)r * INW); m.x = fmaxf(m.x, fabsf(v.x)); m.y = fmaxf(m.y, fabsf(v.y)); m.z = fmaxf(m.z, fabsf(v.z)); m.w = fmaxf(m.w, fabsf(v.w)); }
            unsigned* d = CM + 256 * cb + 4 * lane;
            atomicMax(d, __float_as_uint(m.x)); atomicMax(d + 1, __float_as_uint(m.y)); atomicMax(d + 2, __float_as_uint(m.z)); atomicMax(d + 3, __float_as_uint(m.w));
        }
    }
}

__device__ __forceinline__ void u_rows2_load(f32x4 (&v)[2][8], const float* peer_u, int e2, int lane) {
#pragma unroll
    for (int h = 0; h < 2; ++h) {
        const float* p0 = peer_u + (size_t)(2 * e2 + h) * D + 4 * lane; const float* p1 = p0 + 1024;
        asm volatile("" : "+v"(p0), "+v"(p1));
#pragma unroll
        for (int j = 0; j < 4; ++j) { v[h][j] = *(const f32x4*)(p0 + 256 * j); v[h][4 + j] = *(const f32x4*)(p1 + 256 * j); }
    }
}
__device__ __forceinline__ void u_rows2_store(f32x4 (&v)[2][8], const float* gr, unsigned char* UQ, float* SU, int e2, int lane) {
#pragma unroll
    for (int j = 0; j < 8; ++j) { const f32x4 gg = *(const f32x4*)(gr + 256 * j); v[0][j] = v[0][j] * gg; v[1][j] = v[1][j] * gg; }
#pragma unroll
    for (int h = 0; h < 2; ++h) {
        const int e = 2 * e2 + h, g = egroup(e), r = erow(e);
#pragma unroll
        for (int j = 0; j < 8; ++j) {
            float m = fmaxf(fmaxf(fabsf(v[h][j].x), fabsf(v[h][j].y)), fmaxf(fabsf(v[h][j].z), fabsf(v[h][j].w)));
            m = fmaxf(m, __shfl_xor(m, 1)); m = fmaxf(m, __shfl_xor(m, 2)); m = fmaxf(m, __shfl_xor(m, 4)); m = fmaxf(m, __shfl_xor(m, 8)); m = fmaxf(m, __shfl_xor(m, 16));
            const float inv = m > 0.f ? 127.f / m : 0.f;
            const int q0 = (int)rintf(v[h][j].x * inv), q1 = (int)rintf(v[h][j].y * inv), q2 = (int)rintf(v[h][j].z * inv), q3 = (int)rintf(v[h][j].w * inv);
            const unsigned w = (unsigned)(q0 & 255) | ((unsigned)(q1 & 255) << 8) | ((unsigned)(q2 & 255) << 16) | ((unsigned)(q3 & 255) << 24);
            const int sl = 2 * j + (lane >> 5), role = g * NS + sl;
            *(unsigned*)(UQ + ((size_t)role * EG + r) * DW + 4 * (lane & 31)) = w;
            if ((lane & 31) == 0) SU[role * EG + r] = m * (1.f / 127.f);
        }
    }
}
__device__ __forceinline__ void peer_tables_to_i8(const Ptrs& P, int gw, int NGW, int lane) {
    unsigned char* UQ = P.ws + WS_UQ; float* SU = (float*)(P.ws + WS_SU);
    const float* gr = P.norm_ffn + 4 * lane;
    f32x4 va[2][8], vb[2][8];
    int e2 = gw;
    if (e2 < NEXP / 2) u_rows2_load(va, P.peer_u, e2, lane);
#pragma unroll 1
    for (; e2 < NEXP / 2; e2 += 2 * NGW) {
        const bool hb = e2 + NGW < NEXP / 2; if (hb) u_rows2_load(vb, P.peer_u, e2 + NGW, lane);
        u_rows2_store(va, gr, UQ, SU, e2, lane);
        if (e2 + 2 * NGW < NEXP / 2) u_rows2_load(va, P.peer_u, e2 + 2 * NGW, lane);
        if (hb) u_rows2_store(vb, gr, UQ, SU, e2 + NGW, lane);
    }
}

__device__ __forceinline__ void p0_win_i8(const Ptrs& P, LAS unsigned char* lds, int vcu, int G, int wave, int lane) {
    LAS float* scr = (LAS float*)(lds + RING_OFF + wave * 16384);
    const int gw = vcu * NWAVES + wave, NGW = G * NWAVES;
    const float* CM = (const float*)((const unsigned*)(P.ws + WS_CTL) + CW_COLMAX);
    constexpr int NITEMS = (D / 64) * (INW / 32);
    auto mk = [&](int it) { TrItem t; t.W = P.w_in; t.WT = (bf16*)(P.ws + WS_WIN); t.kscale = nullptr; t.K = D; t.N = INW; t.k0 = 64 * (it & 31); t.n0 = 32 * (it >> 5); return t; };
    f32x4 va[8], vb[8];
    int it = gw;
    if (it < NITEMS) { const TrItem a = mk(it); tr_load(a, va, lane); }
    for (; it < NITEMS; it += 2 * NGW) {
        const TrItem a = mk(it);
        const bool hb = it + NGW < NITEMS; TrItem b = a; if (hb) { b = mk(it + NGW); tr_load(b, vb, lane); }
        tr_finish_i8(a, va, CM, scr, lane);
        if (it + 2 * NGW < NITEMS) { const TrItem c = mk(it + 2 * NGW); tr_load(c, va, lane); }
        if (hb) tr_finish_i8(b, vb, CM, scr, lane);
    }
}

__device__ __forceinline__ void p2_conv(const Ptrs& P, int gt, int NGT) {
    const bf16* PROJ = (const bf16*)(P.ws + WS_PROJ); bf16* YC = (bf16*)(P.ws + WS_YC);
    constexpr int NIT = (T / 8) * (CW / 8);
    for (int it = gt; it < NIT; it += NGT) {
        const int ch = it % (CW / 8), tb = it / (CW / 8), c0 = ch * 8, t0 = tb * 8;
        float w0[8], w1[8], w2[8];
#pragma unroll
        for (int i = 0; i < 8; ++i) { w0[i] = P.conv_w[c0 + i]; w1[i] = P.conv_w[CW + c0 + i]; w2[i] = P.conv_w[2 * CW + c0 + i]; }
        float zm2[8], zm1[8];
#pragma unroll
        for (int i = 0; i < 8; ++i) { zm2[i] = 0.f; zm1[i] = 0.f; }
#pragma unroll
        for (int dt = -2; dt < 8; ++dt) {
            const int t = t0 + dt; if (t < 0) continue;
            const v4u cc = *(const v4u*)(PROJ + (size_t)t * INW + C_CC + c0), hh = *(const v4u*)(PROJ + (size_t)t * INW + C_CH + c0);
            float z[8];
            z[0] = bflo(cc.x) * bflo(hh.x); z[1] = bfhi(cc.x) * bfhi(hh.x); z[2] = bflo(cc.y) * bflo(hh.y); z[3] = bfhi(cc.y) * bfhi(hh.y);
            z[4] = bflo(cc.z) * bflo(hh.z); z[5] = bfhi(cc.z) * bfhi(hh.z); z[6] = bflo(cc.w) * bflo(hh.w); z[7] = bfhi(cc.w) * bfhi(hh.w);
            if (dt >= 0) {
                const v4u cb = *(const v4u*)(PROJ + (size_t)t * INW + C_CB + c0);
                float b[8] = {bflo(cb.x), bfhi(cb.x), bflo(cb.y), bfhi(cb.y), bflo(cb.z), bfhi(cb.z), bflo(cb.w), bfhi(cb.w)};
                float y[8];
#pragma unroll
                for (int i = 0; i < 8; ++i) y[i] = b[i] * (w0[i] * zm2[i] + w1[i] * zm1[i] + w2[i] * z[i]);
                v4u o; o.x = pk2(y[0], y[1]); o.y = pk2(y[2], y[3]); o.z = pk2(y[4], y[5]); o.w = pk2(y[6], y[7]);
                *(v4u*)(YC + (size_t)t * CW + c0) = o;
            }
#pragma unroll
            for (int i = 0; i < 8; ++i) { zm2[i] = zm1[i]; zm1[i] = z[i]; }
        }
    }
}

__device__ __forceinline__ s16x4 vtr(LAS const unsigned char* p) { typedef short v4i16_t __attribute__((ext_vector_type(4))); return __builtin_bit_cast(s16x4, __builtin_amdgcn_ds_read_tr16_b64_v4i16((LAS v4i16_t*)p)); }

__device__ __forceinline__ void attn_task(const bf16* PROJ, bf16* YA, LAS unsigned char* vl  , int qt, int h, int lane) {
    const int r32 = lane & 31, hi = lane >> 5, q0 = qt * 32;
    const bf16* Qp = PROJ + (size_t)(q0 + r32) * INW + C_Q + h * HD + 8 * hi;
    bf16x8 qf[4];
#pragma unroll
    for (int s = 0; s < 4; ++s) qf[s] = *(const bf16x8*)(Qp + 16 * s);
    float carry = 1.f;
    f32x16 o0, o1;
#pragma unroll
    for (int r = 0; r < 16; ++r) { o0[r] = 0.f; o1[r] = 0.f; }
    const int g1 = (lane >> 4) & 1, qq = (lane & 15) >> 2, pp = lane & 3;
    LAS const unsigned char* vrd = vl + (4 * hi + qq) * 128 + g1 * 32 + pp * 8;
    for (int kt = qt; kt >= 0; --kt) {
        const int k0 = kt * 32;
        const bf16* Kp = PROJ + (size_t)(k0 + r32) * INW + C_K + h * HD + 8 * hi;
        bf16x8 kf[4];
#pragma unroll
        for (int s = 0; s < 4; ++s) kf[s] = *(const bf16x8*)(Kp + 16 * s);
        v4u vv[4];
#pragma unroll
        for (int i = 0; i < 4; ++i) { const int c = lane + 64 * i, row = c >> 3, chn = c & 7; vv[i] = *(const v4u*)(PROJ + (size_t)(k0 + row) * INW + C_V + h * HD + chn * 8); }
        f32x16 S;
#pragma unroll
        for (int r = 0; r < 16; ++r) S[r] = 0.f;
#pragma unroll
        for (int s = 0; s < 4; ++s) S = __builtin_amdgcn_mfma_f32_32x32x16_bf16(kf[s], qf[s], S, 0, 0, 0);
#pragma unroll
        for (int i = 0; i < 4; ++i) { const int c = lane + 64 * i, row = c >> 3, chn = c & 7; *(LAS v4u*)(vl + row * 128 + chn * 16) = vv[i]; }
        float kp[16], bt[16];
        const float cs = 0.125f * 1.4426950408889634f;
#pragma unroll
        for (int r = 0; r < 16; ++r) { const float a = fminf(S[r] * cs, 126.f); const float e = __builtin_amdgcn_exp2f(a); const float ri = __builtin_amdgcn_rcpf(1.f + e); kp[r] = ri; bt[r] = e * ri; }
        if (kt == qt) {
#pragma unroll
            for (int r = 0; r < 16; ++r) { if (crow(r, hi) >= r32) { kp[r] = 1.f; bt[r] = 0.f; } }
        }
        float Pm[4], Qm[4], Tt[4];
#pragma unroll
        for (int i = 0; i < 4; ++i) { Pm[i] = (kp[4 * i] * kp[4 * i + 1]) * (kp[4 * i + 2] * kp[4 * i + 3]); Qm[i] = partner32(Pm[i]); Tt[i] = Pm[i] * Qm[i]; }
        float R[4]; R[3] = 1.f; R[2] = Tt[3]; R[1] = Tt[3] * Tt[2]; R[0] = R[1] * Tt[1];
        const float total = R[0] * Tt[0];
        float w[16];
#pragma unroll
        for (int i = 0; i < 4; ++i) {
            const float base = carry * R[i] * (hi ? 1.f : Qm[i]);
            const float x3 = base, x2 = x3 * kp[4 * i + 3], x1 = x2 * kp[4 * i + 2], x0 = x1 * kp[4 * i + 1];
            w[4 * i + 3] = bt[4 * i + 3] * x3; w[4 * i + 2] = bt[4 * i + 2] * x2; w[4 * i + 1] = bt[4 * i + 1] * x1; w[4 * i] = bt[4 * i] * x0;
        }
        carry *= total;
        v4u wa0, wa1;
        wa0.x = cvtpk(w[0], w[1]); wa0.y = cvtpk(w[2], w[3]); wa0.z = cvtpk(w[4], w[5]); wa0.w = cvtpk(w[6], w[7]);
        wa1.x = cvtpk(w[8], w[9]); wa1.y = cvtpk(w[10], w[11]); wa1.z = cvtpk(w[12], w[13]); wa1.w = cvtpk(w[14], w[15]);
        asm volatile("s_waitcnt lgkmcnt(0)" ::: "memory");
        s16x4 l00 = vtr(vrd + 0 * 64 + 0 * 2048), h00 = vtr(vrd + 0 * 64 + 0 * 2048 + 1024);
        s16x4 l01 = vtr(vrd + 0 * 64 + 1 * 2048), h01 = vtr(vrd + 0 * 64 + 1 * 2048 + 1024);
        s16x4 l10 = vtr(vrd + 1 * 64 + 0 * 2048), h10 = vtr(vrd + 1 * 64 + 0 * 2048 + 1024);
        s16x4 l11 = vtr(vrd + 1 * 64 + 1 * 2048), h11 = vtr(vrd + 1 * 64 + 1 * 2048 + 1024);
        asm volatile("s_waitcnt lgkmcnt(0)" ::: "memory");
#define PKV(l, hh) (bf16x8){l[0], l[1], l[2], l[3], hh[0], hh[1], hh[2], hh[3]}
        o0 = __builtin_amdgcn_mfma_f32_32x32x16_bf16(__builtin_bit_cast(bf16x8, wa0), PKV(l00, h00), o0, 0, 0, 0);
        o0 = __builtin_amdgcn_mfma_f32_32x32x16_bf16(__builtin_bit_cast(bf16x8, wa1), PKV(l01, h01), o0, 0, 0, 0);
        o1 = __builtin_amdgcn_mfma_f32_32x32x16_bf16(__builtin_bit_cast(bf16x8, wa0), PKV(l10, h10), o1, 0, 0, 0);
        o1 = __builtin_amdgcn_mfma_f32_32x32x16_bf16(__builtin_bit_cast(bf16x8, wa1), PKV(l11, h11), o1, 0, 0, 0);
#undef PKV
        if (__all(carry < 1e-30f)) break;
    }
    bf16* Op = YA + (size_t)q0 * AW + h * HD + r32;
#pragma unroll
    for (int r = 0; r < 16; ++r) { const int qr = crow(r, hi); Op[(size_t)qr * AW] = (bf16)f2bf(o0[r]); Op[(size_t)qr * AW + 32] = (bf16)f2bf(o1[r]); }
}

template <int N> __device__ __forceinline__ float tree_max(const float (&v)[N]) {
    float t[N];
#pragma unroll
    for (int i = 0; i < N; ++i) t[i] = v[i];
#pragma unroll
    for (int w = N; w > 1; w = (w + 2) / 3) {
#pragma unroll
        for (int i = 0; i < (w + 2) / 3; ++i) { const float a = t[3 * i], b = (3 * i + 1 < w) ? t[3 * i + 1] : a, c = (3 * i + 2 < w) ? t[3 * i + 2] : a; t[i] = fmaxf(fmaxf(a, b), c); }
    }
    return t[0];
}
template <int N> __device__ __forceinline__ float take_max(float (&v)[N]) {
    const float m = tree_max<N>(v);
    const float g = fmaxf(m, partner32(m));
#pragma unroll
    for (int i = 0; i < N; ++i) v[i] = (v[i] == g) ? -INFINITY : v[i];
    return g;
}
#define CEX(a, b) do { const float hi_ = fmaxf(a, b), lo_ = fminf(a, b); a = hi_; b = lo_; } while (0)
template <int O, int N> __device__ __forceinline__ void sort16_desc_at(float (&v)[N]) {
#pragma unroll
    for (int k = 2; k <= 16; k <<= 1)
#pragma unroll
        for (int j = k >> 1; j > 0; j >>= 1)
#pragma unroll
            for (int i = 0; i < 16; ++i) { const int l = i ^ j; if (l > i) { if ((i & k) == 0) CEX(v[O + i], v[O + l]); else CEX(v[O + l], v[O + i]); } }
}
template <int A, int B, int N> __device__ __forceinline__ void merge_top16_at(float (&v)[N]) {
#pragma unroll
    for (int i = 0; i < 16; ++i) v[A + i] = fmaxf(v[A + i], v[B + 15 - i]);
#pragma unroll
    for (int j = 8; j > 0; j >>= 1)
#pragma unroll
        for (int i = 0; i < 16; ++i) { const int l = i ^ j; if (l > i) CEX(v[A + i], v[A + l]); }
}
__device__ __forceinline__ void sort16_desc(float (&v)[16]) { sort16_desc_at<0, 16>(v); }
__device__ __forceinline__ void merge_top16(float (&a)[16], const float (&b)[16]) {
#pragma unroll
    for (int i = 0; i < 16; ++i) a[i] = fmaxf(a[i], b[15 - i]);
#pragma unroll
    for (int j = 8; j > 0; j >>= 1)
#pragma unroll
        for (int i = 0; i < 16; ++i) { const int l = i ^ j; if (l > i) CEX(a[i], a[l]); }
}
__device__ __forceinline__ void top16_of_pair(float (&sc)[64], float (&out)[16]) {
    sort16_desc_at<0, 64>(sc); sort16_desc_at<16, 64>(sc); merge_top16_at<0, 16, 64>(sc);
    sort16_desc_at<32, 64>(sc); sort16_desc_at<48, 64>(sc); merge_top16_at<32, 48, 64>(sc);
    merge_top16_at<0, 32, 64>(sc);
#pragma unroll
    for (int i = 0; i < 16; ++i) out[i] = sc[i];
    float p[16];
#pragma unroll
    for (int i = 0; i < 16; ++i) p[i] = partner32(out[i]);
    merge_top16(out, p);
}
struct constexpr_ij { int i, j; };
__host__ __device__ constexpr constexpr_ij cand_ij(int k) {
    int n = 0;
    for (int i = 0; i < 16; ++i) for (int j = 0; j < 16; ++j) if ((i + 1) * (j + 1) <= 16) { if (n == k) return constexpr_ij{i, j}; ++n; }
    return constexpr_ij{0, 0};
}
__device__ __forceinline__ void topk_task(const bf16* QP, const bf16* SK, int* IDX, float* GATE, LAS unsigned char* tlds  , int tt, int h, int lane) {
    const int r32 = lane & 31, hi = lane >> 5, t = tt * 32 + r32;
    asm volatile("" : "+s"(SK), "+s"(QP));
    float top[2][16];
#pragma unroll
    for (int side = 0; side < 2; ++side) {
        const bf16* Qp = QP + (size_t)t * D + h * PQD + side * PHALF + 8 * hi;
        bf16x8 qf[8];
#pragma unroll
        for (int s = 0; s < 8; ++s) qf[s] = *(const bf16x8*)(Qp + 16 * s);
        float sc[64];
#pragma unroll
        for (int kb = 0; kb < 4; ++kb) {
            const bf16* Kp = SK + (size_t)(side * PKEYS + kb * 32 + r32) * PHALF + 8 * hi;
            asm volatile("" : "+v"(Kp));
            f32x16 S;
#pragma unroll
            for (int r = 0; r < 16; ++r) S[r] = 0.f;
#pragma unroll
            for (int s = 0; s < 8; ++s) { const bf16x8 kf = *(const bf16x8*)(Kp + 16 * s); S = __builtin_amdgcn_mfma_f32_32x32x16_bf16(kf, qf[s], S, 0, 0, 0); }
#pragma unroll
            for (int r = 0; r < 16; ++r) { const unsigned key = (unsigned)(kb * 32 + crow(r, hi)); sc[kb * 16 + r] = __uint_as_float((__float_as_uint(S[r]) & ~127u) | (127u - key)); }
            asm volatile("" ::: "memory");
        }
        top16_of_pair(sc, top[side]);
        asm volatile("" ::: "memory");
    }
    asm volatile("" ::: "memory");
    int hi_c = hi; asm volatile("" : "+v"(hi_c));
    float ca[16], cb[16];
    LAS unsigned short* tab = (LAS unsigned short*)(tlds + r32 * 128);
    LAS unsigned short* tabh = tab + (hi ? 25 : 0); asm volatile("" : "+v"(tabh), "+v"(tab));
#pragma unroll
    for (int k = 0; k < 25; ++k) {
        constexpr_ij c0 = cand_ij(k), c1 = cand_ij(k + 25);
        const float a = hi_c ? top[0][c1.i] : top[0][c0.i], b = hi_c ? top[1][c1.j] : top[1][c0.j];
        const float sm = a + b;
        const float cvk = __uint_as_float((__float_as_uint(sm) & ~63u) | (unsigned)(hi_c ? 63 - (k + 25) : 63 - k));
        if (k < 16) ca[k] = cvk; else cb[k - 16] = cvk;
        tabh[k] = (unsigned short)((127u - (__float_as_uint(a) & 127u)) * PKEYS + (127u - (__float_as_uint(b) & 127u)));
    }
#pragma unroll
    for (int k = 9; k < 16; ++k) cb[k] = -INFINITY;
    sort16_desc(ca); sort16_desc(cb); merge_top16(ca, cb);
    {
        float p[16];
#pragma unroll
        for (int i = 0; i < 16; ++i) p[i] = partner32(ca[i]);
        merge_top16(ca, p);
    }
    float sv[16]; int si[16];
    asm volatile("s_waitcnt lgkmcnt(0)" ::: "memory");
#pragma unroll
    for (int k = 0; k < 16; ++k) { sv[k] = ca[k]; si[k] = (int)tab[63u - (__float_as_uint(ca[k]) & 63u)]; }
    float ex[16], sum = 0.f;
#pragma unroll
    for (int k = 0; k < 16; ++k) { ex[k] = __expf(sv[k] - sv[0]); sum += ex[k]; }
    const float rs = 1.f / sum;
    if (!hi) {
        int* ip = IDX + (size_t)t * NPAIR + h * PTOPK;
#pragma unroll
        for (int k = 0; k < 16; k += 4) *(int4*)(ip + k) = make_int4(si[k], si[k + 1], si[k + 2], si[k + 3]);
    } else {
        float* gp = GATE + (size_t)t * NPAIR + h * PTOPK;
#pragma unroll
        for (int k = 0; k < 16; k += 4) *(f32x4*)(gp + k) = (f32x4){ex[k] * rs, ex[k + 1] * rs, ex[k + 2] * rs, ex[k + 3] * rs};
    }
}

struct SortIn { int id0, id1; float g0, g1; v4u x[4]; float ssq; };
__device__ __forceinline__ void sortq_load(SortIn& in, const bf16* X1B, const float* SSQ, const int* IDX, const float* GATE, int t, int lane) {
    in.id0 = IDX[(size_t)t * NPAIR + lane]; in.id1 = IDX[(size_t)t * NPAIR + 64 + lane];
    in.g0 = GATE[(size_t)t * NPAIR + lane]; in.g1 = GATE[(size_t)t * NPAIR + 64 + lane];
    const v4u* xr = (const v4u*)(X1B + (size_t)t * D) + lane;
#pragma unroll
    for (int j = 0; j < 4; ++j) in.x[j] = xr[64 * j];
    in.ssq = SSQ[t];
}
__device__ __forceinline__ void sortq_token(const SortIn& in, unsigned short* ES, unsigned short* ESG, float* GS, unsigned short* OFFN, float* SXS, unsigned char* XQ, int t, int lane) {
    const int id0 = in.id0, id1 = in.id1; const float g0 = in.g0, g1 = in.g1;
    const int k0 = egroup(id0), k1 = egroup(id1);
    int off = 0, pos0 = 0, pos1 = 0, myoffn = 0, rk0 = 0, rk1 = 0;
#pragma unroll
    for (int g = 0; g < NG; ++g) {
        const unsigned long long m0 = __ballot(k0 == g), m1 = __ballot(k1 == g);
        const int c0 = __popcll(m0), c1 = __popcll(m1);
        const int r0 = __builtin_amdgcn_mbcnt_hi((unsigned)(m0 >> 32), __builtin_amdgcn_mbcnt_lo((unsigned)m0, 0));
        const int r1 = __builtin_amdgcn_mbcnt_hi((unsigned)(m1 >> 32), __builtin_amdgcn_mbcnt_lo((unsigned)m1, 0));
        if (k0 == g) { pos0 = off + r0; rk0 = r0; }
        if (k1 == g) { pos1 = off + c0 + r1; rk1 = c0 + r1; }
        { const int ov_ = __builtin_amdgcn_readfirstlane(off | ((c0 + c1) << 8)); asm volatile("v_writelane_b32 %0, %1, %2" : "+v"(myoffn) : "s"(ov_), "n"(g)); }
        off += c0 + c1;
    }
    ES[(size_t)t * NPAIR + pos0] = (unsigned short)id0; ES[(size_t)t * NPAIR + pos1] = (unsigned short)id1;
    if (rk0 < 16) ESG[((size_t)t * NG + k0) * 16 + rk0] = (unsigned short)id0;
    if (rk1 < 16) ESG[((size_t)t * NG + k1) * 16 + rk1] = (unsigned short)id1;
    GS[(size_t)t * NPAIR + pos0] = g0; GS[(size_t)t * NPAIR + pos1] = g1;
    if (lane < NG) OFFN[(size_t)t * NG + lane] = (unsigned short)myoffn;
    const float inv_rms = 1.0f / sqrtf(in.ssq * (1.f / D) + RMS_EPS);
#pragma unroll
    for (int j = 0; j < 4; ++j) {
        const v4u xv = in.x[j];
        float f[8] = {bflo(xv.x), bfhi(xv.x), bflo(xv.y), bfhi(xv.y), bflo(xv.z), bfhi(xv.z), bflo(xv.w), bfhi(xv.w)};
        float m = 0.f;
#pragma unroll
        for (int i = 0; i < 8; ++i) m = fmaxf(m, fabsf(f[i]));
        m = fmaxf(m, __shfl_xor(m, 1)); m = fmaxf(m, __shfl_xor(m, 2)); m = fmaxf(m, __shfl_xor(m, 4)); m = fmaxf(m, __shfl_xor(m, 8));
        const float inv = m > 0.f ? 127.f / m : 0.f;
        unsigned w0 = 0, w1 = 0;
#pragma unroll
        for (int i = 0; i < 4; ++i) { w0 |= ((unsigned)((int)rintf(f[i] * inv) & 255)) << (8 * i); w1 |= ((unsigned)((int)rintf(f[4 + i] * inv) & 255)) << (8 * i); }
        *(u32x2*)(XQ + (size_t)t * D + 512 * j + 8 * lane) = (u32x2){w0, w1};
        if ((lane & 15) == 0) SXS[(size_t)t * NS + 4 * j + (lane >> 4)] = m * (1.f / 127.f) * inv_rms;
    }
}

#define U_DPPDOT(C) asm volatile("v_dot4c_i32_i8_dpp %0, %4, %8 row_ror:" #C " row_mask:0xf bank_mask:0xf\n\tv_dot4c_i32_i8_dpp %1, %5, %9 row_ror:" #C " row_mask:0xf bank_mask:0xf\n\t" \
        "v_dot4c_i32_i8_dpp %2, %6, %10 row_ror:" #C " row_mask:0xf bank_mask:0xf\n\tv_dot4c_i32_i8_dpp %3, %7, %11 row_ror:" #C " row_mask:0xf bank_mask:0xf" \
        : "+v"(a0_), "+v"(a1_), "+v"(a2_), "+v"(a3_) : "v"(xv_.x), "v"(xv_.y), "v"(xv_.z), "v"(xv_.w), "v"(tb_[C].x), "v"(tb_[C].y), "v"(tb_[C].z), "v"(tb_[C].w))
__device__ __forceinline__ void peer_u_role(const unsigned char* UQ, const float* SU, const unsigned char* XQ, const float* SXS, const unsigned short* ES, const unsigned short* ESG, const unsigned short* OFFN, float* PART,
                                            LAS unsigned char* lds, int role, int wave, int lane, int tid) {
    const int s = role & (NS - 1), g = role >> 4;
    __syncthreads();
    {
        const v4u* src = (const v4u*)(UQ + (size_t)role * EG * DW);
#pragma unroll 4
        for (int i = tid; i < EG * DW / 16; i += NWAVES * 64) *(LAS v4u*)(lds + (size_t)i * 16) = src[i];
        const float* ssrc = SU + (size_t)role * EG;
        for (int i = tid; i < EG; i += NWAVES * 64) *(LAS float*)(lds + LDS_SU_OFF + i * 4) = ssrc[i];
    }
    __syncthreads();
    STAMP(20);
    const int ts = lane >> 4, k = lane & 15, cid = lane & 7;
    float* part = PART + (size_t)s * T * NPAIR;
    int coff[8];
#pragma unroll
    for (int c_ = 0; c_ < 8; ++c_) coff[c_] = ((cid - c_) & 7) * 16;
    const unsigned tt0 = (unsigned)(4 * wave + ts);
    unsigned o_of = (tt0 * NG + g) * 2u, o_e = ((tt0 * NG + g) * 16u + k) * 2u, o_x = tt0 * D + s * DW + 16u * cid, o_s = (tt0 * NS + s) * 4u;
    const unsigned char* bOF = (const unsigned char*)OFFN; const unsigned char* bE = (const unsigned char*)ESG; const unsigned char* bS = (const unsigned char*)SXS;
#define U_TQ(I) (wave + NWAVES * (I))
#define U_LOAD(I, OF, E, XV, SX) do { OF = *(const unsigned short*)(bOF + o_of); E = *(const unsigned short*)(bE + o_e); XV = *(const v4u*)(XQ + o_x); SX = *(const float*)(bS + o_s); \
        o_of += 4 * NWAVES * NG * 2; o_e += 4 * NWAVES * NG * 32; o_x += 4 * NWAVES * D; o_s += 4 * NWAVES * NS * 4; } while (0)
#define U_DOT(ACC, EV, XV, ACTIVE) do { LAS const unsigned char* rowp_ = lds + erow((int)(EV)) * DW; v4u tb_[8]; const v4u xv_ = (XV); \
        _Pragma("unroll") for (int c_ = 0; c_ < 8; ++c_) tb_[c_] = (v4u){0u, 0u, 0u, 0u}; \
        if (ACTIVE) { _Pragma("unroll") for (int c_ = 0; c_ < 8; ++c_) tb_[c_] = *(const LAS v4u*)(rowp_ + coff[c_]); } \
        int a0_ = 0, a1_ = 0, a2_ = 0, a3_ = 0; \
        asm volatile("s_nop 4\n\tv_dot4c_i32_i8 %0, %4, %8\n\tv_dot4c_i32_i8 %1, %5, %9\n\tv_dot4c_i32_i8 %2, %6, %10\n\tv_dot4c_i32_i8 %3, %7, %11" \
            : "+v"(a0_), "+v"(a1_), "+v"(a2_), "+v"(a3_) : "v"(xv_.x), "v"(xv_.y), "v"(xv_.z), "v"(xv_.w), "v"(tb_[0].x), "v"(tb_[0].y), "v"(tb_[0].z), "v"(tb_[0].w)); \
        U_DPPDOT(1); U_DPPDOT(2); U_DPPDOT(3); U_DPPDOT(4); U_DPPDOT(5); U_DPPDOT(6); U_DPPDOT(7); ACC = (a0_ + a1_) + (a2_ + a3_); } while (0)
#define U_RD(TB, SUV, E, OF) do { const int r_ = erow((int)(E)); LAS const unsigned char* rowp_ = lds + r_ * DW; \
        if (k < (int)((OF) >> 8)) { _Pragma("unroll") for (int c_ = 0; c_ < 8; ++c_) TB[c_] = *(const LAS v4u*)(rowp_ + coff[c_]); SUV = *(const LAS float*)(lds + LDS_SU_OFF + r_ * 4); } } while (0)
#define U_DPPD(C, TB) asm volatile("v_dot4c_i32_i8_dpp %0, %4, %8 row_ror:" #C " row_mask:0xf bank_mask:0xf\n\tv_dot4c_i32_i8_dpp %1, %5, %9 row_ror:" #C " row_mask:0xf bank_mask:0xf\n\t" \
        "v_dot4c_i32_i8_dpp %2, %6, %10 row_ror:" #C " row_mask:0xf bank_mask:0xf\n\tv_dot4c_i32_i8_dpp %3, %7, %11 row_ror:" #C " row_mask:0xf bank_mask:0xf" \
        : "+v"(a0_), "+v"(a1_), "+v"(a2_), "+v"(a3_) : "v"(xv_.x), "v"(xv_.y), "v"(xv_.z), "v"(xv_.w), "v"(TB[C].x), "v"(TB[C].y), "v"(TB[C].z), "v"(TB[C].w))
#define U_MATH(I, OF, TB, SUV, XV, SX) do { const int t_ = 4 * U_TQ(I) + ts; const int j0_ = (OF) & 255, n_ = (OF) >> 8; const v4u xv_ = (XV); int a0_ = 0, a1_ = 0, a2_ = 0, a3_ = 0; \
        asm volatile("s_nop 4\n\tv_dot4c_i32_i8 %0, %4, %8\n\tv_dot4c_i32_i8 %1, %5, %9\n\tv_dot4c_i32_i8 %2, %6, %10\n\tv_dot4c_i32_i8 %3, %7, %11" \
            : "+v"(a0_), "+v"(a1_), "+v"(a2_), "+v"(a3_) : "v"(xv_.x), "v"(xv_.y), "v"(xv_.z), "v"(xv_.w), "v"(TB[0].x), "v"(TB[0].y), "v"(TB[0].z), "v"(TB[0].w)); \
        U_DPPD(1, TB); U_DPPD(2, TB); U_DPPD(3, TB); U_DPPD(4, TB); U_DPPD(5, TB); U_DPPD(6, TB); U_DPPD(7, TB); \
        if (k < n_) part[(size_t)t_ * NPAIR + j0_ + k] = (float)((a0_ + a1_) + (a2_ + a3_)) * (SUV) * (SX); } while (0)
    unsigned of0, of1, of2, of3, of4, of5, of6, of7, e0, e1, e2, e3, e4, e5, e6, e7; v4u x0, x1, x2, x3, x4, x5, x6, x7; float s0, s1, s2, s3, s4, s5, s6, s7;
    v4u tA[8], tB[8]; float uA = 0.f, uB = 0.f;
#pragma unroll
    for (int c_ = 0; c_ < 8; ++c_) { tA[c_] = (v4u){0u, 0u, 0u, 0u}; tB[c_] = (v4u){0u, 0u, 0u, 0u}; }
    U_LOAD(0, of0, e0, x0, s0); U_LOAD(1, of1, e1, x1, s1); U_LOAD(2, of2, e2, x2, s2); U_LOAD(3, of3, e3, x3, s3);
    U_RD(tA, uA, e0, of0);
#pragma unroll 1
    for (int it = 0; it < T / 4 / NWAVES; it += 8) {
        U_LOAD(it + 4, of4, e4, x4, s4); U_RD(tB, uB, e1, of1); U_MATH(it, of0, tA, uA, x0, s0); __builtin_amdgcn_sched_barrier(0);
        U_LOAD(it + 5, of5, e5, x5, s5); U_RD(tA, uA, e2, of2); U_MATH(it + 1, of1, tB, uB, x1, s1); __builtin_amdgcn_sched_barrier(0);
        U_LOAD(it + 6, of6, e6, x6, s6); U_RD(tB, uB, e3, of3); U_MATH(it + 2, of2, tA, uA, x2, s2); __builtin_amdgcn_sched_barrier(0);
        U_LOAD(it + 7, of7, e7, x7, s7); U_RD(tA, uA, e4, of4); U_MATH(it + 3, of3, tB, uB, x3, s3); __builtin_amdgcn_sched_barrier(0);
        U_LOAD(it + 8, of0, e0, x0, s0); U_RD(tB, uB, e5, of5); U_MATH(it + 4, of4, tA, uA, x4, s4); __builtin_amdgcn_sched_barrier(0);
        U_LOAD(it + 9, of1, e1, x1, s1); U_RD(tA, uA, e6, of6); U_MATH(it + 5, of5, tB, uB, x5, s5); __builtin_amdgcn_sched_barrier(0);
        U_LOAD(it + 10, of2, e2, x2, s2); U_RD(tB, uB, e7, of7); U_MATH(it + 6, of6, tA, uA, x6, s6); __builtin_amdgcn_sched_barrier(0);
        U_LOAD(it + 11, of3, e3, x3, s3); U_RD(tA, uA, e0, of0); U_MATH(it + 7, of7, tB, uB, x7, s7); __builtin_amdgcn_sched_barrier(0);
    }
#undef U_RD
#undef U_DPPD
#undef U_MATH
    STAMP(21);
    {
        unsigned ofl[16];
#pragma unroll
        for (int b16 = 0; b16 < 16; ++b16) { const int i_ = b16 * 64 + lane; const int t_l = 4 * (wave + NWAVES * (i_ >> 2)) + (i_ & 3); ofl[b16] = OFFN[(size_t)t_l * NG + g]; }
#pragma unroll
        for (int b16 = 0; b16 < 16; ++b16) {
            const int i_ = b16 * 64 + lane; const int t_l = 4 * (wave + NWAVES * (i_ >> 2)) + (i_ & 3);
            const unsigned of_l = ofl[b16];
            unsigned long long mask = __ballot((of_l >> 8) > 16u);
            while (mask) {
                const int b = __builtin_ctzll(mask); mask &= mask - 1;
                const int t_o = __builtin_amdgcn_readlane(t_l, b); const unsigned of_o = (unsigned)__builtin_amdgcn_readlane((int)of_l, b);
                const int j0_ = of_o & 255, n_ = of_o >> 8;
                const v4u xo = *(const v4u*)(XQ + (size_t)t_o * D + s * DW + 16 * cid); const float so = SXS[(size_t)t_o * NS + s];
                for (int kk = 16 + 16 * ts + k; __any(kk < n_); kk += 64) {
                    const unsigned e2 = (kk < n_) ? ES[(size_t)t_o * NPAIR + j0_ + kk] : 0u; int a2; U_DOT(a2, e2, xo, kk < n_);
                    const float su2 = *(const LAS float*)(lds + LDS_SU_OFF + erow((int)e2) * 4);
                    if (kk < n_) part[(size_t)t_o * NPAIR + j0_ + kk] = (float)a2 * su2 * so;
                }
            }
        }
    }
    STAMP(23);
#undef U_LOAD
#undef U_TQ
#undef U_DOT
}

__device__ __forceinline__ void peer_reduce_tile(const float* PART, const float* GS, const unsigned short* ES, const float* SV, unsigned* E32, unsigned char* A8, float* TS, int tile, int tid) {
    const int t = tile * 32 + (tid >> 4), sidx = tid & 15, jb = sidx * 8; const size_t base = (size_t)t * NPAIR + jb;
    f32x4 h0 = (f32x4){0.f, 0.f, 0.f, 0.f}, h1 = h0;
#pragma unroll
    for (int sl = 0; sl < NS; ++sl) { const float* p = PART + (size_t)sl * T * NPAIR + base; h0 += *(const f32x4*)p; h1 += *(const f32x4*)(p + 4); }
    const f32x4 ga = *(const f32x4*)(GS + base), gb = *(const f32x4*)(GS + base + 4);
    const v4u ev = *(const v4u*)(ES + base);
    const float hh[8] = {h0.x, h0.y, h0.z, h0.w, h1.x, h1.y, h1.z, h1.w}; const float gg[8] = {ga.x, ga.y, ga.z, ga.w, gb.x, gb.y, gb.z, gb.w};
    const unsigned ee[8] = {ev.x & 0xffffu, ev.x >> 16, ev.y & 0xffffu, ev.y >> 16, ev.z & 0xffffu, ev.z >> 16, ev.w & 0xffffu, ev.w >> 16};
    float a[8]; float m = 0.f;
#pragma unroll
    for (int i = 0; i < 8; ++i) { const float h = hh[i]; a[i] = 0.5f * h * (1.f + erff(h * 0.70710678118654752f)) * gg[i] * SV[ee[i]]; m = fmaxf(m, fabsf(a[i])); }
    m = fmaxf(m, __shfl_xor(m, 1)); m = fmaxf(m, __shfl_xor(m, 2)); m = fmaxf(m, __shfl_xor(m, 4)); m = fmaxf(m, __shfl_xor(m, 8));
    const float inv = m > 0.f ? 127.f / m : 0.f;
    unsigned w0 = 0, w1 = 0;
#pragma unroll
    for (int i = 0; i < 4; ++i) { w0 |= ((unsigned)((int)rintf(a[i] * inv) & 255)) << (8 * i); w1 |= ((unsigned)((int)rintf(a[4 + i] * inv) & 255)) << (8 * i); }
    *(u32x2*)(A8 + base) = (u32x2){w0, w1};
    if (sidx == 0) TS[t] = m * (1.f / 127.f);
#pragma unroll
    for (int q = 0; q < 8; ++q) E32[(size_t)t * NPAIR + q * 16 + sidx] = ee[q] * 8u;
}

#ifndef TR_MAP
#define TR_MAP 0
#endif
typedef int v2i_t __attribute__((ext_vector_type(2)));
__device__ __forceinline__ void peer_v_role(const unsigned char* VQ, const unsigned* E32, const unsigned char* A8, const float* TS, const bf16* X1B, float* X  , float* SSQ2,
                                            LAS unsigned char* lds, int c, int wave, int lane, int tid) {
    __syncthreads();
    {
        const v4u* src = (const v4u*)(VQ + (size_t)c * NEXP * 8);
#pragma unroll 4
        for (int i = tid; i < NEXP * 8 / 16; i += NWAVES * 64) *(LAS v4u*)(lds + (size_t)i * 16) = src[i];
    }
    __syncthreads();
    STAMP(22);
    const int G16 = lane >> 4, L = lane & 15;
    const int sq = (TR_MAP == 0) ? (L >> 1) : (L & 7), sp = (TR_MAP == 0) ? (L & 1) : (L >> 3);
    const int rp = L >> 3, rd = L & 7;
    LAS unsigned char* stg = lds + LDS_SU_OFF + wave * 2304;
    LAS unsigned char* stw = stg + (lane >> 3) * 144 + (lane & 7) * 16;
    LAS const unsigned char* str = stg + (2 * G16 + rp) * 144;
    const unsigned char* bE = (const unsigned char*)E32; const unsigned char* bX = (const unsigned char*)X1B; const unsigned char* bT = (const unsigned char*)TS;
    const unsigned oE0 = ((unsigned)(2 * G16 + sp) * NPAIR + sq * 16) * 4u, oA0 = (unsigned)(lane >> 3) * NPAIR + (lane & 7) * 16u, oX0 = ((unsigned)(2 * G16 + rp) * D + 8 * c + rd) * 2u, oT0 = (unsigned)(2 * G16 + rp) * 4u;
#define V_LD(IT, ES, AV, XS, SS) do { const unsigned it_ = (unsigned)(IT); \
        const v4u* ep_ = (const v4u*)(bE + (oE0 + it_ * (8u * NPAIR * 4u))); ES[0] = ep_[0]; ES[1] = ep_[1]; ES[2] = ep_[2]; ES[3] = ep_[3]; \
        AV = *(const v4u*)(A8 + (oA0 + it_ * (8u * NPAIR))); \
        XS = *(const unsigned short*)(bX + (oX0 + it_ * (8u * D * 2u))); SS = *(const float*)(bT + (oT0 + it_ * 32u)); } while (0)
#define V_TR(EO) __builtin_amdgcn_ds_read_tr8_b64_v2i32((LAS v2i_t*)(unsigned)(EO))
#define V_DO(IT, ES, AV, XS, SS, BUF) do { *(LAS v4u*)(stw + (BUF) * 1152) = AV; \
        v2i_t r_[16]; v4u a_[8]; \
        r_[0] = V_TR(ES[0].x); r_[1] = V_TR(ES[0].y); r_[2] = V_TR(ES[0].z); r_[3] = V_TR(ES[0].w); r_[4] = V_TR(ES[1].x); r_[5] = V_TR(ES[1].y); r_[6] = V_TR(ES[1].z); r_[7] = V_TR(ES[1].w); \
        r_[8] = V_TR(ES[2].x); r_[9] = V_TR(ES[2].y); r_[10] = V_TR(ES[2].z); r_[11] = V_TR(ES[2].w); r_[12] = V_TR(ES[3].x); r_[13] = V_TR(ES[3].y); r_[14] = V_TR(ES[3].z); r_[15] = V_TR(ES[3].w); \
        _Pragma("unroll") for (int k_ = 0; k_ < 8; ++k_) a_[k_] = *(const LAS v4u*)(str + (BUF) * 1152 + k_ * 16); \
        __builtin_amdgcn_sched_barrier(0); \
        int acc = 0, acc2 = 0; \
        _Pragma("unroll") for (int k_ = 0; k_ < 8; ++k_) { acc = __builtin_amdgcn_sdot4((int)a_[k_].x, r_[2 * k_].x, acc, false); acc2 = __builtin_amdgcn_sdot4((int)a_[k_].y, r_[2 * k_].y, acc2, false); \
            acc = __builtin_amdgcn_sdot4((int)a_[k_].z, r_[2 * k_ + 1].x, acc, false); acc2 = __builtin_amdgcn_sdot4((int)a_[k_].w, r_[2 * k_ + 1].y, acc2, false); } \
        const float y_ = __uint_as_float((unsigned)(XS) << 16) + (float)(acc + acc2) * (SS); \
        *(float*)((unsigned char*)X + (oX0 * 2u + (unsigned)(IT) * (8u * D * 4u))) = y_; float ss_ = y_ * y_; ss_ += __int_as_float(__builtin_amdgcn_mov_dpp(__float_as_int(ss_), 0xB1, 0xf, 0xf, false)); ss_ += __int_as_float(__builtin_amdgcn_mov_dpp(__float_as_int(ss_), 0x4E, 0xf, 0xf, false)); \
        ss_ += __int_as_float(__builtin_amdgcn_mov_dpp(__float_as_int(ss_), 0x141, 0xf, 0xf, false)); \
        *(float*)((unsigned char*)SSQ2 + (((unsigned)(2 * G16 + rp) * (D / 8) + c) * 4u + (unsigned)(IT) * (8u * (D / 8) * 4u))) = ss_; } while (0)
    v4u eA[4], eB[4], eC[4], eD[4], aA, aB, aC, aD; unsigned short xA, xB, xC, xD; float sA, sB, sC, sD;
#define V_IT(I) ((I) < T / 8 ? (I) : T / 8 - 1)
    V_LD(V_IT(wave), eA, aA, xA, sA); V_LD(V_IT(wave + NWAVES), eB, aB, xB, sB); V_LD(V_IT(wave + 2 * NWAVES), eC, aC, xC, sC);
#pragma unroll 1
    for (int it = wave; it < T / 8; it += 4 * NWAVES) {
        V_LD(V_IT(it + 3 * NWAVES), eD, aD, xD, sD); V_DO(it, eA, aA, xA, sA, 0);
        V_LD(V_IT(it + 4 * NWAVES), eA, aA, xA, sA); V_DO(it + NWAVES, eB, aB, xB, sB, 1);
        V_LD(V_IT(it + 5 * NWAVES), eB, aB, xB, sB); V_DO(it + 2 * NWAVES, eC, aC, xC, sC, 0);
        V_LD(V_IT(it + 6 * NWAVES), eC, aC, xC, sC); V_DO(it + 3 * NWAVES, eD, aD, xD, sD, 1);
    }
#undef V_IT
#undef V_LD
#undef V_TR
#undef V_DO
    STAMP(24);
}
__device__ __forceinline__ void final_norm_row(float* X, const float* SSQP, const float* gfin, int t, int lane) {
    const f32x4 pp = *((const f32x4*)(SSQP + (size_t)t * (D / 8)) + lane);
    const float inv = 1.0f / sqrtf(wave_sum((pp.x + pp.y) + (pp.z + pp.w)) * (1.f / D) + RMS_EPS);
    f32x4* xr = (f32x4*)(X + (size_t)t * D) + lane; const f32x4* gr = (const f32x4*)gfin + lane;
    f32x4 v[8];
#pragma unroll
    for (int j = 0; j < 8; ++j) v[j] = xr[64 * j];
#pragma unroll
    for (int j = 0; j < 8; ++j) { const f32x4 g = gr[64 * j]; xr[64 * j] = (f32x4){v[j].x * inv * g.x, v[j].y * inv * g.y, v[j].z * inv * g.z, v[j].w * inv * g.w}; }
}

#ifndef PHASE_MASK
#define PHASE_MASK 0x1ff
#endif
#define PH_ON(k) ((PHASE_MASK >> (k)) & 1)
#ifndef REP_MASK
#define REP_MASK 0
#endif
#define PH_REP(k) (1 + ((REP_MASK >> (k)) & 1))
__device__ __forceinline__ Ptrs load_args() {
#if defined(__HIP_DEVICE_COMPILE__)
    const __attribute__((address_space(4))) Ptrs* pp = (const __attribute__((address_space(4))) Ptrs*)__builtin_amdgcn_kernarg_segment_ptr();
    asm volatile("" : "+s"(pp));
    Ptrs r;
    r.x = pp->x; r.norm_mix = pp->norm_mix; r.w_in = pp->w_in; r.conv_w = pp->conv_w; r.w_conv_out = pp->w_conv_out; r.w_attn_out = pp->w_attn_out; r.w_out = pp->w_out; r.norm_ffn = pp->norm_ffn;
    r.peer_wq = pp->peer_wq; r.peer_sk = pp->peer_sk; r.peer_u = pp->peer_u; r.peer_v = pp->peer_v; r.norm_final = pp->norm_final; r.out = pp->out; r.ws = pp->ws;
    return r;
#else
    return Ptrs{};
#endif
}
__global__ void __launch_bounds__(NWAVES * 64, 2) hyb_fwd(Ptrs Punused) {
    extern __shared__ __attribute__((aligned(16))) unsigned char lds_raw[];
    LAS unsigned char* lds = (LAS unsigned char*)lds_raw;
    const int G = gridDim.x; const int bx = blockIdx.x; const int vcu = (G % 8 == 0) ? (bx % 8) * (G / 8) + bx / 8 : bx;
    const int wave = __builtin_amdgcn_readfirstlane(threadIdx.x >> 6);
#define TIDV const int lane = hw_lane(), tid = wave * 64 + lane; const int gw = vcu * NWAVES + wave, NGW = G * NWAVES; (void)gw; (void)NGW; (void)lane;
    XcdBarrier bar;
    {
        TIDV; const Ptrs P = load_args();
        volatile LAS unsigned* MISC = (volatile LAS unsigned*)(lds + MISC_OFF);
        for (int u = tid; u < 128; u += NWAVES * 64) ((LAS unsigned*)(lds + LDSCTL_OFF))[u] = 0u;
        __syncthreads();
        bar = xcd_barrier_post((unsigned*)(P.ws + WS_CTL) + CW_BAR, MISC + 8, wave);
    }
#define CTLP ((unsigned*)(P.ws + WS_CTL))
    STAMP(0);

    if (PH_ON(0)) { TIDV; const Ptrs P = load_args(); p0_prologue(P, lds, vcu, G, wave, lane, tid); }
    xcd_barrier_w(bar, wave);
    { TIDV; const Ptrs P = load_args(); p0_win_i8(P, lds, vcu, G, wave, lane); }
    xcd_barrier_w(bar, wave);
    STAMP(1);

    if (PH_ON(1)) {
        const Ptrs P = load_args();
        pg8::Gemm g{(const pg8::bf16_t*)(P.ws + WS_XN), (const pg8::bf16_t*)(P.ws + WS_WIN), T, INW, D}; pg8::StaticOrder S; S.init(T, INW, G, bx);
        pg8::EpiStoreI8 E{(pg8::bf16_t*)(P.ws + WS_PROJ), INW, (const float*)(P.ws + WS_SA), (const float*)(CTLP + CW_COLMAX)};
        pg8::gemm_phase<pg8::EpiStoreI8, pg8::StaticOrder, true, true, true>(lds + RING_OFF, g, S, E, wave);
    }
    xcd_barrier_w(bar, wave);
    STAMP(2);

    if (PH_ON(2)) {
        TIDV; const Ptrs P = load_args();
        p2_conv(P, gw * 64 + lane, NGW * 64);
        const bf16* PROJ = (const bf16*)(P.ws + WS_PROJ); bf16* YA = (bf16*)(P.ws + WS_YA);
        LAS unsigned char* vl = lds + RING_OFF + wave * 4096;
        constexpr int NTASK = (T / 32) * NH;
        for (int it = gw; it < NTASK; it += NGW) { const int task = NTASK - 1 - it; attn_task(PROJ, YA, vl, task / NH, task % NH, lane); }
    }
    xcd_barrier_w(bar, wave);
    STAMP(3);

    if (PH_ON(3)) {
        pg8::StaticOrder S; S.init(T, D, G, bx);
        { const Ptrs P = load_args();
          pg8::Gemm g{(const pg8::bf16_t*)(P.ws + WS_YC), (const pg8::bf16_t*)(P.ws + WS_WCO), T, D, CW};
          pg8::EpiGate<0> E{(const pg8::bf16_t*)(P.ws + WS_PROJ) + C_GC, INW, (pg8::bf16_t*)(P.ws + WS_XN), D};
          pg8::gemm_phase<pg8::EpiGate<0>, pg8::StaticOrder, true, true>(lds + RING_OFF, g, S, E, wave); }
        { const Ptrs P = load_args();
          pg8::Gemm g{(const pg8::bf16_t*)(P.ws + WS_YA), (const pg8::bf16_t*)(P.ws + WS_WAO), T, D, AW};
          pg8::EpiGate<1> E{(const pg8::bf16_t*)(P.ws + WS_PROJ) + C_GA, INW, (pg8::bf16_t*)(P.ws + WS_XN), D};
          pg8::gemm_phase<pg8::EpiGate<1>, pg8::StaticOrder, true, true>(lds + RING_OFF, g, S, E, wave); }
    }
    xcd_barrier_w(bar, wave);
    STAMP(4);

    if (PH_ON(4)) {
        const Ptrs P = load_args();
        pg8::Gemm g{(const pg8::bf16_t*)(P.ws + WS_XN), (const pg8::bf16_t*)(P.ws + WS_WO), T, D, D}; pg8::StaticOrder S; S.init(T, D, G, bx);
        pg8::EpiX1 E{P.x, (pg8::bf16_t*)(P.ws + WS_X1B), (float*)(CTLP + CW_SSQ), D};
        pg8::gemm_phase<pg8::EpiX1, pg8::StaticOrder, true, true>(lds + RING_OFF, g, S, E, wave);
    }
    xcd_barrier_w(bar, wave);
    STAMP(5);

    if (PH_ON(5)) {
        const Ptrs P = load_args();
        pg8::Gemm g{(const pg8::bf16_t*)(P.ws + WS_X1B), (const pg8::bf16_t*)(P.ws + WS_WQ), T, D, D}; pg8::StaticOrder S; S.init(T, D, G, bx);
        pg8::EpiQP E{(const float*)(CTLP + CW_SSQ), (pg8::bf16_t*)(P.ws + WS_QP), D, 1.f / D, RMS_EPS};
        pg8::gemm_phase<pg8::EpiQP, pg8::StaticOrder, true, true>(lds + RING_OFF, g, S, E, wave);
    }
    xcd_barrier_w(bar, wave);
    STAMP(6);

    if (PH_ON(6)) {
        TIDV; const Ptrs P = load_args();
#define P6_TOPK(TILE) topk_task((const bf16*)(P.ws + WS_QP), (const bf16*)(P.ws + WS_SK), (int*)(P.ws + WS_IDX), (float*)(P.ws + WS_GATE), lds + RING_OFF + wave * 4096, TILE, wave, lane)
#define P6_SORT(TILE) do { asm volatile("s_waitcnt vmcnt(0)" ::: "memory"); __builtin_amdgcn_fence(__ATOMIC_RELEASE, "workgroup"); __syncthreads(); __builtin_amdgcn_fence(__ATOMIC_ACQUIRE, "workgroup"); \
            SortIn i0, i1; const int t0 = (TILE) * 32 + wave * 4; \
            unsigned char* ws2 = P.ws; asm volatile("" : "+s"(ws2)); \
            const bf16* X1B_ = (const bf16*)(ws2 + WS_X1B); const float* SSQ_ = (const float*)((unsigned*)(ws2 + WS_CTL) + CW_SSQ); const int* IDX_ = (const int*)(ws2 + WS_IDX); const float* GATE_ = (const float*)(ws2 + WS_GATE); \
            sortq_load(i0, X1B_, SSQ_, IDX_, GATE_, t0, lane); sortq_load(i1, X1B_, SSQ_, IDX_, GATE_, t0 + 1, lane); \
            SQ_DO(i0, t0); sortq_load(i0, X1B_, SSQ_, IDX_, GATE_, t0 + 2, lane); asm volatile("" ::: "memory"); \
            SQ_DO(i1, t0 + 1); sortq_load(i1, X1B_, SSQ_, IDX_, GATE_, t0 + 3, lane); asm volatile("" ::: "memory"); \
            SQ_DO(i0, t0 + 2); asm volatile("" ::: "memory"); SQ_DO(i1, t0 + 3); } while (0)
#define SQ_DO(IN, TT) sortq_token(IN, (unsigned short*)(ws2 + WS_ES), (unsigned short*)(ws2 + WS_ESG), (float*)(ws2 + WS_GS), (unsigned short*)(ws2 + WS_OFFN), (float*)(ws2 + WS_SXS), ws2 + WS_XQ, TT, lane)
        if (vcu < T / 32) {
            if ((wave & 4) == 0) peer_tables_to_i8(P, gw, NGW, lane);
            P6_TOPK(vcu);
            if ((wave & 4) != 0) peer_tables_to_i8(P, gw, NGW, lane);
            P6_SORT(vcu);
        } else peer_tables_to_i8(P, gw, NGW, lane);
#pragma unroll 1
        for (int tile = vcu + G; tile < T / 32; tile += G) { P6_TOPK(tile); P6_SORT(tile); }
#undef SQ_DO
#undef P6_TOPK
#undef P6_SORT
    }
    xcd_barrier_w(bar, wave);
    STAMP(7);
    {
        TIDV; const Ptrs P = load_args();
        for (int role = bx; role < NS * NG; role += G) peer_u_role(P.ws + WS_UQ, (const float*)(P.ws + WS_SU), P.ws + WS_XQ, (const float*)(P.ws + WS_SXS), (const unsigned short*)(P.ws + WS_ES), (const unsigned short*)(P.ws + WS_ESG),
                                                                  (const unsigned short*)(P.ws + WS_OFFN), (float*)(P.ws + WS_PART), lds, role, wave, lane, tid);
    }
    xcd_barrier_w(bar, wave);
    STAMP(8);
    {
        TIDV; const Ptrs P = load_args();
        for (int tile = vcu; tile < T / 32; tile += G) peer_reduce_tile((const float*)(P.ws + WS_PART), (const float*)(P.ws + WS_GS), (const unsigned short*)(P.ws + WS_ES), (const float*)(P.ws + WS_SV), (unsigned*)(P.ws + WS_E32), P.ws + WS_A8, (float*)(P.ws + WS_TS), tile, tid);
    }
    xcd_barrier_w(bar, wave);
    STAMP(9);

    if (PH_ON(8)) {
        TIDV; const Ptrs P = load_args();
        for (int c = vcu; c < D / 8; c += G) peer_v_role(P.ws + WS_VQ, (const unsigned*)(P.ws + WS_E32), P.ws + WS_A8, (const float*)(P.ws + WS_TS), (const bf16*)(P.ws + WS_X1B), P.out, (float*)(P.ws + WS_SSQP), lds, c, wave, lane, tid);
    }
    xcd_barrier_w(bar, wave);
    STAMP(10);

    {
        TIDV; const Ptrs P = load_args();
        for (int t = gw; t < T; t += NGW) final_norm_row(P.out, (const float*)(P.ws + WS_SSQP), P.norm_final, t, lane);
    }
    if (PROBE_PHASE >= 0 && blockIdx.x == 0 && wave == 0 && hw_lane() == 0) {
        const unsigned long long now = __builtin_amdgcn_s_memrealtime();
        *(volatile LAS unsigned long long*)(lds + LDSCTL_OFF + 64 + 8 * 12) = now;
        const unsigned long long a = *(volatile LAS unsigned long long*)(lds + LDSCTL_OFF + 64 + 8 * PROBE_A);
        const unsigned long long b = *(volatile LAS unsigned long long*)(lds + LDSCTL_OFF + 64 + 8 * PROBE_B);
        const unsigned long long dt = (b - a) * 8ull;
        while (__builtin_amdgcn_s_memrealtime() - now < dt) __builtin_amdgcn_s_sleep(8);
    }
}

extern "C" void kernel_launch(void* const* d_in, const int* in_sizes, int n_in, void* d_out, int out_size, void* d_ws, size_t ws_size, hipStream_t stream) {
    static int grid = 0;
    if (grid == 0) {
        if (n_in != 13 || out_size != T * D || ws_size < WS_END) { fprintf(stderr, "kernel_launch: unexpected shapes (n_in %d out %d ws %zu)\n", n_in, out_size, ws_size); grid = -1; return; }
        int dev = 0, cus = 0, per_cu = 0;
        if (hipGetDevice(&dev) != hipSuccess || hipDeviceGetAttribute(&cus, hipDeviceAttributeMultiprocessorCount, dev) != hipSuccess) { grid = -1; return; }
        if (hipFuncSetAttribute((const void*)hyb_fwd, hipFuncAttributeMaxDynamicSharedMemorySize, LDS_BYTES) != hipSuccess) { fprintf(stderr, "kernel_launch: hipFuncSetAttribute failed\n"); grid = -1; return; }
        if (hipOccupancyMaxActiveBlocksPerMultiprocessor(&per_cu, (const void*)hyb_fwd, NWAVES * 64, LDS_BYTES) != hipSuccess || per_cu < 1) { fprintf(stderr, "kernel_launch: occupancy query says %d\n", per_cu); per_cu = 1; }
        (void)hipGetLastError();
        grid = cus;
    }
    if (grid < 0) return;
    (void)hipMemsetAsync((char*)d_ws + WS_CTL, 0, CTL_ZERO_BYTES, stream);
    Ptrs p{};
    p.x = (const float*)d_in[0]; p.norm_mix = (const float*)d_in[1]; p.w_in = (const float*)d_in[2]; p.conv_w = (const float*)d_in[3];
    p.w_conv_out = (const float*)d_in[4]; p.w_attn_out = (const float*)d_in[5]; p.w_out = (const float*)d_in[6]; p.norm_ffn = (const float*)d_in[7];
    p.peer_wq = (const float*)d_in[8]; p.peer_sk = (const float*)d_in[9]; p.peer_u = (const float*)d_in[10]; p.peer_v = (const float*)d_in[11]; p.norm_final = (const float*)d_in[12];
    p.out = (float*)d_out; p.ws = (unsigned char*)d_ws;
    void* args[] = {&p};
    hipError_t e = hipLaunchCooperativeKernel((const void*)hyb_fwd, dim3(grid), dim3(NWAVES * 64), args, LDS_BYTES, stream);
    if (e != hipSuccess) fprintf(stderr, "kernel_launch: cooperative launch failed: %s (grid %d)\n", hipGetErrorString(e), grid);
}
```

```cpp
#include <hip/hip_runtime.h>
#include <cstdio>
#include <cstdint>
__device__ __forceinline__ int hw_lane() { return (int)__builtin_amdgcn_mbcnt_hi(~0u, __builtin_amdgcn_mbcnt_lo(~0u, 0u)); }
namespace pg8 {
#define PG8_LAS __attribute__((address_space(3)))
typedef unsigned short bf16_t;
typedef short bf16x8 __attribute__((ext_vector_type(8)));
typedef float f32x4 __attribute__((ext_vector_type(4)));
typedef unsigned u32x4 __attribute__((ext_vector_type(4)));
constexpr int BM = 256, BK = 64, HALF = 128, HTB = HALF * BK * 2  , STAGE_BYTES = 8 * HTB, NXCD = 8, WGM = 4;

__host__ __device__ __forceinline__ int lds_byte(int r, int c) { const int st = (r >> 4) * 2 + (c >> 5), rr = r & 15, cc = c & 31, ob = rr * 64 + cc * 2; return st * 1024 + (ob ^ (((ob >> 9) & 1) << 5)); }
__host__ __device__ __forceinline__ void stage_rc(int b, int& R, int& C) { const int st = b / 1024, sb = b % 1024, swz = sb ^ (((sb >> 9) & 1) << 5); R = (st >> 1) * 16 + swz / 64; C = (st & 1) * 32 + (swz % 64) / 2; }
__host__ __device__ __forceinline__ int perm32(int rho) { const int n = rho >> 4, i = rho & 15; return 8 * (i >> 2) + 4 * n + (i & 3); }

struct Unit { int pm, pn, last; };
struct Gemm { const bf16_t* A; const bf16_t* Bt; int M, N, K; const bf16_t* A2 = nullptr; const bf16_t* Bt2 = nullptr; };

struct StaticOrder {
    int nM, nN, nwg, G, c;
    __host__ __device__ void init(int M, int N, int G_, int c_) { nM = M / BM; nN = N / BM; nwg = nM * nN; G = G_; c = c_; }
    __host__ __device__ bool next(int i, Unit& u) const {
        const long L = (long)i * G + c; if (L >= nwg) return false;
        int wgid = (int)L; { const int q = nwg / NXCD, r = nwg % NXCD, xcd = wgid % NXCD, off = wgid / NXCD; wgid = (xcd < r ? xcd * (q + 1) : r * (q + 1) + (xcd - r) * q) + off; }
        const int nig = WGM * nN, gid = wgid / nig, fm = gid * WGM, gsz = (nM - fm) < WGM ? (nM - fm) : WGM;
        u.pm = fm + ((wgid % nig) % gsz); u.pn = (wgid % nig) / gsz; return true;
    }
    __device__ __forceinline__ void a_ready(const Unit&) const {}
    __device__ __forceinline__ void done(const Unit&) const {}
};


typedef int i32x4 __attribute__((ext_vector_type(4)));
__device__ __forceinline__ unsigned cvt_pk_bf16(float lo, float hi) { unsigned r; asm volatile("v_cvt_pk_bf16_f32 %0, %1, %2" : "=v"(r) : "v"(lo), "v"(hi)); return r; }
__device__ __forceinline__ float bf_lo(unsigned w) { return __uint_as_float(w << 16); }
__device__ __forceinline__ float bf_hi(unsigned w) { return __uint_as_float(w & 0xffff0000u); }
__device__ __forceinline__ float sigmoidf_fast(float x) { return __builtin_amdgcn_rcpf(1.0f + __builtin_amdgcn_exp2f(-1.4426950408889634f * x)); }

__device__ __forceinline__ void store16(void* p, u32x4 w, int wt) {
    if (wt) asm volatile("global_store_dwordx4 %0, %1, off sc1" :: "v"(p), "v"(w) : "memory"); else *(u32x4*)p = w;
}
struct EpiStore {
    static constexpr bool PERM = true, AFTER_DRAIN = false;
    bf16_t* O; int ldc;
    __device__ __forceinline__ void operator()(const f32x4 (&acc)[2][2][4][2], const Unit& u, int wr, int wc, int fr, int fq) const {
        const int row0 = u.pm * BM + wr * 64 + fr, col0 = u.pn * BM + wc * 32 + 8 * fq;
#pragma unroll
        for (int ai = 0; ai < 2; ++ai)
#pragma unroll
            for (int m = 0; m < 4; ++m) { bf16_t* rowp = O + (size_t)(row0 + ai * HALF + m * 16) * ldc + col0;
#pragma unroll
                for (int bj = 0; bj < 2; ++bj) { const f32x4 v0 = acc[ai][bj][m][0], v1 = acc[ai][bj][m][1];
                    u32x4 w; w.x = cvt_pk_bf16(v0[0], v0[1]); w.y = cvt_pk_bf16(v0[2], v0[3]); w.z = cvt_pk_bf16(v1[0], v1[1]); w.w = cvt_pk_bf16(v1[2], v1[3]);
                    *(u32x4*)(rowp + bj * HALF) = w; } }
    }
};
struct EpiStoreI8 {
    static constexpr bool PERM = true, AFTER_DRAIN = false;
    bf16_t* O; int ldc; const float* SA; const float* SB;
    __device__ __forceinline__ void operator()(const f32x4 (&acc)[2][2][4][2], const Unit& u, int wr, int wc, int fr, int fq) const {
        const int row0 = u.pm * BM + wr * 64 + fr, col0 = u.pn * BM + wc * 32 + 8 * fq;
        f32x4 sb[2][2];
#pragma unroll
        for (int bj = 0; bj < 2; ++bj) { sb[bj][0] = *(const f32x4*)(SB + col0 + bj * HALF) * (1.f / 127.f); sb[bj][1] = *(const f32x4*)(SB + col0 + bj * HALF + 4) * (1.f / 127.f); }
#pragma unroll
        for (int ai = 0; ai < 2; ++ai)
#pragma unroll
            for (int m = 0; m < 4; ++m) { const int row = row0 + ai * HALF + m * 16; const float sa = SA[row]; bf16_t* rowp = O + (size_t)row * ldc + col0;
#pragma unroll
                for (int bj = 0; bj < 2; ++bj) { const i32x4 i0 = __builtin_bit_cast(i32x4, acc[ai][bj][m][0]), i1 = __builtin_bit_cast(i32x4, acc[ai][bj][m][1]);
                    const f32x4 v0 = (f32x4){(float)i0.x, (float)i0.y, (float)i0.z, (float)i0.w} * sb[bj][0] * sa, v1 = (f32x4){(float)i1.x, (float)i1.y, (float)i1.z, (float)i1.w} * sb[bj][1] * sa;
                    u32x4 w; w.x = cvt_pk_bf16(v0[0], v0[1]); w.y = cvt_pk_bf16(v0[2], v0[3]); w.z = cvt_pk_bf16(v1[0], v1[1]); w.w = cvt_pk_bf16(v1[2], v1[3]);
                    store16(rowp + bj * HALF, w, u.last); } }
    }
};
template <int PASS> struct EpiGate {
    static constexpr bool PERM = true, AFTER_DRAIN = false;
    const bf16_t* G; int ldg; bf16_t* O; int ldc;
    __device__ __forceinline__ void operator()(const f32x4 (&acc)[2][2][4][2], const Unit& u, int wr, int wc, int fr, int fq) const {
        const int row0 = u.pm * BM + wr * 64 + fr, col0 = u.pn * BM + wc * 32 + 8 * fq;
#pragma unroll
        for (int ai = 0; ai < 2; ++ai)
#pragma unroll
            for (int m = 0; m < 4; ++m) { const size_t row = (size_t)(row0 + ai * HALF + m * 16);
#pragma unroll
                for (int bj = 0; bj < 2; ++bj) { const f32x4 v0 = acc[ai][bj][m][0], v1 = acc[ai][bj][m][1];
                    const u32x4 g = *(const u32x4*)(G + row * ldg + col0 + bj * HALF);
                    float r[8];
                    r[0] = v0[0] * sigmoidf_fast(bf_lo(g.x)); r[1] = v0[1] * sigmoidf_fast(bf_hi(g.x)); r[2] = v0[2] * sigmoidf_fast(bf_lo(g.y)); r[3] = v0[3] * sigmoidf_fast(bf_hi(g.y));
                    r[4] = v1[0] * sigmoidf_fast(bf_lo(g.z)); r[5] = v1[1] * sigmoidf_fast(bf_hi(g.z)); r[6] = v1[2] * sigmoidf_fast(bf_lo(g.w)); r[7] = v1[3] * sigmoidf_fast(bf_hi(g.w));
                    bf16_t* op = O + row * ldc + col0 + bj * HALF;
                    if (PASS == 1) { const u32x4 p = *(const u32x4*)op;
                        r[0] += bf_lo(p.x); r[1] += bf_hi(p.x); r[2] += bf_lo(p.y); r[3] += bf_hi(p.y); r[4] += bf_lo(p.z); r[5] += bf_hi(p.z); r[6] += bf_lo(p.w); r[7] += bf_hi(p.w); }
                    u32x4 w; w.x = cvt_pk_bf16(r[0], r[1]); w.y = cvt_pk_bf16(r[2], r[3]); w.z = cvt_pk_bf16(r[4], r[5]); w.w = cvt_pk_bf16(r[6], r[7]);
                    *(u32x4*)op = w; }
                asm volatile("" ::: "memory"); }
    }
};
struct EpiGateChain {
    static constexpr bool PERM = true, AFTER_DRAIN = false;
    const bf16_t* GC; const bf16_t* GA; int ldg; bf16_t* O; int ldc;
    static __device__ __forceinline__ float en(float x) { return __builtin_amdgcn_exp2f(-1.4426950408889634f * fmaxf(x, -30.f)); }
    __device__ __forceinline__ void mid(f32x4 (&acc)[2][2][4][2], const Unit& u, int wr, int wc, int fr, int fq) const {
        const int row0 = u.pm * BM + wr * 64 + fr, col0 = u.pn * BM + wc * 32 + 8 * fq;
#pragma unroll
        for (int ai = 0; ai < 2; ++ai)
#pragma unroll
            for (int m = 0; m < 4; ++m) { const size_t row = (size_t)(row0 + ai * HALF + m * 16);
#pragma unroll
                for (int bj = 0; bj < 2; ++bj) {
                    const u32x4 c = *(const u32x4*)(GC + row * ldg + col0 + bj * HALF), a = *(const u32x4*)(GA + row * ldg + col0 + bj * HALF);
                    const unsigned cw[4] = {c.x, c.y, c.z, c.w}, aw[4] = {a.x, a.y, a.z, a.w};
#pragma unroll
                    for (int q = 0; q < 4; ++q) {
                        const float f0 = (1.f + en(bf_lo(aw[q]))) * __builtin_amdgcn_rcpf(1.f + en(bf_lo(cw[q]))), f1 = (1.f + en(bf_hi(aw[q]))) * __builtin_amdgcn_rcpf(1.f + en(bf_hi(cw[q])));
                        acc[ai][bj][m][q >> 1][2 * (q & 1)] *= f0; acc[ai][bj][m][q >> 1][2 * (q & 1) + 1] *= f1; } }
                asm volatile("" ::: "memory"); }
    }
    __device__ __forceinline__ void operator()(const f32x4 (&acc)[2][2][4][2], const Unit& u, int wr, int wc, int fr, int fq) const {
        const int row0 = u.pm * BM + wr * 64 + fr, col0 = u.pn * BM + wc * 32 + 8 * fq;
#pragma unroll
        for (int ai = 0; ai < 2; ++ai)
#pragma unroll
            for (int m = 0; m < 4; ++m) { const size_t row = (size_t)(row0 + ai * HALF + m * 16);
#pragma unroll
                for (int bj = 0; bj < 2; ++bj) { const f32x4 v0 = acc[ai][bj][m][0], v1 = acc[ai][bj][m][1];
                    const u32x4 g = *(const u32x4*)(GA + row * ldg + col0 + bj * HALF);
                    float r[8];
                    r[0] = v0[0] * __builtin_amdgcn_rcpf(1.f + en(bf_lo(g.x))); r[1] = v0[1] * __builtin_amdgcn_rcpf(1.f + en(bf_hi(g.x))); r[2] = v0[2] * __builtin_amdgcn_rcpf(1.f + en(bf_lo(g.y))); r[3] = v0[3] * __builtin_amdgcn_rcpf(1.f + en(bf_hi(g.y)));
                    r[4] = v1[0] * __builtin_amdgcn_rcpf(1.f + en(bf_lo(g.z))); r[5] = v1[1] * __builtin_amdgcn_rcpf(1.f + en(bf_hi(g.z))); r[6] = v1[2] * __builtin_amdgcn_rcpf(1.f + en(bf_lo(g.w))); r[7] = v1[3] * __builtin_amdgcn_rcpf(1.f + en(bf_hi(g.w)));
                    u32x4 w; w.x = cvt_pk_bf16(r[0], r[1]); w.y = cvt_pk_bf16(r[2], r[3]); w.z = cvt_pk_bf16(r[4], r[5]); w.w = cvt_pk_bf16(r[6], r[7]);
                    *(u32x4*)(O + row * ldc + col0 + bj * HALF) = w; }
                asm volatile("" ::: "memory"); }
    }
};
struct EpiX1 {
    static constexpr bool PERM = true, AFTER_DRAIN = false;
    const float* X; bf16_t* X1B; float* SSQ; int ldc;
    __device__ __forceinline__ void operator()(const f32x4 (&acc)[2][2][4][2], const Unit& u, int wr, int wc, int fr, int fq) const {
        const int row0 = u.pm * BM + wr * 64 + fr, col0 = u.pn * BM + wc * 32 + 8 * fq;
#pragma unroll
        for (int ai = 0; ai < 2; ++ai)
#pragma unroll
            for (int m = 0; m < 4; ++m) { const size_t row = (size_t)(row0 + ai * HALF + m * 16); float ss = 0.f;
#pragma unroll
                for (int bj = 0; bj < 2; ++bj) { const size_t off = row * ldc + col0 + bj * HALF;
                    const f32x4 x0 = *(const f32x4*)(X + off), x1 = *(const f32x4*)(X + off + 4);
                    const f32x4 v0 = acc[ai][bj][m][0] + x0, v1 = acc[ai][bj][m][1] + x1;
                    u32x4 w; w.x = cvt_pk_bf16(v0[0], v0[1]); w.y = cvt_pk_bf16(v0[2], v0[3]); w.z = cvt_pk_bf16(v1[0], v1[1]); w.w = cvt_pk_bf16(v1[2], v1[3]);
                    *(u32x4*)(X1B + off) = w;
                    ss += (v0[0] * v0[0] + v0[1] * v0[1]) + (v0[2] * v0[2] + v0[3] * v0[3]) + (v1[0] * v1[0] + v1[1] * v1[1]) + (v1[2] * v1[2] + v1[3] * v1[3]); }
                { const auto r16 = __builtin_amdgcn_permlane16_swap(__float_as_uint(ss), __float_as_uint(ss), false, false); ss = __uint_as_float(r16[0]) + __uint_as_float(r16[1]);
                  const auto r32 = __builtin_amdgcn_permlane32_swap(__float_as_uint(ss), __float_as_uint(ss), false, false); ss = __uint_as_float(r32[0]) + __uint_as_float(r32[1]); }
                if (fq == 0) atomicAdd(SSQ + row, ss);
                asm volatile("" ::: "memory"); }
    }
};
struct EpiQP {
    static constexpr bool PERM = true, AFTER_DRAIN = false;
    const float* SSQ; bf16_t* O; int ldc; float inv_n, eps;
    __device__ __forceinline__ void operator()(const f32x4 (&acc)[2][2][4][2], const Unit& u, int wr, int wc, int fr, int fq) const {
        const int row0 = u.pm * BM + wr * 64 + fr, col0 = u.pn * BM + wc * 32 + 8 * fq;
#pragma unroll
        for (int ai = 0; ai < 2; ++ai)
#pragma unroll
            for (int m = 0; m < 4; ++m) { const size_t row = (size_t)(row0 + ai * HALF + m * 16); const float inv = 1.0f / sqrtf(SSQ[row] * inv_n + eps);
                bf16_t* rowp = O + row * ldc + col0;
#pragma unroll
                for (int bj = 0; bj < 2; ++bj) { const f32x4 v0 = acc[ai][bj][m][0] * inv, v1 = acc[ai][bj][m][1] * inv;
                    u32x4 w; w.x = cvt_pk_bf16(v0[0], v0[1]); w.y = cvt_pk_bf16(v0[2], v0[3]); w.z = cvt_pk_bf16(v1[0], v1[1]); w.w = cvt_pk_bf16(v1[2], v1[3]);
                    *(u32x4*)(rowp + bj * HALF) = w; } }
    }
};


template <bool I8> __device__ __forceinline__ f32x4 mma16(bf16x8 a, bf16x8 b, f32x4 c) {
    if constexpr (I8) return __builtin_bit_cast(f32x4, __builtin_amdgcn_mfma_i32_16x16x64_i8(__builtin_bit_cast(i32x4, a), __builtin_bit_cast(i32x4, b), __builtin_bit_cast(i32x4, c), 0, 0, 0));
    else return __builtin_amdgcn_mfma_f32_16x16x32_bf16(a, b, c, 0, 0, 0);
}
template <class Epi, class Sched, bool ALIGN_EPI = false, bool SP2 = false, bool I8 = false, bool CHAIN = false>
__device__ __forceinline__ void gemm_phase(PG8_LAS unsigned char* lds, const Gemm g, const Sched& S, const Epi& E, int wid) {
    const int lane = hw_lane(), tid = wid * 64 + lane, wr = wid >> 2, wc = wid & 3, fr = lane & 15, fq = lane >> 4;
    const int K = I8 ? g.K / 2 : g.K, nt = K / BK;
    unsigned voffA[2], voffB[2];
#pragma unroll
    for (int i = 0; i < 2; ++i) { int R, C; stage_rc(tid * 16 + i * 8192, R, C); const int Rb = Epi::PERM ? ((R & ~31) + perm32(R & 31)) : R;
        voffA[i] = (unsigned)(R * K + C) * 2u; voffB[i] = (unsigned)(Rb * K + C) * 2u; }
    const size_t kstep = (size_t)(BK * 2);
    const size_t hstep = (size_t)HALF * K * 2;
    const size_t tstep = 2 * hstep;
    const unsigned ldsw = (unsigned)wid * 1024u;
    const int aoff = lds_byte(wr * 64 + fr, fq * 8), boff = lds_byte(wc * 32 + fr, fq * 8);
#define PG8_SA(b, h) (((b) * 2 + (h)) * HTB)
#define PG8_SB(b, h) ((4 + (b) * 2 + (h)) * HTB)
#define PG8_STAGE(bufoff, gbase, voff) do { _Pragma("unroll") for (int _i = 0; _i < 2; ++_i) \
        __builtin_amdgcn_global_load_lds((const unsigned*)((const char*)(gbase) + (voff)[_i]), (PG8_LAS unsigned*)(lds + (bufoff) + ldsw + _i * 8192), 16, 0, 0); } while (0)
#define PG8_LDA(dst, b, h) do { _Pragma("unroll") for (int m = 0; m < 4; ++m) _Pragma("unroll") for (int k = 0; k < 2; ++k) dst[m][k] = *(const PG8_LAS bf16x8*)(lds + PG8_SA(b, h) + aoff + m * 2048 + k * 1024); } while (0)
#define PG8_LDB(dst, b, h) do { _Pragma("unroll") for (int n = 0; n < 2; ++n) _Pragma("unroll") for (int k = 0; k < 2; ++k) dst[n][k] = *(const PG8_LAS bf16x8*)(lds + PG8_SB(b, h) + boff + n * 2048 + k * 1024); } while (0)
#define PG8_MMA(ai, bj, At, Bt) do { __builtin_amdgcn_s_setprio(1); _Pragma("unroll") for (int m = 0; m < 4; ++m) _Pragma("unroll") for (int n = 0; n < 2; ++n) _Pragma("unroll") for (int k = 0; k < 2; ++k) \
        acc[ai][bj][m][n] = mma16<I8>(Bt[n][k], At[m][k], acc[ai][bj][m][n]); __builtin_amdgcn_s_setprio(0); } while (0)
#define PG8_WAIT_V(n) asm volatile("s_waitcnt vmcnt(" #n ")" ::: "memory")
#define PG8_WAIT_L(n) asm volatile("s_waitcnt lgkmcnt(" #n ")" ::: "memory")
#define PG8_BAR __builtin_amdgcn_s_barrier()
#define PG8_SCHED __builtin_amdgcn_sched_barrier(0)
    Unit cur, nxt; int ui = 0;
#define PG8_UA(i) ((const char*)((CHAIN && ((i) & 1)) ? g.A2 : g.A))
#define PG8_UB(i) ((const char*)((CHAIN && ((i) & 1)) ? g.Bt2 : g.Bt))
#define PG8_UI(i) (CHAIN ? ((i) >> 1) : (i))
    if (!S.next(0, cur)) return;
    f32x4 acc[2][2][4][2];
#pragma unroll
    for (int a = 0; a < 2; ++a)
#pragma unroll
        for (int b = 0; b < 2; ++b)
#pragma unroll
            for (int m = 0; m < 4; ++m)
#pragma unroll
                for (int n = 0; n < 2; ++n) acc[a][b][m][n] = (f32x4){0.f, 0.f, 0.f, 0.f};
    bf16x8 At[4][2], B0[2][2], B1[2][2];
    const char* cA = (const char*)g.A + (size_t)cur.pm * tstep; const char* cB = (const char*)g.Bt + (size_t)cur.pn * tstep;
    S.a_ready(cur);
    if constexpr (SP2) {
        PG8_STAGE(PG8_SB(0, 0), cB, voffB); PG8_STAGE(PG8_SB(0, 1), cB + hstep, voffB); PG8_STAGE(PG8_SA(0, 0), cA, voffA); PG8_STAGE(PG8_SA(0, 1), cA + hstep, voffA);
        if (wr == 1) PG8_BAR;
        PG8_WAIT_V(2); PG8_BAR;
        PG8_STAGE(PG8_SB(1, 0), cB + kstep, voffB); PG8_STAGE(PG8_SA(1, 0), cA + kstep, voffA); PG8_STAGE(PG8_SB(1, 1), cB + hstep + kstep, voffB);
        PG8_WAIT_V(6); PG8_BAR;
    } else {
        PG8_STAGE(PG8_SB(0, 0), cB, voffB); PG8_STAGE(PG8_SA(0, 0), cA, voffA); PG8_STAGE(PG8_SB(0, 1), cB + hstep, voffB); PG8_STAGE(PG8_SA(0, 1), cA + hstep, voffA);
        if (wr == 1) PG8_BAR;
        PG8_WAIT_V(4); PG8_BAR;
        PG8_STAGE(PG8_SB(1, 0), cB + kstep, voffB); PG8_STAGE(PG8_SA(1, 0), cA + kstep, voffA); PG8_STAGE(PG8_SB(1, 1), cB + hstep + kstep, voffB);
        PG8_WAIT_V(6); PG8_BAR;
    }
    for (;;) {
        const bool has_next = S.next(PG8_UI(ui + 1), nxt);
        const char* nA = has_next ? PG8_UA(ui + 1) + (size_t)nxt.pm * tstep : cA; const char* nB = has_next ? PG8_UB(ui + 1) + (size_t)nxt.pn * tstep : cB;
        for (int t = 0; t < nt; t += 2) {
            const bool last = (t == nt - 2);
            const char* a1 = cA + (size_t)(t + 1) * kstep;
            const char* a2 = last ? nA : cA + (size_t)(t + 2) * kstep; const char* b2 = last ? nB : cB + (size_t)(t + 2) * kstep;
            const char* a3 = a2 + kstep; const char* b3 = b2 + kstep;
            if (last && has_next) S.a_ready(nxt);
            if constexpr (SP2) {
            PG8_LDB(B0, 0, 0); PG8_LDB(B1, 0, 1); PG8_SCHED; PG8_LDA(At, 0, 0); PG8_STAGE(PG8_SA(1, 1), a1 + hstep, voffA);
            PG8_WAIT_V(8); PG8_WAIT_L(0); PG8_BAR; PG8_MMA(0, 0, At, B0); PG8_MMA(0, 1, At, B1); PG8_BAR; PG8_SCHED;
            PG8_LDA(At, 0, 1); PG8_STAGE(PG8_SB(0, 0), b2, voffB); PG8_STAGE(PG8_SB(0, 1), b2 + hstep, voffB); PG8_STAGE(PG8_SA(0, 0), a2, voffA);
            PG8_WAIT_V(8); PG8_WAIT_L(0); PG8_BAR; PG8_MMA(1, 0, At, B0); PG8_MMA(1, 1, At, B1); PG8_BAR; PG8_SCHED;
            PG8_LDB(B0, 1, 0); PG8_LDB(B1, 1, 1); PG8_SCHED; PG8_LDA(At, 1, 0); PG8_STAGE(PG8_SA(0, 1), a2 + hstep, voffA);
            PG8_WAIT_V(8); PG8_WAIT_L(0); PG8_BAR; PG8_MMA(0, 0, At, B0); PG8_MMA(0, 1, At, B1); PG8_BAR; PG8_SCHED;
            PG8_LDA(At, 1, 1); PG8_STAGE(PG8_SB(1, 0), b3, voffB); PG8_STAGE(PG8_SB(1, 1), b3 + hstep, voffB); PG8_STAGE(PG8_SA(1, 0), a3, voffA);
            PG8_WAIT_V(8); PG8_WAIT_L(0); PG8_BAR; PG8_MMA(1, 0, At, B0); PG8_MMA(1, 1, At, B1); PG8_BAR; PG8_SCHED;
            } else {
            PG8_LDB(B0, 0, 0); PG8_SCHED; PG8_LDA(At, 0, 0); PG8_STAGE(PG8_SA(1, 1), a1 + hstep, voffA);
            PG8_WAIT_L(8); PG8_BAR; PG8_WAIT_L(0); PG8_MMA(0, 0, At, B0); PG8_BAR; PG8_SCHED;
            PG8_LDB(B1, 0, 1); PG8_STAGE(PG8_SB(0, 0), b2, voffB);
            PG8_BAR; PG8_WAIT_L(0); PG8_MMA(0, 1, At, B1); PG8_BAR;
            PG8_LDA(At, 0, 1); PG8_STAGE(PG8_SA(0, 0), a2, voffA);
            PG8_BAR; PG8_WAIT_L(0); PG8_MMA(1, 0, At, B0); PG8_BAR; PG8_SCHED;
            PG8_STAGE(PG8_SB(0, 1), b2 + hstep, voffB);
            PG8_WAIT_V(6); PG8_BAR; PG8_MMA(1, 1, At, B1); PG8_BAR;
            PG8_LDB(B0, 1, 0); PG8_SCHED; PG8_LDA(At, 1, 0); PG8_STAGE(PG8_SA(0, 1), a2 + hstep, voffA);
            PG8_WAIT_L(8); PG8_BAR; PG8_WAIT_L(0); PG8_MMA(0, 0, At, B0); PG8_BAR; PG8_SCHED;
            PG8_LDB(B1, 1, 1); PG8_STAGE(PG8_SB(1, 0), b3, voffB);
            PG8_BAR; PG8_WAIT_L(0); PG8_MMA(0, 1, At, B1); PG8_BAR;
            PG8_LDA(At, 1, 1); PG8_STAGE(PG8_SA(1, 0), a3, voffA);
            PG8_BAR; PG8_WAIT_L(0); PG8_MMA(1, 0, At, B0); PG8_BAR; PG8_SCHED;
            PG8_STAGE(PG8_SB(1, 1), b3 + hstep, voffB);
            PG8_WAIT_V(6); PG8_BAR; PG8_MMA(1, 1, At, B1); PG8_BAR;
            }
        }
        if constexpr (ALIGN_EPI) { if (wr == 0) PG8_BAR; }
        cur.last = has_next ? 0 : 1;
        bool fin = true;
        if constexpr (CHAIN) { if ((ui & 1) == 0) { E.mid(acc, cur, wr, wc, fr, fq); fin = false; } }
        if (fin) {
        if constexpr (!Epi::AFTER_DRAIN) { E(acc, cur, wr, wc, fr, fq); S.done(cur); }
        }
        if (!has_next) break;
        if (fin) {
#pragma unroll
        for (int a = 0; a < 2; ++a)
#pragma unroll
            for (int b = 0; b < 2; ++b)
#pragma unroll
                for (int m = 0; m < 4; ++m)
#pragma unroll
                    for (int n = 0; n < 2; ++n) acc[a][b][m][n] = (f32x4){0.f, 0.f, 0.f, 0.f};
        }
        cur = nxt; cA = nA; cB = nB; ++ui;
        if constexpr (ALIGN_EPI) { if (wr == 1) PG8_BAR; }
    }
    PG8_WAIT_V(0);
    if constexpr (!ALIGN_EPI) { if (wr == 0) PG8_BAR; }
    PG8_BAR;
    if constexpr (Epi::AFTER_DRAIN) { E.fused(acc, cur, wr, wc, fr, fq, lds, wid, lane); S.done(cur); }
#undef PG8_UA
#undef PG8_UB
#undef PG8_UI
#undef PG8_SA
#undef PG8_SB
#undef PG8_STAGE
#undef PG8_LDA
#undef PG8_LDB
#undef PG8_MMA
#undef PG8_WAIT_V
#undef PG8_WAIT_L
#undef PG8_BAR
#undef PG8_SCHED
}
}


constexpr int NWAVES = 8;
constexpr int T = 8192, D = 2048, CW = 1024, AW = 1024, NH = 16, HD = 64, INW = 10240;
constexpr int C_CB = 0, C_CC = 1024, C_CH = 2048, C_Q = 3072, C_K = 4096, C_V = 5120, C_GC = 6144, C_GA = 8192;
constexpr int NS = 16, DW = 128, NG = 16, EG = 1024;
__host__ __device__ constexpr int egroup(int e) { return ((e >> 7) ^ e) & 15; }
__host__ __device__ constexpr int erow(int e) { return ((e >> 7) << 3) | ((e >> 4) & 7); }
constexpr int PH = 8, PKEYS = 128, PHALF = 128, PQD = 256, PTOPK = 16, NEXP = 16384, NPAIR = PH * PTOPK;
constexpr float RMS_EPS = 1e-6f;

constexpr size_t MiB = 1u << 20;
constexpr size_t WS_CTL = 0, CTL_ZERO_BYTES = 32768;
constexpr size_t WS_WIN = 1 * MiB;
constexpr size_t WS_SA = 22 * MiB;
constexpr size_t WS_WCO = 41 * MiB;
constexpr size_t WS_WAO = 45 * MiB;
constexpr size_t WS_WO = 49 * MiB;
constexpr size_t WS_WQ = 57 * MiB;
constexpr size_t WS_SK = 65 * MiB;
constexpr size_t WS_XN = 66 * MiB;
constexpr size_t WS_YC = 98 * MiB;
constexpr size_t WS_YA = 114 * MiB;
constexpr size_t WS_UQ = 66 * MiB;
constexpr size_t WS_SU = 2 * MiB;
constexpr size_t WS_SV = 226 * MiB;
constexpr size_t WS_VQ = 194 * MiB;
constexpr size_t WS_PROJ = 258 * MiB;
constexpr size_t WS_X1B = WS_PROJ;
constexpr size_t WS_QP = WS_PROJ + 32 * MiB;
constexpr size_t WS_IDX = WS_PROJ + 64 * MiB;
constexpr size_t WS_GATE = WS_PROJ + 68 * MiB;
constexpr size_t WS_ACT = WS_PROJ + 72 * MiB;
constexpr size_t WS_E32 = WS_PROJ + 108 * MiB;
constexpr size_t WS_A8 = WS_PROJ + 78 * MiB;
constexpr size_t WS_TS = WS_PROJ + 79 * MiB;
constexpr size_t WS_ES = WS_PROJ + 80 * MiB;
constexpr size_t WS_GS = WS_PROJ + 82 * MiB;
constexpr size_t WS_OFFN = WS_PROJ + 86 * MiB;
constexpr size_t WS_SXS = WS_PROJ + 87 * MiB;
constexpr size_t WS_XQ = WS_PROJ + 88 * MiB;
constexpr size_t WS_PART = 98 * MiB;
constexpr size_t WS_ESG = WS_PROJ + 104 * MiB;
constexpr size_t WS_SSQP = WS_PROJ + 112 * MiB;
constexpr size_t WS_END = 418 * MiB;
constexpr int CW_BAR = 4096;
constexpr int CW_SSQ = 65536;
constexpr int CW_COLMAX = CW_SSQ + 16384;
constexpr int CW_SSQ2 = CW_SSQ + 8192;
static_assert((CW_COLMAX + INW) * 4 <= (int)MiB && (CW_BAR + 4096) * 4 <= (int)CTL_ZERO_BYTES, "ctl");

constexpr int RING_OFF = 0, RING_BYTES = 131072;
constexpr int LDSCTL_OFF = RING_BYTES, MISC_OFF = LDSCTL_OFF + 320;
constexpr int LDS_BYTES = 163840;
constexpr int LDS_SU_OFF = 132096;

#define GAS __attribute__((address_space(1)))
#define LAS __attribute__((address_space(3)))
typedef unsigned short bf16;
typedef unsigned v4u __attribute__((ext_vector_type(4)));
typedef float f32x4 __attribute__((ext_vector_type(4)));
typedef short bf16x8 __attribute__((ext_vector_type(8)));
typedef GAS unsigned gu32;
typedef GAS unsigned long long gu64;
#define RLX_AGENT __ATOMIC_RELAXED, __HIP_MEMORY_SCOPE_AGENT
#define LDS_WAIT() asm volatile("s_waitcnt lgkmcnt(0)" ::: "memory")
#define VM_WAIT() asm volatile("s_waitcnt vmcnt(0)" ::: "memory")
__device__ __forceinline__ unsigned long long rt() { return __builtin_amdgcn_s_memrealtime(); }
__device__ __forceinline__ unsigned f2bf(float f) { unsigned u = __builtin_bit_cast(unsigned, f); return (u + 0x7fffu + ((u >> 16) & 1u)) >> 16; }
__device__ __forceinline__ unsigned pk2(float lo, float hi) { unsigned r; asm("v_cvt_pk_bf16_f32 %0, %1, %2" : "=v"(r) : "v"(lo), "v"(hi)); return r; }

#define XB_TMO      128
#define XB_XCNT(j)  (256  + 64 * (j))
#define XB_XSUB(j)  (1280 + 64 * (j))
#define XB_XGEN(j)  (2304 + 64 * (j))
#define XB_TOP      3328
#define XB_TOPGEN   3392
#define XCD_BAR_WORDS 3456
#define XB_SPIN_CAP (1u << 18)

__device__ __forceinline__ unsigned xb_ld(unsigned* p)              { return __hip_atomic_load(p, __ATOMIC_RELAXED, __HIP_MEMORY_SCOPE_AGENT); }
__device__ __forceinline__ unsigned xb_add(unsigned* p, unsigned v) { return __hip_atomic_fetch_add(p, v, __ATOMIC_RELAXED, __HIP_MEMORY_SCOPE_AGENT); }
__device__ __forceinline__ unsigned xb_xcc_id() { return (unsigned)__builtin_amdgcn_s_getreg((3 << 11) | 20) & 0xFu; }
#define XB_SPIN(cond, bar) do { unsigned _sp = 0; while (cond) { __builtin_amdgcn_s_sleep(1); \
    if ((++_sp & 255u) == 0u) { if (xb_ld(&(bar)[XB_TMO])) break; if (_sp > XB_SPIN_CAP) { atomicAdd(&(bar)[XB_TMO], 1u); break; } } } } while (0)

struct XcdBarrier {
    unsigned* bar; unsigned x;
    volatile LAS unsigned* st;
};

__device__ __forceinline__ XcdBarrier xcd_barrier_post(unsigned* bar, volatile LAS unsigned* st, int wave) {
    XcdBarrier b; b.bar = bar; b.x = xb_xcc_id(); b.st = st;
    if (wave == 0 && hw_lane() == 0) (void)xb_add(&bar[XB_XCNT(b.x)], 1u);
    return b;
}
__device__ __forceinline__ void xcd_barrier_complete(unsigned* bar, unsigned x, unsigned& nloc, unsigned& nx) {
    const unsigned G = gridDim.x * gridDim.y * gridDim.z;
    unsigned sum, cnt, mine, sp = 0u;
    for (;;) {
        sum = 0u; cnt = 0u; mine = 0u;
#pragma unroll
        for (unsigned j = 0; j < 16; ++j) { const unsigned c = xb_ld(&bar[XB_XCNT(j)]); sum += c; cnt += (c > 0u) ? 1u : 0u; mine = (j == x) ? c : mine; }
        if (sum == G) break;
        __builtin_amdgcn_s_sleep(1);
        if ((++sp & 255u) == 0u) { if (xb_ld(&bar[XB_TMO])) break; if (sp > XB_SPIN_CAP) { atomicAdd(&bar[XB_TMO], 1u); break; } }
    }
    nloc = mine > 0u ? mine : 1u; nx = cnt > 0u ? cnt : 1u;
}

__device__ __forceinline__ void xcd_barrier_w(const XcdBarrier& b, int wave) {
    asm volatile("s_waitcnt vmcnt(0)" ::: "memory");
    __syncthreads();
    if (wave == 0 && hw_lane() == 0) {
        unsigned* bar = b.bar;
        __builtin_amdgcn_s_waitcnt(0);
        unsigned nloc = b.st[0], nx = b.st[1];
        if (nloc == 0u) { xcd_barrier_complete(bar, b.x, nloc, nx); b.st[0] = nloc; b.st[1] = nx; }
        const unsigned old = xb_add(&bar[XB_XSUB(b.x)], 1u);
        const unsigned gen = old / nloc;
        if (old + 1u == (gen + 1u) * nloc) {
            __builtin_amdgcn_fence(__ATOMIC_RELEASE, "agent");
            asm volatile("s_waitcnt vmcnt(0)" ::: "memory");
            const unsigned og = xb_add(&bar[XB_TOP], 1u);
            const unsigned tg = og / nx;
            if (og + 1u == (tg + 1u) * nx) xb_add(&bar[XB_TOPGEN], 1u);
            else XB_SPIN(xb_ld(&bar[XB_TOPGEN]) == tg, bar);
            __builtin_amdgcn_fence(__ATOMIC_ACQUIRE, "agent");
            xb_add(&bar[XB_XGEN(b.x)], 1u);
            asm volatile("s_waitcnt vmcnt(0)" ::: "memory");
        } else {
            XB_SPIN(xb_ld(&bar[XB_XGEN(b.x)]) == gen, bar);
            __builtin_amdgcn_fence(__ATOMIC_ACQUIRE, "agent");
            asm volatile("s_waitcnt vmcnt(0)" ::: "memory");
        }
    }
    __syncthreads();
}

__device__ __forceinline__ void xcd_arrive_w(const XcdBarrier& b, int wave) {
    asm volatile("s_waitcnt vmcnt(0)" ::: "memory");
    __syncthreads();
    if (wave == 0 && hw_lane() == 0) {
        unsigned* bar = b.bar;
        __builtin_amdgcn_s_waitcnt(0);
        unsigned nloc = b.st[0], nx = b.st[1];
        if (nloc == 0u) { xcd_barrier_complete(bar, b.x, nloc, nx); b.st[0] = nloc; b.st[1] = nx; }
        const unsigned old = xb_add(&bar[XB_XSUB(b.x)], 1u);
        const unsigned gen = old / nloc;
        b.st[2] = gen;
        if (old + 1u == (gen + 1u) * nloc) {
            __builtin_amdgcn_fence(__ATOMIC_RELEASE, "agent");
            asm volatile("s_waitcnt vmcnt(0)" ::: "memory");
            const unsigned og = xb_add(&bar[XB_TOP], 1u);
            const unsigned tg = og / nx;
            if (og + 1u == (tg + 1u) * nx) xb_add(&bar[XB_TOPGEN], 1u);
            b.st[3] = 1u; b.st[4] = tg;
        } else b.st[3] = 0u;
    }
}
__device__ __forceinline__ void xcd_wait_w(const XcdBarrier& b, int wave) {
    if (wave == 0 && hw_lane() == 0) {
        unsigned* bar = b.bar;
        if (b.st[3]) {
            const unsigned tg = b.st[4];
            XB_SPIN(xb_ld(&bar[XB_TOPGEN]) == tg, bar);
            __builtin_amdgcn_fence(__ATOMIC_ACQUIRE, "agent");
            xb_add(&bar[XB_XGEN(b.x)], 1u);
            asm volatile("s_waitcnt vmcnt(0)" ::: "memory");
        } else {
            const unsigned gen = b.st[2];
            XB_SPIN(xb_ld(&bar[XB_XGEN(b.x)]) == gen, bar);
            __builtin_amdgcn_fence(__ATOMIC_ACQUIRE, "agent");
            asm volatile("s_waitcnt vmcnt(0)" ::: "memory");
        }
    }
    __syncthreads();
}


#define PROBE_PHASE -1
#define PROBE_A 0
#define PROBE_B 1
#define STAMP(i) do { if (PROBE_PHASE >= 0 && blockIdx.x == 0 && wave == 0 && hw_lane() == 0) *(volatile LAS unsigned long long*)(lds + LDSCTL_OFF + 64 + 8 * (i)) = __builtin_amdgcn_s_memrealtime(); } while (0)
typedef float f32x16 __attribute__((ext_vector_type(16)));
typedef short s16x4 __attribute__((ext_vector_type(4)));
typedef unsigned u32x2 __attribute__((ext_vector_type(2)));
typedef float f32x2 __attribute__((ext_vector_type(2)));
template <int CTRL> __device__ __forceinline__ float dppf(float v) { return __int_as_float(__builtin_amdgcn_mov_dpp(__float_as_int(v), CTRL, 0xf, 0xf, false)); }
__device__ __forceinline__ float wave_sum(float v) {
    v += dppf<0xB1>(v); v += dppf<0x4E>(v); v += dppf<0x141>(v); v += dppf<0x140>(v);
    const float r0 = __int_as_float(__builtin_amdgcn_readlane(__float_as_int(v), 0)), r1 = __int_as_float(__builtin_amdgcn_readlane(__float_as_int(v), 16));
    const float r2 = __int_as_float(__builtin_amdgcn_readlane(__float_as_int(v), 32)), r3 = __int_as_float(__builtin_amdgcn_readlane(__float_as_int(v), 48));
    return (r0 + r1) + (r2 + r3);
}
__device__ __forceinline__ int partner32i(int v) { const auto r = __builtin_amdgcn_permlane32_swap((unsigned)v, (unsigned)v, false, false); return (int)((hw_lane() & 32) ? r[0] : r[1]); }
__device__ __forceinline__ float partner32(float v) { return __int_as_float(partner32i(__float_as_int(v))); }
__device__ __forceinline__ int crow(int r, int hi) { return (r & 3) + 8 * (r >> 2) + 4 * hi; }
__device__ __forceinline__ float bflo(unsigned w) { return __uint_as_float(w << 16); }
__device__ __forceinline__ float bfhi(unsigned w) { return __uint_as_float(w & 0xffff0000u); }
__device__ __forceinline__ unsigned cvtpk(float lo, float hi) { unsigned r; asm volatile("v_cvt_pk_bf16_f32 %0, %1, %2" : "=v"(r) : "v"(lo), "v"(hi)); return r; }

struct TrItem { const float* W; bf16* WT; const float* kscale; int K, N, k0, n0; };
__device__ __forceinline__ void tr_load(const TrItem& it, f32x4 (&v)[8], int lane) {
    const int rr = lane >> 3, ch = lane & 7;
#pragma unroll
    for (int i = 0; i < 8; ++i) v[i] = __builtin_nontemporal_load((const f32x4*)(it.W + (size_t)(it.k0 + rr + 8 * i) * it.N + it.n0 + 4 * ch));
}
__device__ __forceinline__ void tr_finish(const TrItem& it, f32x4 (&v)[8], LAS float* scr, int lane) {
    const int rr = lane >> 3, ch = lane & 7;
    if (it.kscale) {
#pragma unroll
        for (int i = 0; i < 8; ++i) v[i] = v[i] * it.kscale[it.k0 + rr + 8 * i];
    }
#pragma unroll
    for (int i = 0; i < 8; ++i) { LAS float* p = scr + (rr + 8 * i) * 33 + 4 * ch; p[0] = v[i].x; p[1] = v[i].y; p[2] = v[i].z; p[3] = v[i].w; }
    LDS_WAIT(); asm volatile("" ::: "memory");
    const int c = lane & 7;
#pragma unroll
    for (int j = 0; j < 4; ++j) { const int n = (lane >> 3) + 8 * j; const LAS float* s = scr + (8 * c) * 33 + n;
        v4u o; o.x = pk2(s[0 * 33], s[1 * 33]); o.y = pk2(s[2 * 33], s[3 * 33]); o.z = pk2(s[4 * 33], s[5 * 33]); o.w = pk2(s[6 * 33], s[7 * 33]);
        __builtin_nontemporal_store(o, (v4u*)(it.WT + (size_t)(it.n0 + n) * it.K + it.k0 + 8 * c)); }
    LDS_WAIT(); asm volatile("" ::: "memory");
}
__device__ __forceinline__ float wave_max(float v) {
    v = fmaxf(v, dppf<0xB1>(v)); v = fmaxf(v, dppf<0x4E>(v)); v = fmaxf(v, dppf<0x141>(v)); v = fmaxf(v, dppf<0x140>(v));
    const float r0 = __int_as_float(__builtin_amdgcn_readlane(__float_as_int(v), 0)), r1 = __int_as_float(__builtin_amdgcn_readlane(__float_as_int(v), 16));
    const float r2 = __int_as_float(__builtin_amdgcn_readlane(__float_as_int(v), 32)), r3 = __int_as_float(__builtin_amdgcn_readlane(__float_as_int(v), 48));
    return fmaxf(fmaxf(r0, r1), fmaxf(r2, r3));
}
__device__ __forceinline__ void rms_rows2_to_i8(const float* x0, const float* x1, const float* gain, unsigned char* o0, unsigned char* o1, float* sa0, float* sa1, int lane) {
    const f32x4* xa = (const f32x4*)x0 + lane; const f32x4* xb = (const f32x4*)x1 + lane; const f32x4* gr = (const f32x4*)gain + lane;
    f32x4 va[8], vb[8]; float sa = 0.f, sb = 0.f;
#pragma unroll
    for (int j = 0; j < 8; ++j) { va[j] = xa[64 * j]; vb[j] = xb[64 * j]; }
#pragma unroll
    for (int j = 0; j < 8; ++j) { sa += (va[j].x * va[j].x + va[j].y * va[j].y) + (va[j].z * va[j].z + va[j].w * va[j].w); sb += (vb[j].x * vb[j].x + vb[j].y * vb[j].y) + (vb[j].z * vb[j].z + vb[j].w * vb[j].w); }
    const float ia = 1.f / sqrtf(wave_sum(sa) * (1.f / D) + RMS_EPS), ib = 1.f / sqrtf(wave_sum(sb) * (1.f / D) + RMS_EPS);
    float ma = 0.f, mb = 0.f;
#pragma unroll
    for (int j = 0; j < 8; ++j) { const f32x4 g = gr[64 * j]; va[j] = va[j] * g * ia; vb[j] = vb[j] * g * ib;
        ma = fmaxf(ma, fmaxf(fmaxf(fabsf(va[j].x), fabsf(va[j].y)), fmaxf(fabsf(va[j].z), fabsf(va[j].w)))); mb = fmaxf(mb, fmaxf(fmaxf(fabsf(vb[j].x), fabsf(vb[j].y)), fmaxf(fabsf(vb[j].z), fabsf(vb[j].w)))); }
    ma = wave_max(ma); mb = wave_max(mb);
    const float qa = ma > 0.f ? 127.f / ma : 0.f, qb = mb > 0.f ? 127.f / mb : 0.f;
    unsigned* pa = (unsigned*)o0 + lane; unsigned* pb = (unsigned*)o1 + lane;
#pragma unroll
    for (int j = 0; j < 8; ++j) {
        pa[64 * j] = (unsigned)((int)rintf(va[j].x * qa) & 255) | ((unsigned)((int)rintf(va[j].y * qa) & 255) << 8) | ((unsigned)((int)rintf(va[j].z * qa) & 255) << 16) | ((unsigned)((int)rintf(va[j].w * qa) & 255) << 24);
        pb[64 * j] = (unsigned)((int)rintf(vb[j].x * qb) & 255) | ((unsigned)((int)rintf(vb[j].y * qb) & 255) << 8) | ((unsigned)((int)rintf(vb[j].z * qb) & 255) << 16) | ((unsigned)((int)rintf(vb[j].w * qb) & 255) << 24); }
    if (lane == 0) { *sa0 = ma * (1.f / 127.f); *sa1 = mb * (1.f / 127.f); }
}
__device__ __forceinline__ void tr_finish_i8(const TrItem& it, f32x4 (&v)[8], const float* colmax, LAS float* scr, int lane) {
    const int rr = lane >> 3, ch = lane & 7;
#pragma unroll
    for (int i = 0; i < 8; ++i) { LAS float* p = scr + (rr + 8 * i) * 33 + 4 * ch; p[0] = v[i].x; p[1] = v[i].y; p[2] = v[i].z; p[3] = v[i].w; }
    LDS_WAIT(); asm volatile("" ::: "memory");
    const int c = lane & 3;
#pragma unroll
    for (int j = 0; j < 2; ++j) { const int n = (lane >> 2) + 16 * j; const LAS float* s = scr + (16 * c) * 33 + n;
        const float cm = colmax[it.n0 + n]; const float q = cm > 0.f ? 127.f / cm : 0.f;
        unsigned w[4];
#pragma unroll
        for (int d = 0; d < 4; ++d) w[d] = (unsigned)((int)rintf(s[(4 * d) * 33] * q) & 255) | ((unsigned)((int)rintf(s[(4 * d + 1) * 33] * q) & 255) << 8) | ((unsigned)((int)rintf(s[(4 * d + 2) * 33] * q) & 255) << 16) | ((unsigned)((int)rintf(s[(4 * d + 3) * 33] * q) & 255) << 24);
        *(v4u*)((unsigned char*)it.WT + (size_t)(it.n0 + n) * it.K + it.k0 + 16 * c) = (v4u){w[0], w[1], w[2], w[3]}; }
    LDS_WAIT(); asm volatile("" ::: "memory");
}

struct Ptrs {
    const float *x, *norm_mix, *w_in, *conv_w, *w_conv_out, *w_attn_out, *w_out, *norm_ffn, *peer_wq, *peer_sk, *peer_u, *peer_v, *norm_final;
    float* out; unsigned char* ws;
};

__device__ __forceinline__ void u_row_load(f32x4 (&v)[8], const float* peer_u, int e, int lane) {
    const float* p0 = peer_u + (size_t)e * D + 4 * lane; const float* p1 = p0 + 1024;
    asm volatile("" : "+v"(p0), "+v"(p1));
#pragma unroll
    for (int j = 0; j < 4; ++j) { v[j] = __builtin_nontemporal_load((const f32x4*)(p0 + 256 * j)); v[4 + j] = __builtin_nontemporal_load((const f32x4*)(p1 + 256 * j)); }
}
__device__ __forceinline__ void u_row_store(f32x4 (&v)[8], const float* gr, unsigned char* UQ, float* SU, int e, int lane) {
#pragma unroll
    for (int j = 0; j < 8; ++j) { const f32x4 gg = *(const f32x4*)(gr + 256 * j); v[j] = v[j] * gg; }
    const int g = egroup(e), r = erow(e);
#pragma unroll
    for (int j = 0; j < 8; ++j) {
        float m = fmaxf(fmaxf(fabsf(v[j].x), fabsf(v[j].y)), fmaxf(fabsf(v[j].z), fabsf(v[j].w)));
        m = fmaxf(m, dppf<0xB1>(m)); m = fmaxf(m, dppf<0x4E>(m)); m = fmaxf(m, dppf<0x141>(m)); m = fmaxf(m, dppf<0x140>(m)); { const auto r16_ = __builtin_amdgcn_permlane16_swap(__float_as_uint(m), __float_as_uint(m), false, false); m = fmaxf(__uint_as_float(r16_[0]), __uint_as_float(r16_[1])); }
        const float inv = m > 0.f ? 127.f * __builtin_amdgcn_rcpf(m) : 0.f;
        const int q0 = (int)rintf(v[j].x * inv), q1 = (int)rintf(v[j].y * inv), q2 = (int)rintf(v[j].z * inv), q3 = (int)rintf(v[j].w * inv);
        const unsigned w = (unsigned)(q0 & 255) | ((unsigned)(q1 & 255) << 8) | ((unsigned)(q2 & 255) << 16) | ((unsigned)(q3 & 255) << 24);
        const int sl = 2 * j + (lane >> 5), role = g * NS + sl;
        *(unsigned*)(UQ + ((size_t)role * EG + r) * DW + 4 * (lane & 31)) = w;
        if ((lane & 31) == 0) SU[role * EG + r] = m * (1.f / 127.f);
    }
}
__device__ __forceinline__ void peer_tables_to_i8(const Ptrs& P, int first, int step, int end, int lane) {
    unsigned char* UQ = P.ws + WS_UQ; float* SU = (float*)(P.ws + WS_SU);
    const float* gr = P.norm_ffn + 4 * lane;
    f32x4 va[8], vb[8];
    int e = first;
    if (e < end) u_row_load(va, P.peer_u, e, lane);
#pragma unroll 1
    for (; e < end; e += 2 * step) {
        const bool hb = e + step < end; if (hb) u_row_load(vb, P.peer_u, e + step, lane);
        u_row_store(va, gr, UQ, SU, e, lane);
        if (e + 2 * step < end) u_row_load(va, P.peer_u, e + 2 * step, lane);
        if (hb) u_row_store(vb, gr, UQ, SU, e + step, lane);
    }
}

__device__ __forceinline__ void xn_row_i8(f32x4 (&v)[8], const float* gain, unsigned char* XN, float* SA, int row, int lane) {
    const f32x4* gr = (const f32x4*)gain + lane;
    float ss = 0.f;
#pragma unroll
    for (int j = 0; j < 8; ++j) ss += (v[j].x * v[j].x + v[j].y * v[j].y) + (v[j].z * v[j].z + v[j].w * v[j].w);
    const float inv = 1.f / sqrtf(wave_sum(ss) * (1.f / D) + RMS_EPS);
    float mx = 0.f;
#pragma unroll
    for (int j = 0; j < 8; ++j) { const f32x4 g = gr[64 * j]; v[j] = v[j] * g * inv; mx = fmaxf(mx, fmaxf(fmaxf(fabsf(v[j].x), fabsf(v[j].y)), fmaxf(fabsf(v[j].z), fabsf(v[j].w)))); }
    mx = wave_max(mx);
    const float q = mx > 0.f ? 127.f / mx : 0.f;
    unsigned* po = (unsigned*)(XN + (size_t)row * D) + lane;
#pragma unroll
    for (int j = 0; j < 8; ++j)
        po[64 * j] = (unsigned)((int)rintf(v[j].x * q) & 255) | ((unsigned)((int)rintf(v[j].y * q) & 255) << 8) | ((unsigned)((int)rintf(v[j].z * q) & 255) << 16) | ((unsigned)((int)rintf(v[j].w * q) & 255) << 24);
    if (lane == 0) SA[row] = mx * (1.f / 127.f);
}
__device__ __forceinline__ void vq_row_to_tile(const f32x4 (&v)[8], LAS unsigned char* tile, float* SV, int e0, int er, int lane) {
    float m = 0.f;
#pragma unroll
    for (int j = 0; j < 8; ++j) m = fmaxf(m, fmaxf(fmaxf(fabsf(v[j].x), fabsf(v[j].y)), fmaxf(fabsf(v[j].z), fabsf(v[j].w))));
    m = wave_max(m);
    const float inv = m > 0.f ? 127.f / m : 0.f;
    if (lane == 0) SV[e0 + er] = m * (1.f / 127.f);
#pragma unroll
    for (int j = 0; j < 8; ++j) {
        const f32x4 x = v[j];
        const int w = (int)((unsigned)((int)rintf(x.x * inv) & 255) | ((unsigned)((int)rintf(x.y * inv) & 255) << 8) | ((unsigned)((int)rintf(x.z * inv) & 255) << 16) | ((unsigned)((int)rintf(x.w * inv) & 255) << 24));
        const int c = (lane >> 1) + 32 * j;
        *(LAS int*)(tile + (c * 33 + er) * 8 + 4 * (lane & 1)) = w;
    }
}
__device__ __forceinline__ void rows2_load(f32x4 (&v)[2][8], const float* base, int lane) {
#pragma unroll
    for (int i = 0; i < 2; ++i) { const float* p0 = base + (size_t)i * D + 4 * lane; const float* p1 = p0 + 1024;
        asm volatile("" : "+v"(p0), "+v"(p1));
#pragma unroll
        for (int j = 0; j < 4; ++j) { v[i][j] = __builtin_nontemporal_load((const f32x4*)(p0 + 256 * j)); v[i][4 + j] = __builtin_nontemporal_load((const f32x4*)(p1 + 256 * j)); } }
}
__device__ __forceinline__ void p0_all(const Ptrs& P, LAS unsigned char* lds, int vcu, int G, int wave, int lane, int tid) {
    const int gw = vcu * NWAVES + wave, NGW = G * NWAVES;
    LAS unsigned* cmx = (LAS unsigned*)(lds + 83200);
    LAS float* scr = (LAS float*)(lds + (wave < 5 ? 84480 + 8448 * wave : LDS_SU_OFF + 8448 * (wave - 5)));
    static_assert(84480 + 5 * 8448 <= LDSCTL_OFF && LDS_SU_OFF + 3 * 8448 <= LDS_BYTES, "p0 lds");
    bf16* WCO = (bf16*)(P.ws + WS_WCO); bf16* WAO = (bf16*)(P.ws + WS_WAO); bf16* WO = (bf16*)(P.ws + WS_WO); bf16* WQ = (bf16*)(P.ws + WS_WQ);
    constexpr int I_CO = (CW / 64) * (D / 32), I_AO = (AW / 64) * (D / 32), I_O = (D / 64) * (D / 32), I_Q = I_O;
    constexpr int NITEMS = I_CO + I_AO + I_O + I_Q;
    const float *p_wco = P.w_conv_out, *p_wao = P.w_attn_out, *p_wo = P.w_out, *p_wq = P.peer_wq, *p_nf = P.norm_ffn, *p_v = P.peer_v, *p_x = P.x;
    asm volatile("" : "+s"(p_wco), "+s"(p_wao), "+s"(p_wo), "+s"(p_wq), "+s"(p_nf), "+s"(p_v), "+s"(p_x));
    auto mk = [&](int it) {
        TrItem t; int r = it, K, N;
        if (r < I_CO) { t.W = p_wco; t.WT = WCO; t.kscale = nullptr; K = CW; N = D; }
        else if ((r -= I_CO) < I_AO) { t.W = p_wao; t.WT = WAO; t.kscale = nullptr; K = AW; N = D; }
        else if ((r -= I_AO) < I_O) { t.W = p_wo; t.WT = WO; t.kscale = nullptr; K = D; N = D; }
        else { r -= I_O; t.W = p_wq; t.WT = WQ; t.kscale = p_nf; K = D; N = D; }
        const int nblk = N / 32; t.K = K; t.N = N; t.k0 = 64 * (r / nblk); t.n0 = 32 * (r % nblk); return t; };
    f32x4 va[8], vb[8];
    if (gw < NITEMS) { const TrItem a = mk(gw); tr_load(a, va, lane); }
    if (gw + NGW < NITEMS) { const TrItem b = mk(gw + NGW); tr_load(b, vb, lane); }
    f32x4 A[2][8], B[2][8];
    auto next_rows = [&](int nb) -> const float* {
        if (nb < NEXP / 32) return p_v + (size_t)(nb * 32 + wave * 4) * D;
        const int m4 = gw < T / 4 ? gw : T / 4 - 1;
        return p_x + (size_t)(4 * m4) * D; };
    bool vpre = false;
#pragma unroll 1
    for (int it = gw; it < NITEMS; it += 2 * NGW) {
        const bool lastt = it + 2 * NGW >= NITEMS;
        if (lastt) { int b0 = vcu; asm volatile("" : "+s"(b0)); const float* nb = next_rows(b0); rows2_load(A, nb, lane); rows2_load(B, nb + 2 * D, lane); vpre = true; asm volatile("" ::: "memory"); }
        { const TrItem a = mk(it); tr_finish(a, va, scr, lane); }
        if (!lastt) { const TrItem c = mk(it + 2 * NGW); tr_load(c, va, lane); }
        if (it + NGW < NITEMS) { const TrItem b = mk(it + NGW); tr_finish(b, vb, scr, lane); if (it + 3 * NGW < NITEMS) { const TrItem d = mk(it + 3 * NGW); tr_load(d, vb, lane); } }
    }
    if (!vpre) { const float* nb = next_rows(vcu); rows2_load(A, nb, lane); rows2_load(B, nb + 2 * D, lane); }
    {
        LAS unsigned char* tile = lds + RING_OFF;
        unsigned char* VQ = P.ws + WS_VQ; float* SV = (float*)(P.ws + WS_SV);
        __syncthreads();
#pragma unroll 1
        for (int b = vcu; b < NEXP / 32; b += G) {
            const int e0 = b * 32;
            const float* nb = next_rows(b + G);
            vq_row_to_tile(A[0], tile, SV, e0, wave * 4 + 0, lane); vq_row_to_tile(A[1], tile, SV, e0, wave * 4 + 1, lane);
            asm volatile("" ::: "memory"); rows2_load(A, nb, lane); asm volatile("" ::: "memory");
            vq_row_to_tile(B[0], tile, SV, e0, wave * 4 + 2, lane); vq_row_to_tile(B[1], tile, SV, e0, wave * 4 + 3, lane);
            asm volatile("" ::: "memory"); rows2_load(B, nb + 2 * D, lane); asm volatile("" ::: "memory");
            __syncthreads();
#pragma unroll 4
            for (int k = 0; k < 16; ++k) {
                const int c = wave * 32 + 2 * k + (lane >> 5), er = lane & 31;
                const u32x2 q = *(const LAS u32x2*)(tile + (c * 33 + er) * 8);
                __builtin_nontemporal_store(q, (u32x2*)(VQ + ((size_t)c * NEXP + e0 + er) * 8));
            }
            __syncthreads();
        }
    }
    {
        unsigned char* XN = P.ws + WS_XN; float* SA = (float*)(P.ws + WS_SA);
        bool first = true;
#pragma unroll 1
        for (int m4 = gw; m4 < T / 4; m4 += NGW) {
            if (!first) { const float* nb = P.x + (size_t)(4 * m4) * D; rows2_load(A, nb, lane); rows2_load(B, nb + 2 * D, lane); }
            first = false;
            xn_row_i8(A[0], P.norm_mix, XN, SA, 4 * m4 + 0, lane); xn_row_i8(A[1], P.norm_mix, XN, SA, 4 * m4 + 1, lane);
            xn_row_i8(B[0], P.norm_mix, XN, SA, 4 * m4 + 2, lane); xn_row_i8(B[1], P.norm_mix, XN, SA, 4 * m4 + 3, lane);
        }
    }
    {
        constexpr int NC = 40, NITEM = INW / NC;
        LAS unsigned char* tl = lds + RING_OFF + wave * (NC * 260);
        const int rsub = lane / 10, ch = lane - 10 * rsub;
        unsigned char* WQ8 = P.ws + WS_WIN; float* CM = (float*)((unsigned*)(P.ws + WS_CTL) + CW_COLMAX);
#pragma unroll 1
        for (int item = vcu; item < NITEM; item += G) {
            const int n0 = item * NC;
            __syncthreads();
            if (tid < NC) cmx[tid] = 0u;
            __syncthreads();
            f32x4 v[43];
            const float* src = P.w_in + (size_t)(256 * wave + rsub) * INW + n0 + 4 * ch;
#pragma unroll
            for (int i = 0; i < 43; ++i) { const bool ok = (rsub < 6) && (6 * i + rsub < 256); v[i] = ok ? __builtin_nontemporal_load((const f32x4*)(src + (size_t)(6 * i) * INW)) : (f32x4){0.f, 0.f, 0.f, 0.f}; }
            f32x4 m = (f32x4){0.f, 0.f, 0.f, 0.f};
#pragma unroll
            for (int i = 0; i < 43; ++i) { m.x = fmaxf(m.x, fabsf(v[i].x)); m.y = fmaxf(m.y, fabsf(v[i].y)); m.z = fmaxf(m.z, fabsf(v[i].z)); m.w = fmaxf(m.w, fabsf(v[i].w)); }
            if (rsub < 6) { __hip_atomic_fetch_max(cmx + 4 * ch, __float_as_uint(m.x), __ATOMIC_RELAXED, __HIP_MEMORY_SCOPE_WORKGROUP); __hip_atomic_fetch_max(cmx + 4 * ch + 1, __float_as_uint(m.y), __ATOMIC_RELAXED, __HIP_MEMORY_SCOPE_WORKGROUP);
                            __hip_atomic_fetch_max(cmx + 4 * ch + 2, __float_as_uint(m.z), __ATOMIC_RELAXED, __HIP_MEMORY_SCOPE_WORKGROUP); __hip_atomic_fetch_max(cmx + 4 * ch + 3, __float_as_uint(m.w), __ATOMIC_RELAXED, __HIP_MEMORY_SCOPE_WORKGROUP); }
            __syncthreads();
            const int chc = ch < 10 ? ch : 0;
            const float c0 = __uint_as_float(cmx[4 * chc]), c1 = __uint_as_float(cmx[4 * chc + 1]), c2 = __uint_as_float(cmx[4 * chc + 2]), c3 = __uint_as_float(cmx[4 * chc + 3]);
            const float q0 = c0 > 0.f ? 127.f / c0 : 0.f, q1 = c1 > 0.f ? 127.f / c1 : 0.f, q2 = c2 > 0.f ? 127.f / c2 : 0.f, q3 = c3 > 0.f ? 127.f / c3 : 0.f;
            if (tid < NC) CM[n0 + tid] = __uint_as_float(cmx[tid]);
            if (rsub < 6) {
#pragma unroll
                for (int i = 0; i < 43; ++i) { const int r = 6 * i + rsub; if (r < 256) { LAS unsigned char* p = tl + (4 * ch) * 260 + r;
                    p[0] = (unsigned char)((int)rintf(v[i].x * q0) & 255); p[260] = (unsigned char)((int)rintf(v[i].y * q1) & 255); p[520] = (unsigned char)((int)rintf(v[i].z * q2) & 255); p[780] = (unsigned char)((int)rintf(v[i].w * q3) & 255); } }
            }
            LDS_WAIT(); asm volatile("" ::: "memory");
#pragma unroll 8
            for (int n = 0; n < NC; ++n) *(unsigned*)(WQ8 + (size_t)(n0 + n) * D + 256 * wave + 4 * lane) = *(const LAS unsigned*)(tl + n * 260 + 4 * lane);
        }
    }
    {
        const int gt = gw * 64 + lane, NGT = NGW * 64;
        bf16* SK = (bf16*)(P.ws + WS_SK);
        float* SSQ0 = (float*)((unsigned*)(P.ws + WS_CTL) + CW_SSQ);
        for (int it = gt; it < T; it += NGT) SSQ0[it] = 0.f;
        for (int it = gt; it < 2 * PKEYS * PHALF; it += NGT) SK[it] = (bf16)f2bf(P.peer_sk[it]);
    }
}

__device__ __forceinline__ void p2_conv(const Ptrs& P, int gt, int NGT) {
    const bf16* PROJ = (const bf16*)(P.ws + WS_PROJ); bf16* YC = (bf16*)(P.ws + WS_YC);
    constexpr int NIT = (T / 8) * (CW / 8);
    for (int it = gt; it < NIT; it += NGT) {
        const int ch = it % (CW / 8), tb = it / (CW / 8), c0 = ch * 8, t0 = tb * 8;
        float w0[8], w1[8], w2[8];
#pragma unroll
        for (int i = 0; i < 8; ++i) { w0[i] = P.conv_w[c0 + i]; w1[i] = P.conv_w[CW + c0 + i]; w2[i] = P.conv_w[2 * CW + c0 + i]; }
        float zm2[8], zm1[8];
#pragma unroll
        for (int i = 0; i < 8; ++i) { zm2[i] = 0.f; zm1[i] = 0.f; }
#pragma unroll
        for (int dt = -2; dt < 8; ++dt) {
            const int t = t0 + dt; if (t < 0) continue;
            const v4u cc = *(const v4u*)(PROJ + (size_t)t * INW + C_CC + c0), hh = *(const v4u*)(PROJ + (size_t)t * INW + C_CH + c0);
            float z[8];
            z[0] = bflo(cc.x) * bflo(hh.x); z[1] = bfhi(cc.x) * bfhi(hh.x); z[2] = bflo(cc.y) * bflo(hh.y); z[3] = bfhi(cc.y) * bfhi(hh.y);
            z[4] = bflo(cc.z) * bflo(hh.z); z[5] = bfhi(cc.z) * bfhi(hh.z); z[6] = bflo(cc.w) * bflo(hh.w); z[7] = bfhi(cc.w) * bfhi(hh.w);
            if (dt >= 0) {
                const v4u cb = *(const v4u*)(PROJ + (size_t)t * INW + C_CB + c0);
                float b[8] = {bflo(cb.x), bfhi(cb.x), bflo(cb.y), bfhi(cb.y), bflo(cb.z), bfhi(cb.z), bflo(cb.w), bfhi(cb.w)};
                float y[8];
#pragma unroll
                for (int i = 0; i < 8; ++i) y[i] = b[i] * (w0[i] * zm2[i] + w1[i] * zm1[i] + w2[i] * z[i]);
                v4u o; o.x = pk2(y[0], y[1]); o.y = pk2(y[2], y[3]); o.z = pk2(y[4], y[5]); o.w = pk2(y[6], y[7]);
                *(v4u*)(YC + (size_t)t * CW + c0) = o;
            }
#pragma unroll
            for (int i = 0; i < 8; ++i) { zm2[i] = zm1[i]; zm1[i] = z[i]; }
        }
    }
}

__device__ __forceinline__ s16x4 vtr(LAS const unsigned char* p) { typedef short v4i16_t __attribute__((ext_vector_type(4))); return __builtin_bit_cast(s16x4, __builtin_amdgcn_ds_read_tr16_b64_v4i16((LAS v4i16_t*)p)); }

__device__ __forceinline__ void attn_task(const bf16* PROJ, bf16* YA, LAS unsigned char* vl  , int qt, int h, int lane) {
    const int r32 = lane & 31, hi = lane >> 5, q0 = qt * 32;
    const bf16* Qp = PROJ + (size_t)(q0 + r32) * INW + C_Q + h * HD + 8 * hi;
    bf16x8 qf[4];
#pragma unroll
    for (int s = 0; s < 4; ++s) qf[s] = *(const bf16x8*)(Qp + 16 * s);
    float carry = 1.f;
    f32x16 o0, o1;
#pragma unroll
    for (int r = 0; r < 16; ++r) { o0[r] = 0.f; o1[r] = 0.f; }
    const int g1 = (lane >> 4) & 1, qq = (lane & 15) >> 2, pp = lane & 3;
    LAS const unsigned char* vrd = vl + (4 * hi + qq) * 128 + g1 * 32 + pp * 8;
#define A_LOAD(KT, KF, VV) do { const int k0_ = (KT) * 32; const bf16* Kp_ = PROJ + (size_t)(k0_ + r32) * INW + C_K + h * HD + 8 * hi; \
        _Pragma("unroll") for (int s = 0; s < 4; ++s) KF[s] = *(const bf16x8*)(Kp_ + 16 * s); \
        _Pragma("unroll") for (int i = 0; i < 4; ++i) { const int c_ = lane + 64 * i; VV[i] = *(const v4u*)(PROJ + (size_t)(k0_ + (c_ >> 3)) * INW + C_V + h * HD + (c_ & 7) * 8); } } while (0)
    bf16x8 kfn[4]; v4u vvn[4];
    A_LOAD(qt, kfn, vvn);
    for (int kt = qt; kt >= 0; --kt) {
        bf16x8 kf[4]; v4u vv[4];
#pragma unroll
        for (int s = 0; s < 4; ++s) { kf[s] = kfn[s]; vv[s] = vvn[s]; }
        if (kt > 0) A_LOAD(kt - 1, kfn, vvn);
        f32x16 S;
#pragma unroll
        for (int r = 0; r < 16; ++r) S[r] = 0.f;
#pragma unroll
        for (int s = 0; s < 4; ++s) S = __builtin_amdgcn_mfma_f32_32x32x16_bf16(kf[s], qf[s], S, 0, 0, 0);
#pragma unroll
        for (int i = 0; i < 4; ++i) { const int c = lane + 64 * i, row = c >> 3, chn = c & 7; *(LAS v4u*)(vl + row * 128 + chn * 16) = vv[i]; }
        float kp[16], bt[16];
        const float cs = 0.125f * 1.4426950408889634f;
#pragma unroll
        for (int r = 0; r < 16; ++r) { const float a = fminf(S[r] * cs, 126.f); const float e = __builtin_amdgcn_exp2f(a); const float ri = __builtin_amdgcn_rcpf(1.f + e); kp[r] = ri; bt[r] = e * ri; }
        if (kt == qt) {
#pragma unroll
            for (int r = 0; r < 16; ++r) { if (crow(r, hi) >= r32) { kp[r] = 1.f; bt[r] = 0.f; } }
        }
        float Pm[4], Qm[4], Tt[4];
#pragma unroll
        for (int i = 0; i < 4; ++i) { Pm[i] = (kp[4 * i] * kp[4 * i + 1]) * (kp[4 * i + 2] * kp[4 * i + 3]); Qm[i] = partner32(Pm[i]); Tt[i] = Pm[i] * Qm[i]; }
        float R[4]; R[3] = 1.f; R[2] = Tt[3]; R[1] = Tt[3] * Tt[2]; R[0] = R[1] * Tt[1];
        const float total = R[0] * Tt[0];
        float w[16];
#pragma unroll
        for (int i = 0; i < 4; ++i) {
            const float base = carry * R[i] * (hi ? 1.f : Qm[i]);
            const float x3 = base, x2 = x3 * kp[4 * i + 3], x1 = x2 * kp[4 * i + 2], x0 = x1 * kp[4 * i + 1];
            w[4 * i + 3] = bt[4 * i + 3] * x3; w[4 * i + 2] = bt[4 * i + 2] * x2; w[4 * i + 1] = bt[4 * i + 1] * x1; w[4 * i] = bt[4 * i] * x0;
        }
        carry *= total;
        v4u wa0, wa1;
        wa0.x = cvtpk(w[0], w[1]); wa0.y = cvtpk(w[2], w[3]); wa0.z = cvtpk(w[4], w[5]); wa0.w = cvtpk(w[6], w[7]);
        wa1.x = cvtpk(w[8], w[9]); wa1.y = cvtpk(w[10], w[11]); wa1.z = cvtpk(w[12], w[13]); wa1.w = cvtpk(w[14], w[15]);
        asm volatile("s_waitcnt lgkmcnt(0)" ::: "memory");
        s16x4 l00 = vtr(vrd + 0 * 64 + 0 * 2048), h00 = vtr(vrd + 0 * 64 + 0 * 2048 + 1024);
        s16x4 l01 = vtr(vrd + 0 * 64 + 1 * 2048), h01 = vtr(vrd + 0 * 64 + 1 * 2048 + 1024);
        s16x4 l10 = vtr(vrd + 1 * 64 + 0 * 2048), h10 = vtr(vrd + 1 * 64 + 0 * 2048 + 1024);
        s16x4 l11 = vtr(vrd + 1 * 64 + 1 * 2048), h11 = vtr(vrd + 1 * 64 + 1 * 2048 + 1024);
        asm volatile("s_waitcnt lgkmcnt(0)" ::: "memory");
#define PKV(l, hh) (bf16x8){l[0], l[1], l[2], l[3], hh[0], hh[1], hh[2], hh[3]}
        o0 = __builtin_amdgcn_mfma_f32_32x32x16_bf16(__builtin_bit_cast(bf16x8, wa0), PKV(l00, h00), o0, 0, 0, 0);
        o0 = __builtin_amdgcn_mfma_f32_32x32x16_bf16(__builtin_bit_cast(bf16x8, wa1), PKV(l01, h01), o0, 0, 0, 0);
        o1 = __builtin_amdgcn_mfma_f32_32x32x16_bf16(__builtin_bit_cast(bf16x8, wa0), PKV(l10, h10), o1, 0, 0, 0);
        o1 = __builtin_amdgcn_mfma_f32_32x32x16_bf16(__builtin_bit_cast(bf16x8, wa1), PKV(l11, h11), o1, 0, 0, 0);
#undef PKV
        if (__all(carry < 1e-30f)) break;
    }
    bf16* Op = YA + (size_t)q0 * AW + h * HD + r32;
#pragma unroll
    for (int r = 0; r < 16; ++r) { const int qr = crow(r, hi); Op[(size_t)qr * AW] = (bf16)f2bf(o0[r]); Op[(size_t)qr * AW + 32] = (bf16)f2bf(o1[r]); }
}

template <int N> __device__ __forceinline__ float tree_max(const float (&v)[N]) {
    float t[N];
#pragma unroll
    for (int i = 0; i < N; ++i) t[i] = v[i];
#pragma unroll
    for (int w = N; w > 1; w = (w + 2) / 3) {
#pragma unroll
        for (int i = 0; i < (w + 2) / 3; ++i) { const float a = t[3 * i], b = (3 * i + 1 < w) ? t[3 * i + 1] : a, c = (3 * i + 2 < w) ? t[3 * i + 2] : a; t[i] = fmaxf(fmaxf(a, b), c); }
    }
    return t[0];
}
template <int N> __device__ __forceinline__ float take_max(float (&v)[N]) {
    const float m = tree_max<N>(v);
    const float g = fmaxf(m, partner32(m));
#pragma unroll
    for (int i = 0; i < N; ++i) v[i] = (v[i] == g) ? -INFINITY : v[i];
    return g;
}
#define CEX(a, b) do { const float hi_ = fmaxf(a, b), lo_ = fminf(a, b); a = hi_; b = lo_; } while (0)
template <int O, int N> __device__ __forceinline__ void sort16_desc_at(float (&v)[N]) {
#pragma unroll
    for (int k = 2; k <= 16; k <<= 1)
#pragma unroll
        for (int j = k >> 1; j > 0; j >>= 1)
#pragma unroll
            for (int i = 0; i < 16; ++i) { const int l = i ^ j; if (l > i) { if ((i & k) == 0) CEX(v[O + i], v[O + l]); else CEX(v[O + l], v[O + i]); } }
}
template <int A, int B, int N> __device__ __forceinline__ void merge_top16_at(float (&v)[N]) {
#pragma unroll
    for (int i = 0; i < 16; ++i) v[A + i] = fmaxf(v[A + i], v[B + 15 - i]);
#pragma unroll
    for (int j = 8; j > 0; j >>= 1)
#pragma unroll
        for (int i = 0; i < 16; ++i) { const int l = i ^ j; if (l > i) CEX(v[A + i], v[A + l]); }
}
__device__ __forceinline__ void sort16_desc(float (&v)[16]) { sort16_desc_at<0, 16>(v); }
__device__ __forceinline__ void merge_top16(float (&a)[16], const float (&b)[16]) {
#pragma unroll
    for (int i = 0; i < 16; ++i) a[i] = fmaxf(a[i], b[15 - i]);
#pragma unroll
    for (int j = 8; j > 0; j >>= 1)
#pragma unroll
        for (int i = 0; i < 16; ++i) { const int l = i ^ j; if (l > i) CEX(a[i], a[l]); }
}
__device__ __forceinline__ void top16_of_pair(float (&sc)[64], float (&out)[16]) {
    sort16_desc_at<0, 64>(sc); sort16_desc_at<16, 64>(sc); merge_top16_at<0, 16, 64>(sc);
    sort16_desc_at<32, 64>(sc); sort16_desc_at<48, 64>(sc); merge_top16_at<32, 48, 64>(sc);
    merge_top16_at<0, 32, 64>(sc);
#pragma unroll
    for (int i = 0; i < 16; ++i) out[i] = sc[i];
    float p[16];
#pragma unroll
    for (int i = 0; i < 16; ++i) p[i] = partner32(out[i]);
    merge_top16(out, p);
}
struct constexpr_ij { int i, j; };
__host__ __device__ constexpr constexpr_ij cand_ij(int k) {
    int n = 0;
    for (int i = 0; i < 16; ++i) for (int j = 0; j < 16; ++j) if ((i + 1) * (j + 1) <= 16) { if (n == k) return constexpr_ij{i, j}; ++n; }
    return constexpr_ij{0, 0};
}
constexpr int SKL_OFF = 32768, SKL_PITCH = 272;
static_assert(SKL_OFF + 2 * PKEYS * SKL_PITCH <= RING_BYTES, "skl");
__device__ __forceinline__ void topk_task(const bf16* QP, const LAS unsigned char* skl  , int* IDX, float* GATE, LAS unsigned char* tlds  , int tt, int h, int lane) {
    const int r32 = lane & 31, hi = lane >> 5, t = tt * 32 + r32;
    asm volatile("" : "+s"(QP));
    float top[2][16];
#pragma unroll
    for (int side = 0; side < 2; ++side) {
        const bf16* Qp = QP + (size_t)t * D + h * PQD + side * PHALF + 8 * hi;
        bf16x8 qf[8];
#pragma unroll
        for (int s = 0; s < 8; ++s) qf[s] = *(const bf16x8*)(Qp + 16 * s);
        float sc[64];
#pragma unroll
        for (int kb = 0; kb < 4; ++kb) {
            const LAS unsigned char* Kp = skl + (side * PKEYS + kb * 32 + r32) * SKL_PITCH + 16 * hi;
            asm volatile("" : "+v"(Kp));
            f32x16 S;
#pragma unroll
            for (int r = 0; r < 16; ++r) S[r] = 0.f;
#pragma unroll
            for (int s = 0; s < 8; ++s) { const bf16x8 kf = *(const LAS bf16x8*)(Kp + 32 * s); S = __builtin_amdgcn_mfma_f32_32x32x16_bf16(kf, qf[s], S, 0, 0, 0); }
#pragma unroll
            for (int r = 0; r < 16; ++r) { const unsigned key = (unsigned)(kb * 32 + crow(r, hi)); sc[kb * 16 + r] = __uint_as_float((__float_as_uint(S[r]) & ~127u) | (127u - key)); }
            asm volatile("" ::: "memory");
        }
        top16_of_pair(sc, top[side]);
        asm volatile("" ::: "memory");
    }
    asm volatile("" ::: "memory");
    int h25 = hi * 25; asm volatile("" : "+v"(h25));
    const unsigned long long himask = 0xFFFFFFFF00000000ull;
    float ca[16], cb[16];
    LAS unsigned short* tab = (LAS unsigned short*)(tlds + r32 * 128);
    LAS unsigned short* tabh = tab + (hi ? 25 : 0); asm volatile("" : "+v"(tabh), "+v"(tab));
#pragma unroll
    for (int k = 0; k < 25; ++k) {
        constexpr_ij c0 = cand_ij(k), c1 = cand_ij(k + 25);
        float a, b;
        asm("v_cndmask_b32_e64 %0, %1, %2, %3" : "=v"(a) : "v"(top[0][c0.i]), "v"(top[0][c1.i]), "s"(himask));
        asm("v_cndmask_b32_e64 %0, %1, %2, %3" : "=v"(b) : "v"(top[1][c0.j]), "v"(top[1][c1.j]), "s"(himask));
        const float sm = a + b;
        const float cvk = __uint_as_float((__float_as_uint(sm) & ~63u) | ((unsigned)(63 - k) - (unsigned)h25));
        if (k < 16) ca[k] = cvk; else cb[k - 16] = cvk;
        tabh[k] = (unsigned short)((127u - (__float_as_uint(a) & 127u)) * PKEYS + (127u - (__float_as_uint(b) & 127u)));
    }
#pragma unroll
    for (int k = 9; k < 16; ++k) cb[k] = -INFINITY;
    sort16_desc(ca); sort16_desc(cb); merge_top16(ca, cb);
    {
        float p[16];
#pragma unroll
        for (int i = 0; i < 16; ++i) p[i] = partner32(ca[i]);
        merge_top16(ca, p);
    }
    float sv[16]; int si[16];
    asm volatile("s_waitcnt lgkmcnt(0)" ::: "memory");
#pragma unroll
    for (int k = 0; k < 16; ++k) { sv[k] = ca[k]; si[k] = (int)tab[63u - (__float_as_uint(ca[k]) & 63u)]; }
    float ex[16], sum = 0.f;
#pragma unroll
    for (int k = 0; k < 16; ++k) { ex[k] = __expf(sv[k] - sv[0]); sum += ex[k]; }
    const float rs = 1.f / sum;
    if (!hi) {
        int* ip = IDX + (size_t)t * NPAIR + h * PTOPK;
#pragma unroll
        for (int k = 0; k < 16; k += 4) *(int4*)(ip + k) = make_int4(si[k], si[k + 1], si[k + 2], si[k + 3]);
    } else {
        float* gp = GATE + (size_t)t * NPAIR + h * PTOPK;
#pragma unroll
        for (int k = 0; k < 16; k += 4) *(f32x4*)(gp + k) = (f32x4){ex[k] * rs, ex[k + 1] * rs, ex[k + 2] * rs, ex[k + 3] * rs};
    }
}

struct SortIn { int id0, id1; float g0, g1; v4u x[4]; float ssq; };
__device__ __forceinline__ void sortq_load(SortIn& in, const bf16* X1B, const float* SSQ, const int* IDX, const float* GATE, int t, int lane) {
    in.id0 = IDX[(size_t)t * NPAIR + lane]; in.id1 = IDX[(size_t)t * NPAIR + 64 + lane];
    in.g0 = GATE[(size_t)t * NPAIR + lane]; in.g1 = GATE[(size_t)t * NPAIR + 64 + lane];
    const v4u* xr = (const v4u*)(X1B + (size_t)t * D) + lane;
#pragma unroll
    for (int j = 0; j < 4; ++j) in.x[j] = xr[64 * j];
    in.ssq = SSQ[t];
}
__device__ __forceinline__ void sortq_token(const SortIn& in, unsigned short* ES, unsigned short* ESG, float* GS, unsigned short* OFFN, float* SXS, unsigned char* XQ, LAS unsigned* cnt  , int t, int lane) {
    const int id0 = in.id0, id1 = in.id1; const float g0 = in.g0, g1 = in.g1;
    const int k0 = egroup(id0), k1 = egroup(id1);
    if (lane < NG) cnt[lane] = 0u;
    const int rk0 = (int)__hip_atomic_fetch_add(cnt + k0, 1u, __ATOMIC_RELAXED, __HIP_MEMORY_SCOPE_WORKGROUP);
    const int rk1 = (int)__hip_atomic_fetch_add(cnt + k1, 1u, __ATOMIC_RELAXED, __HIP_MEMORY_SCOPE_WORKGROUP);
    const int n = (int)cnt[lane & 15];
    int inc = n;
    inc += __builtin_amdgcn_update_dpp(0, inc, 0x111, 0xf, 0xf, true); inc += __builtin_amdgcn_update_dpp(0, inc, 0x112, 0xf, 0xf, true);
    inc += __builtin_amdgcn_update_dpp(0, inc, 0x114, 0xf, 0xf, true); inc += __builtin_amdgcn_update_dpp(0, inc, 0x118, 0xf, 0xf, true);
    const int exc = inc - n;
    const int pos0 = __builtin_amdgcn_ds_bpermute(4 * k0, exc) + rk0, pos1 = __builtin_amdgcn_ds_bpermute(4 * k1, exc) + rk1;
    const int myoffn = exc | (n << 8);
    ES[(size_t)t * NPAIR + pos0] = (unsigned short)id0; ES[(size_t)t * NPAIR + pos1] = (unsigned short)id1;
    if (rk0 < 16) ESG[((size_t)t * NG + k0) * 16 + rk0] = (unsigned short)id0;
    if (rk1 < 16) ESG[((size_t)t * NG + k1) * 16 + rk1] = (unsigned short)id1;
    GS[(size_t)t * NPAIR + pos0] = g0; GS[(size_t)t * NPAIR + pos1] = g1;
    if (lane < NG) OFFN[(size_t)t * NG + lane] = (unsigned short)myoffn;
    const float inv_rms = 1.0f / sqrtf(in.ssq * (1.f / D) + RMS_EPS);
#pragma unroll
    for (int j = 0; j < 4; ++j) {
        const v4u xv = in.x[j];
        float f[8] = {bflo(xv.x), bfhi(xv.x), bflo(xv.y), bfhi(xv.y), bflo(xv.z), bfhi(xv.z), bflo(xv.w), bfhi(xv.w)};
        float m = 0.f;
#pragma unroll
        for (int i = 0; i < 8; ++i) m = fmaxf(m, fabsf(f[i]));
        m = fmaxf(m, dppf<0xB1>(m)); m = fmaxf(m, dppf<0x4E>(m)); m = fmaxf(m, dppf<0x141>(m)); m = fmaxf(m, dppf<0x140>(m));
        const float inv = m > 0.f ? 127.f * __builtin_amdgcn_rcpf(m) : 0.f;
        unsigned w0 = 0, w1 = 0;
#pragma unroll
        for (int i = 0; i < 4; ++i) { w0 |= ((unsigned)((int)rintf(f[i] * inv) & 255)) << (8 * i); w1 |= ((unsigned)((int)rintf(f[4 + i] * inv) & 255)) << (8 * i); }
        *(u32x2*)(XQ + (size_t)t * D + 512 * j + 8 * lane) = (u32x2){w0, w1};
        if ((lane & 15) == 0) SXS[(size_t)t * NS + 4 * j + (lane >> 4)] = m * (1.f / 127.f) * inv_rms;
    }
}

#define U_DPPDOT(C) asm volatile("v_dot4c_i32_i8_dpp %0, %4, %8 row_ror:" #C " row_mask:0xf bank_mask:0xf\n\tv_dot4c_i32_i8_dpp %1, %5, %9 row_ror:" #C " row_mask:0xf bank_mask:0xf\n\t" \
        "v_dot4c_i32_i8_dpp %2, %6, %10 row_ror:" #C " row_mask:0xf bank_mask:0xf\n\tv_dot4c_i32_i8_dpp %3, %7, %11 row_ror:" #C " row_mask:0xf bank_mask:0xf" \
        : "+v"(a0_), "+v"(a1_), "+v"(a2_), "+v"(a3_) : "v"(xv_.x), "v"(xv_.y), "v"(xv_.z), "v"(xv_.w), "v"(tb_[C].x), "v"(tb_[C].y), "v"(tb_[C].z), "v"(tb_[C].w))
__device__ __forceinline__ void peer_u_role(const unsigned char* UQ, const float* SU, const unsigned char* XQ, const float* SXS, const unsigned short* ES, const unsigned short* ESG, const unsigned short* OFFN, float* PART,
                                            LAS unsigned char* lds, int role, int wave, int lane, int tid) {
    const int s = role & (NS - 1), g = role >> 4;
    __syncthreads();
    {
        const v4u* src = (const v4u*)(UQ + (size_t)role * EG * DW);
#pragma unroll 4
        for (int i = tid; i < EG * DW / 16; i += NWAVES * 64) *(LAS v4u*)(lds + (size_t)i * 16) = src[i];
        const float* ssrc = SU + (size_t)role * EG;
        for (int i = tid; i < EG; i += NWAVES * 64) *(LAS float*)(lds + LDS_SU_OFF + i * 4) = ssrc[i];
    }
    __syncthreads();
    STAMP(20);
    const int ts = lane >> 4, k = lane & 15, cid = lane & 7;
    unsigned short* part = (unsigned short*)PART + (size_t)s * T * NPAIR;
    int coff[8];
#pragma unroll
    for (int c_ = 0; c_ < 8; ++c_) coff[c_] = ((cid - c_) & 7) * 16;
    const unsigned tt0 = (unsigned)(4 * wave + ts);
    unsigned o_of = (tt0 * NG + g) * 2u, o_e = ((tt0 * NG + g) * 16u + k) * 2u, o_x = tt0 * D + s * DW + 16u * cid, o_s = (tt0 * NS + s) * 4u;
    const unsigned char* bOF = (const unsigned char*)OFFN; const unsigned char* bE = (const unsigned char*)ESG; const unsigned char* bS = (const unsigned char*)SXS;
#define U_TQ(I) (wave + NWAVES * (I))
#define U_LOAD(I, OF, E, XV, SX) do { OF = *(const unsigned short*)(bOF + o_of); E = *(const unsigned short*)(bE + o_e); XV = *(const v4u*)(XQ + o_x); SX = *(const float*)(bS + o_s); \
        o_of += 4 * NWAVES * NG * 2; o_e += 4 * NWAVES * NG * 32; o_x += 4 * NWAVES * D; o_s += 4 * NWAVES * NS * 4; } while (0)
#define U_DOT(ACC, EV, XV, ACTIVE) do { LAS const unsigned char* rowp_ = lds + erow((int)(EV)) * DW; v4u tb_[8]; const v4u xv_ = (XV); \
        _Pragma("unroll") for (int c_ = 0; c_ < 8; ++c_) tb_[c_] = (v4u){0u, 0u, 0u, 0u}; \
        if (ACTIVE) { _Pragma("unroll") for (int c_ = 0; c_ < 8; ++c_) tb_[c_] = *(const LAS v4u*)(rowp_ + coff[c_]); } \
        int a0_ = 0, a1_ = 0, a2_ = 0, a3_ = 0; \
        asm volatile("s_nop 4\n\tv_dot4c_i32_i8 %0, %4, %8\n\tv_dot4c_i32_i8 %1, %5, %9\n\tv_dot4c_i32_i8 %2, %6, %10\n\tv_dot4c_i32_i8 %3, %7, %11" \
            : "+v"(a0_), "+v"(a1_), "+v"(a2_), "+v"(a3_) : "v"(xv_.x), "v"(xv_.y), "v"(xv_.z), "v"(xv_.w), "v"(tb_[0].x), "v"(tb_[0].y), "v"(tb_[0].z), "v"(tb_[0].w)); \
        U_DPPDOT(1); U_DPPDOT(2); U_DPPDOT(3); U_DPPDOT(4); U_DPPDOT(5); U_DPPDOT(6); U_DPPDOT(7); ACC = (a0_ + a1_) + (a2_ + a3_); } while (0)
#define U_RD(TB, SUV, E, OF) do { const int r_ = erow((int)(E)); LAS const unsigned char* rowp_ = lds + r_ * DW; \
        if (k < (int)((OF) >> 8)) { _Pragma("unroll") for (int c_ = 0; c_ < 8; ++c_) TB[c_] = *(const LAS v4u*)(rowp_ + coff[c_]); SUV = *(const LAS float*)(lds + LDS_SU_OFF + r_ * 4); } } while (0)
#define U_DPPD(C, TB) asm volatile("v_dot4c_i32_i8_dpp %0, %4, %8 row_ror:" #C " row_mask:0xf bank_mask:0xf\n\tv_dot4c_i32_i8_dpp %1, %5, %9 row_ror:" #C " row_mask:0xf bank_mask:0xf\n\t" \
        "v_dot4c_i32_i8_dpp %2, %6, %10 row_ror:" #C " row_mask:0xf bank_mask:0xf\n\tv_dot4c_i32_i8_dpp %3, %7, %11 row_ror:" #C " row_mask:0xf bank_mask:0xf" \
        : "+v"(a0_), "+v"(a1_), "+v"(a2_), "+v"(a3_) : "v"(xv_.x), "v"(xv_.y), "v"(xv_.z), "v"(xv_.w), "v"(TB[C].x), "v"(TB[C].y), "v"(TB[C].z), "v"(TB[C].w))
#define U_MATH(I, OF, TB, SUV, XV, SX) do { const int t_ = 4 * U_TQ(I) + ts; const int j0_ = (OF) & 255, n_ = (OF) >> 8; const v4u xv_ = (XV); int a0_, a1_, a2_, a3_; \
        asm volatile("s_nop 4\n\tv_dot4_i32_i8 %0, %4, %8, 0\n\tv_dot4_i32_i8 %1, %5, %9, 0\n\tv_dot4_i32_i8 %2, %6, %10, 0\n\tv_dot4_i32_i8 %3, %7, %11, 0"   \
            : "=&v"(a0_), "=&v"(a1_), "=&v"(a2_), "=&v"(a3_) : "v"(xv_.x), "v"(xv_.y), "v"(xv_.z), "v"(xv_.w), "v"(TB[0].x), "v"(TB[0].y), "v"(TB[0].z), "v"(TB[0].w)); \
        U_DPPD(1, TB); U_DPPD(2, TB); U_DPPD(3, TB); U_DPPD(4, TB); U_DPPD(5, TB); U_DPPD(6, TB); U_DPPD(7, TB); \
        if (k < n_) *(unsigned short*)((unsigned char*)part + (unsigned)(((unsigned)t_ * NPAIR + (unsigned)j0_ + (unsigned)k) * 2u)) = (unsigned short)cvtpk((float)((a0_ + a1_) + (a2_ + a3_)) * (SUV) * (SX), 0.f); } while (0)
    unsigned of0, of1, of2, of3, of4, of5, of6, of7, e0, e1, e2, e3, e4, e5, e6, e7; v4u x0, x1, x2, x3, x4, x5, x6, x7; float s0, s1, s2, s3, s4, s5, s6, s7;
    v4u tA[8], tB[8]; float uA = 0.f, uB = 0.f;
#pragma unroll
    for (int c_ = 0; c_ < 8; ++c_) { tA[c_] = (v4u){0u, 0u, 0u, 0u}; tB[c_] = (v4u){0u, 0u, 0u, 0u}; }
    U_LOAD(0, of0, e0, x0, s0); U_LOAD(1, of1, e1, x1, s1); U_LOAD(2, of2, e2, x2, s2); U_LOAD(3, of3, e3, x3, s3);
    U_RD(tA, uA, e0, of0);
    if (wave >= 4) __builtin_amdgcn_s_setprio(1);
#pragma unroll 1
    for (int it = 0; it < T / 4 / NWAVES; it += 8) {
        U_LOAD(it + 4, of4, e4, x4, s4); U_RD(tB, uB, e1, of1); U_MATH(it, of0, tA, uA, x0, s0); __builtin_amdgcn_sched_barrier(0);
        U_LOAD(it + 5, of5, e5, x5, s5); U_RD(tA, uA, e2, of2); U_MATH(it + 1, of1, tB, uB, x1, s1); __builtin_amdgcn_sched_barrier(0);
        U_LOAD(it + 6, of6, e6, x6, s6); U_RD(tB, uB, e3, of3); U_MATH(it + 2, of2, tA, uA, x2, s2); __builtin_amdgcn_sched_barrier(0);
        U_LOAD(it + 7, of7, e7, x7, s7); U_RD(tA, uA, e4, of4); U_MATH(it + 3, of3, tB, uB, x3, s3); __builtin_amdgcn_sched_barrier(0);
        U_LOAD(it + 8, of0, e0, x0, s0); U_RD(tB, uB, e5, of5); U_MATH(it + 4, of4, tA, uA, x4, s4); __builtin_amdgcn_sched_barrier(0);
        U_LOAD(it + 9, of1, e1, x1, s1); U_RD(tA, uA, e6, of6); U_MATH(it + 5, of5, tB, uB, x5, s5); __builtin_amdgcn_sched_barrier(0);
        U_LOAD(it + 10, of2, e2, x2, s2); U_RD(tB, uB, e7, of7); U_MATH(it + 6, of6, tA, uA, x6, s6); __builtin_amdgcn_sched_barrier(0);
        U_LOAD(it + 11, of3, e3, x3, s3); U_RD(tA, uA, e0, of0); U_MATH(it + 7, of7, tB, uB, x7, s7); __builtin_amdgcn_sched_barrier(0);
    }
    __builtin_amdgcn_s_setprio(0);
#undef U_RD
#undef U_DPPD
#undef U_MATH
    STAMP(21);
    {
        unsigned ofl[16];
#pragma unroll
        for (int b16 = 0; b16 < 16; ++b16) { const int i_ = b16 * 64 + lane; const int t_l = 4 * (wave + NWAVES * (i_ >> 2)) + (i_ & 3); ofl[b16] = OFFN[(size_t)t_l * NG + g]; }
#pragma unroll
        for (int b16 = 0; b16 < 16; ++b16) {
            const int i_ = b16 * 64 + lane; const int t_l = 4 * (wave + NWAVES * (i_ >> 2)) + (i_ & 3);
            const unsigned of_l = ofl[b16];
            unsigned long long mask = __ballot((of_l >> 8) > 16u);
            while (mask) {
                const int b = __builtin_ctzll(mask); mask &= mask - 1;
                const int t_o = __builtin_amdgcn_readlane(t_l, b); const unsigned of_o = (unsigned)__builtin_amdgcn_readlane((int)of_l, b);
                const int j0_ = of_o & 255, n_ = of_o >> 8;
                const v4u xo = *(const v4u*)(XQ + (size_t)t_o * D + s * DW + 16 * cid); const float so = SXS[(size_t)t_o * NS + s];
                for (int kk = 16 + 16 * ts + k; __any(kk < n_); kk += 64) {
                    const unsigned e2 = (kk < n_) ? ES[(size_t)t_o * NPAIR + j0_ + kk] : 0u; int a2; U_DOT(a2, e2, xo, kk < n_);
                    const float su2 = *(const LAS float*)(lds + LDS_SU_OFF + erow((int)e2) * 4);
                    if (kk < n_) part[(size_t)t_o * NPAIR + j0_ + kk] = (unsigned short)f2bf((float)a2 * su2 * so);
                }
            }
        }
    }
    STAMP(23);
#undef U_LOAD
#undef U_TQ
#undef U_DOT
}

__device__ __forceinline__ void peer_reduce_tile(const float* PART, const float* GS, const unsigned short* ES, const float* SV, unsigned* E32, unsigned char* A8, float* TS, int tile, int tid) {
    const int t = tile * 32 + (tid >> 4), sidx = tid & 15, jb = sidx * 8; const size_t base = (size_t)t * NPAIR + jb;
    f32x4 h0 = (f32x4){0.f, 0.f, 0.f, 0.f}, h1 = h0;
#pragma unroll
    for (int sl = 0; sl < NS; ++sl) { const v4u p = *(const v4u*)((const unsigned short*)PART + (size_t)sl * T * NPAIR + base);
        h0 += (f32x4){bflo(p.x), bfhi(p.x), bflo(p.y), bfhi(p.y)}; h1 += (f32x4){bflo(p.z), bfhi(p.z), bflo(p.w), bfhi(p.w)}; }
    const f32x4 ga = *(const f32x4*)(GS + base), gb = *(const f32x4*)(GS + base + 4);
    const v4u ev = *(const v4u*)(ES + base);
    const float hh[8] = {h0.x, h0.y, h0.z, h0.w, h1.x, h1.y, h1.z, h1.w}; const float gg[8] = {ga.x, ga.y, ga.z, ga.w, gb.x, gb.y, gb.z, gb.w};
    const unsigned ee[8] = {ev.x & 0xffffu, ev.x >> 16, ev.y & 0xffffu, ev.y >> 16, ev.z & 0xffffu, ev.z >> 16, ev.w & 0xffffu, ev.w >> 16};
    float a[8]; float m = 0.f;
#pragma unroll
    for (int i = 0; i < 8; ++i) { const float h = hh[i]; a[i] = 0.5f * h * (1.f + erff(h * 0.70710678118654752f)) * gg[i] * SV[ee[i]]; m = fmaxf(m, fabsf(a[i])); }
    m = fmaxf(m, dppf<0xB1>(m)); m = fmaxf(m, dppf<0x4E>(m)); m = fmaxf(m, dppf<0x141>(m)); m = fmaxf(m, dppf<0x140>(m));
    const float inv = m > 0.f ? 127.f / m : 0.f;
    unsigned w0 = 0, w1 = 0;
#pragma unroll
    for (int i = 0; i < 4; ++i) { w0 |= ((unsigned)((int)rintf(a[i] * inv) & 255)) << (8 * i); w1 |= ((unsigned)((int)rintf(a[4 + i] * inv) & 255)) << (8 * i); }
    *(u32x2*)(A8 + base) = (u32x2){w0, w1};
    if (sidx == 0) TS[t] = m * (1.f / 127.f);
#pragma unroll
    for (int q = 0; q < 8; ++q) E32[(size_t)t * NPAIR + (sidx >> 2) * 32 + q * 4 + (sidx & 3)] = ee[q] * 8u;
}

#ifndef TR_MAP
#define TR_MAP 0
#endif
typedef int v2i_t __attribute__((ext_vector_type(2)));
__device__ __forceinline__ void peer_v_role(const unsigned char* VQ, const unsigned* E32, const unsigned char* A8, const float* TS, const bf16* X1B, bf16* X  , float* SSQ2,
                                            LAS unsigned char* lds, int c, int wave, int lane, int tid, const XcdBarrier& bar, bool wait_bar) {
    __syncthreads();
    {
        const v4u* src = (const v4u*)(VQ + (size_t)c * NEXP * 8);
#pragma unroll 4
        for (int i = tid; i < NEXP * 8 / 16; i += NWAVES * 64) *(LAS v4u*)(lds + (size_t)i * 16) = __builtin_nontemporal_load(src + i);
    }
    if (wait_bar) xcd_wait_w(bar, wave); else __syncthreads();
    STAMP(22);
    const int G16 = lane >> 4, L = lane & 15;
    const int sq = (TR_MAP == 0) ? (L >> 1) : (L & 7), sp = (TR_MAP == 0) ? (L & 1) : (L >> 3);
    const int rp = L >> 3, rd = L & 7;
    LAS unsigned char* stg = lds + LDS_SU_OFF + wave * 2304;
    LAS unsigned char* stw = stg + (lane >> 3) * 144 + (lane & 7) * 16;
    LAS const unsigned char* str = stg + (2 * G16 + rp) * 144;
    const unsigned char* bE = (const unsigned char*)E32; const unsigned char* bX = (const unsigned char*)X1B; const unsigned char* bT = (const unsigned char*)TS;
    const unsigned oE0 = ((unsigned)(2 * G16 + sp) * NPAIR + sq * 4) * 4u, oA0 = (unsigned)(lane >> 3) * NPAIR + (lane & 7) * 16u, oX0 = ((unsigned)(2 * G16 + rp) * D + 8 * c + rd) * 2u, oT0 = (unsigned)(2 * G16 + rp) * 4u;
#define V_LD(IT, ES, AV, XS, SS) do { const unsigned it_ = (unsigned)(IT); \
        const v4u* ep_ = (const v4u*)(bE + (oE0 + it_ * (8u * NPAIR * 4u))); ES[0] = ep_[0]; ES[1] = ep_[8]; ES[2] = ep_[16]; ES[3] = ep_[24]; \
        AV = *(const v4u*)(A8 + (oA0 + it_ * (8u * NPAIR))); \
        XS = *(const unsigned short*)(bX + (oX0 + it_ * (8u * D * 2u))); SS = *(const float*)(bT + (oT0 + it_ * 32u)); } while (0)
#define V_TR(EO) __builtin_amdgcn_ds_read_tr8_b64_v2i32((LAS v2i_t*)(unsigned)(EO))
#define V_DO(IT, ES, AV, XS, SS, BUF) do { *(LAS v4u*)(stw + (BUF) * 1152) = AV; \
        v2i_t r_[16]; v4u a_[8]; \
        r_[0] = V_TR(ES[0].x); r_[1] = V_TR(ES[0].y); r_[2] = V_TR(ES[0].z); r_[3] = V_TR(ES[0].w); r_[4] = V_TR(ES[1].x); r_[5] = V_TR(ES[1].y); r_[6] = V_TR(ES[1].z); r_[7] = V_TR(ES[1].w); \
        r_[8] = V_TR(ES[2].x); r_[9] = V_TR(ES[2].y); r_[10] = V_TR(ES[2].z); r_[11] = V_TR(ES[2].w); r_[12] = V_TR(ES[3].x); r_[13] = V_TR(ES[3].y); r_[14] = V_TR(ES[3].z); r_[15] = V_TR(ES[3].w); \
        _Pragma("unroll") for (int k_ = 0; k_ < 8; ++k_) a_[k_] = *(const LAS v4u*)(str + (BUF) * 1152 + k_ * 16); \
        __builtin_amdgcn_sched_barrier(0); \
        int acc = 0, acc2 = 0; \
        _Pragma("unroll") for (int k_ = 0; k_ < 8; ++k_) { acc = __builtin_amdgcn_sdot4((int)a_[k_].x, r_[2 * k_].x, acc, false); acc2 = __builtin_amdgcn_sdot4((int)a_[k_].y, r_[2 * k_].y, acc2, false); \
            acc = __builtin_amdgcn_sdot4((int)a_[k_].z, r_[2 * k_ + 1].x, acc, false); acc2 = __builtin_amdgcn_sdot4((int)a_[k_].w, r_[2 * k_ + 1].y, acc2, false); } \
        const float y_ = __uint_as_float((unsigned)(XS) << 16) + (float)(acc + acc2) * (SS); \
        *(unsigned short*)((unsigned char*)X + (oX0 + (unsigned)(IT) * (8u * D * 2u))) = (unsigned short)f2bf(y_); float ss_ = y_ * y_;     ss_ += __int_as_float(__builtin_amdgcn_mov_dpp(__float_as_int(ss_), 0xB1, 0xf, 0xf, false)); ss_ += __int_as_float(__builtin_amdgcn_mov_dpp(__float_as_int(ss_), 0x4E, 0xf, 0xf, false)); \
        ss_ += __int_as_float(__builtin_amdgcn_mov_dpp(__float_as_int(ss_), 0x141, 0xf, 0xf, false)); \
        *(float*)((unsigned char*)SSQ2 + (((unsigned)(2 * G16 + rp) * (D / 8) + c) * 4u + (unsigned)(IT) * (8u * (D / 8) * 4u))) = ss_; } while (0)
    v4u eA[4], eB[4], eC[4], eD[4], aA, aB, aC, aD; unsigned short xA, xB, xC, xD; float sA, sB, sC, sD;
#define V_IT(I) ((I) < T / 8 ? (I) : T / 8 - 1)
    V_LD(V_IT(wave), eA, aA, xA, sA); V_LD(V_IT(wave + NWAVES), eB, aB, xB, sB); V_LD(V_IT(wave + 2 * NWAVES), eC, aC, xC, sC);
    if (wave >= 4) __builtin_amdgcn_s_setprio(1);
#pragma unroll 1
    for (int it = wave; it < T / 8; it += 4 * NWAVES) {
        V_LD(V_IT(it + 3 * NWAVES), eD, aD, xD, sD); V_DO(it, eA, aA, xA, sA, 0);
        V_LD(V_IT(it + 4 * NWAVES), eA, aA, xA, sA); V_DO(it + NWAVES, eB, aB, xB, sB, 1);
        V_LD(V_IT(it + 5 * NWAVES), eB, aB, xB, sB); V_DO(it + 2 * NWAVES, eC, aC, xC, sC, 0);
        V_LD(V_IT(it + 6 * NWAVES), eC, aC, xC, sC); V_DO(it + 3 * NWAVES, eD, aD, xD, sD, 1);
    }
    __builtin_amdgcn_s_setprio(0);
#undef V_IT
#undef V_LD
#undef V_TR
#undef V_DO
    STAMP(24);
}
__device__ __forceinline__ void final_norm_row(const bf16* X2B, float* OUT, const float* SSQP, const float* gfin, int t, int lane) {
    const f32x4 pp = __builtin_nontemporal_load((const f32x4*)(SSQP + (size_t)t * (D / 8)) + lane);
    const v4u* xr = (const v4u*)(X2B + (size_t)t * D) + lane;
    v4u xv[4];
#pragma unroll
    for (int j = 0; j < 4; ++j) xv[j] = __builtin_nontemporal_load(xr + 64 * j);
    const float inv = 1.0f / sqrtf(wave_sum((pp.x + pp.y) + (pp.z + pp.w)) * (1.f / D) + RMS_EPS);
#pragma unroll
    for (int j = 0; j < 4; ++j) {
        const f32x4 g0 = *(const f32x4*)(gfin + 512 * j + 8 * lane), g1 = *(const f32x4*)(gfin + 512 * j + 8 * lane + 4);
        float* o = OUT + (size_t)t * D + 512 * j + 8 * lane;
        __builtin_nontemporal_store((f32x4){bflo(xv[j].x) * inv * g0.x, bfhi(xv[j].x) * inv * g0.y, bflo(xv[j].y) * inv * g0.z, bfhi(xv[j].y) * inv * g0.w}, (f32x4*)o);
        __builtin_nontemporal_store((f32x4){bflo(xv[j].z) * inv * g1.x, bfhi(xv[j].z) * inv * g1.y, bflo(xv[j].w) * inv * g1.z, bfhi(xv[j].w) * inv * g1.w}, (f32x4*)(o + 4));
    }
}

#ifndef PHASE_MASK
#define PHASE_MASK 0x1ff
#endif
#define PH_ON(k) ((PHASE_MASK >> (k)) & 1)
#ifndef REP_MASK
#define REP_MASK 0
#endif
#define PH_REP(k) (1 + ((REP_MASK >> (k)) & 1))
__device__ __forceinline__ Ptrs load_args() {
#if defined(__HIP_DEVICE_COMPILE__)
    const __attribute__((address_space(4))) Ptrs* pp = (const __attribute__((address_space(4))) Ptrs*)__builtin_amdgcn_kernarg_segment_ptr();
    asm volatile("" : "+s"(pp));
    Ptrs r;
    r.x = pp->x; r.norm_mix = pp->norm_mix; r.w_in = pp->w_in; r.conv_w = pp->conv_w; r.w_conv_out = pp->w_conv_out; r.w_attn_out = pp->w_attn_out; r.w_out = pp->w_out; r.norm_ffn = pp->norm_ffn;
    r.peer_wq = pp->peer_wq; r.peer_sk = pp->peer_sk; r.peer_u = pp->peer_u; r.peer_v = pp->peer_v; r.norm_final = pp->norm_final; r.out = pp->out; r.ws = pp->ws;
    return r;
#else
    return Ptrs{};
#endif
}
__global__ void __launch_bounds__(NWAVES * 64, 2) hyb_fwd(Ptrs Punused) {
    extern __shared__ __attribute__((aligned(16))) unsigned char lds_raw[];
    LAS unsigned char* lds = (LAS unsigned char*)lds_raw;
    const int G = gridDim.x; const int bx = blockIdx.x; const int vcu = (G % 8 == 0) ? (bx % 8) * (G / 8) + bx / 8 : bx;
    const int wave = __builtin_amdgcn_readfirstlane(threadIdx.x >> 6);
#define TIDV const int lane = hw_lane(), tid = wave * 64 + lane; const int gw = vcu * NWAVES + wave, NGW = G * NWAVES; (void)gw; (void)NGW; (void)lane;
    XcdBarrier bar;
    {
        TIDV; const Ptrs P = load_args();
        volatile LAS unsigned* MISC = (volatile LAS unsigned*)(lds + MISC_OFF);
        for (int u = tid; u < 128; u += NWAVES * 64) ((LAS unsigned*)(lds + LDSCTL_OFF))[u] = 0u;
        __syncthreads();
        bar = xcd_barrier_post((unsigned*)(P.ws + WS_CTL) + CW_BAR, MISC + 8, wave);
    }
#define CTLP ((unsigned*)(P.ws + WS_CTL))
    STAMP(0);

    if (PH_ON(0)) { TIDV; const Ptrs P = load_args(); p0_all(P, lds, vcu, G, wave, lane, tid); }
    xcd_barrier_w(bar, wave);
    STAMP(1);

    if (PH_ON(1)) {
        const Ptrs P = load_args();
        pg8::Gemm g{(const pg8::bf16_t*)(P.ws + WS_XN), (const pg8::bf16_t*)(P.ws + WS_WIN), T, INW, D}; pg8::StaticOrder S; S.init(T, INW, G, bx);
        pg8::EpiStoreI8 E{(pg8::bf16_t*)(P.ws + WS_PROJ), INW, (const float*)(P.ws + WS_SA), (const float*)(CTLP + CW_COLMAX)};
        pg8::gemm_phase<pg8::EpiStoreI8, pg8::StaticOrder, true, true, true>(lds + RING_OFF, g, S, E, wave);
    }
    xcd_barrier_w(bar, wave);
    STAMP(2);

    if (PH_ON(2)) {
        TIDV; const Ptrs P = load_args();
        p2_conv(P, gw * 64 + lane, NGW * 64);
        const bf16* PROJ = (const bf16*)(P.ws + WS_PROJ); bf16* YA = (bf16*)(P.ws + WS_YA);
        LAS unsigned char* vl = lds + RING_OFF + wave * 4096;
        constexpr int NTASK = (T / 32) * NH;
        for (int it = gw; it < NTASK; it += NGW) { const int task = NTASK - 1 - it; attn_task(PROJ, YA, vl, task / NH, task % NH, lane); }
    }
    xcd_barrier_w(bar, wave);
    STAMP(3);

    if (PH_ON(3)) {
        pg8::StaticOrder S; S.init(T, D, G, bx);
        const Ptrs P = load_args();
        pg8::Gemm g{(const pg8::bf16_t*)(P.ws + WS_YC), (const pg8::bf16_t*)(P.ws + WS_WCO), T, D, CW, (const pg8::bf16_t*)(P.ws + WS_YA), (const pg8::bf16_t*)(P.ws + WS_WAO)};
        static_assert(CW == AW, "chained K");
        pg8::EpiGateChain E{(const pg8::bf16_t*)(P.ws + WS_PROJ) + C_GC, (const pg8::bf16_t*)(P.ws + WS_PROJ) + C_GA, INW, (pg8::bf16_t*)(P.ws + WS_XN), D};
        pg8::gemm_phase<pg8::EpiGateChain, pg8::StaticOrder, true, true, false, true>(lds + RING_OFF, g, S, E, wave);
    }
    xcd_barrier_w(bar, wave);
    STAMP(4);

    if (PH_ON(4)) {
        const Ptrs P = load_args();
        pg8::Gemm g{(const pg8::bf16_t*)(P.ws + WS_XN), (const pg8::bf16_t*)(P.ws + WS_WO), T, D, D}; pg8::StaticOrder S; S.init(T, D, G, bx);
        pg8::EpiX1 E{P.x, (pg8::bf16_t*)(P.ws + WS_X1B), (float*)(CTLP + CW_SSQ), D};
        pg8::gemm_phase<pg8::EpiX1, pg8::StaticOrder, true, true>(lds + RING_OFF, g, S, E, wave);
    }
    xcd_barrier_w(bar, wave);
    STAMP(5);

    if (PH_ON(5)) {
        const Ptrs P = load_args();
        pg8::Gemm g{(const pg8::bf16_t*)(P.ws + WS_X1B), (const pg8::bf16_t*)(P.ws + WS_WQ), T, D, D}; pg8::StaticOrder S; S.init(T, D, G, bx);
        pg8::EpiQP E{(const float*)(CTLP + CW_SSQ), (pg8::bf16_t*)(P.ws + WS_QP), D, 1.f / D, RMS_EPS};
        pg8::gemm_phase<pg8::EpiQP, pg8::StaticOrder, true, true>(lds + RING_OFF, g, S, E, wave);
        {
            __syncthreads();
            const int tid = wave * 64 + hw_lane(), row = tid >> 1, half = tid & 1;
            const pg8::u32x4* src = (const pg8::u32x4*)(P.ws + WS_SK + row * 256 + half * 128);
            LAS pg8::u32x4* dst = (LAS pg8::u32x4*)(lds + RING_OFF + SKL_OFF + row * SKL_PITCH + half * 128);
            pg8::u32x4 t[8];
#pragma unroll
            for (int i = 0; i < 8; ++i) t[i] = src[i];
#pragma unroll
            for (int i = 0; i < 8; ++i) dst[i] = t[i];
        }
    }
    xcd_barrier_w(bar, wave);
    STAMP(6);

    if (PH_ON(6)) {
        TIDV; const Ptrs P = load_args();
#define P6_TOPK(TILE) topk_task((const bf16*)(P.ws + WS_QP), lds + RING_OFF + SKL_OFF, (int*)(P.ws + WS_IDX), (float*)(P.ws + WS_GATE), lds + RING_OFF + wave * 4096, TILE, wave, lane)
#define P6_SORT(TILE) do { asm volatile("s_waitcnt vmcnt(0)" ::: "memory"); __builtin_amdgcn_fence(__ATOMIC_RELEASE, "workgroup"); __syncthreads(); __builtin_amdgcn_fence(__ATOMIC_ACQUIRE, "workgroup"); \
            SortIn i0, i1; const int t0 = (TILE) * 32 + wave * 4; \
            unsigned char* ws2 = P.ws; asm volatile("" : "+s"(ws2)); \
            const bf16* X1B_ = (const bf16*)(ws2 + WS_X1B); const float* SSQ_ = (const float*)((unsigned*)(ws2 + WS_CTL) + CW_SSQ); const int* IDX_ = (const int*)(ws2 + WS_IDX); const float* GATE_ = (const float*)(ws2 + WS_GATE); \
            sortq_load(i0, X1B_, SSQ_, IDX_, GATE_, t0, lane); sortq_load(i1, X1B_, SSQ_, IDX_, GATE_, t0 + 1, lane); \
            SQ_DO(i0, t0); sortq_load(i0, X1B_, SSQ_, IDX_, GATE_, t0 + 2, lane); asm volatile("" ::: "memory"); \
            SQ_DO(i1, t0 + 1); sortq_load(i1, X1B_, SSQ_, IDX_, GATE_, t0 + 3, lane); asm volatile("" ::: "memory"); \
            SQ_DO(i0, t0 + 2); asm volatile("" ::: "memory"); SQ_DO(i1, t0 + 3); } while (0)
#define SQ_DO(IN, TT) sortq_token(IN, (unsigned short*)(ws2 + WS_ES), (unsigned short*)(ws2 + WS_ESG), (float*)(ws2 + WS_GS), (unsigned short*)(ws2 + WS_OFFN), (float*)(ws2 + WS_SXS), ws2 + WS_XQ, (LAS unsigned*)(lds + RING_OFF + wave * 4096), TT, lane)
        const bool even = G * 64 == NEXP;
        const int u_first = even ? vcu * 64 + (wave < 4 ? wave * 10 : 40 + (wave - 4) * 6) : gw, u_step = even ? 1 : NGW, u_end = even ? u_first + (wave < 4 ? 10 : 6) : NEXP;
        if (vcu < T / 32) {
            if ((wave & 4) == 0) peer_tables_to_i8(P, u_first, u_step, u_end, lane);
            P6_TOPK(vcu);
            if ((wave & 4) != 0) peer_tables_to_i8(P, u_first, u_step, u_end, lane);
            P6_SORT(vcu);
        } else peer_tables_to_i8(P, u_first, u_step, u_end, lane);
#pragma unroll 1
        for (int tile = vcu + G; tile < T / 32; tile += G) { P6_TOPK(tile); P6_SORT(tile); }
#undef SQ_DO
#undef P6_TOPK
#undef P6_SORT
    }
    xcd_barrier_w(bar, wave);
    STAMP(7);
    {
        TIDV; const Ptrs P = load_args();
        for (int role = bx; role < NS * NG; role += G) peer_u_role(P.ws + WS_UQ, (const float*)(P.ws + WS_SU), P.ws + WS_XQ, (const float*)(P.ws + WS_SXS), (const unsigned short*)(P.ws + WS_ES), (const unsigned short*)(P.ws + WS_ESG),
                                                                  (const unsigned short*)(P.ws + WS_OFFN), (float*)(P.ws + WS_PART), lds, role, wave, lane, tid);
    }
    xcd_barrier_w(bar, wave);
    STAMP(8);
    {
        TIDV; const Ptrs P = load_args();
        for (int tile = vcu; tile < T / 32; tile += G) peer_reduce_tile((const float*)(P.ws + WS_PART), (const float*)(P.ws + WS_GS), (const unsigned short*)(P.ws + WS_ES), (const float*)(P.ws + WS_SV), (unsigned*)(P.ws + WS_E32), P.ws + WS_A8, (float*)(P.ws + WS_TS), tile, tid);
    }
    xcd_arrive_w(bar, wave);
    STAMP(9);

    {
        TIDV; const Ptrs P = load_args();
        if (vcu >= D / 8) xcd_wait_w(bar, wave);
        for (int c = vcu; c < D / 8; c += G) peer_v_role(P.ws + WS_VQ, (const unsigned*)(P.ws + WS_E32), P.ws + WS_A8, (const float*)(P.ws + WS_TS), (const bf16*)(P.ws + WS_X1B), (bf16*)(P.ws + WS_X1B), (float*)(P.ws + WS_SSQP), lds, c, wave, lane, tid, bar, c == vcu);
    }
    xcd_barrier_w(bar, wave);
    STAMP(10);

    {
        TIDV; const Ptrs P = load_args();
        for (int t = gw; t < T; t += NGW) final_norm_row((const bf16*)(P.ws + WS_X1B), P.out, (const float*)(P.ws + WS_SSQP), P.norm_final, t, lane);
    }
    if (PROBE_PHASE >= 0 && blockIdx.x == 0 && wave == 0 && hw_lane() == 0) {
        const unsigned long long now = __builtin_amdgcn_s_memrealtime();
        *(volatile LAS unsigned long long*)(lds + LDSCTL_OFF + 64 + 8 * 12) = now;
        const unsigned long long a = *(volatile LAS unsigned long long*)(lds + LDSCTL_OFF + 64 + 8 * PROBE_A);
        const unsigned long long b = *(volatile LAS unsigned long long*)(lds + LDSCTL_OFF + 64 + 8 * PROBE_B);
        const unsigned long long dt = (b - a) * 8ull;
        while (__builtin_amdgcn_s_memrealtime() - now < dt) __builtin_amdgcn_s_sleep(8);
    }
}

extern "C" void kernel_launch(void* const* d_in, const int* in_sizes, int n_in, void* d_out, int out_size, void* d_ws, size_t ws_size, hipStream_t stream) {
    static int grid = 0;
    if (grid == 0) {
        if (n_in != 13 || out_size != T * D || ws_size < WS_END) { fprintf(stderr, "kernel_launch: unexpected shapes (n_in %d out %d ws %zu)\n", n_in, out_size, ws_size); grid = -1; return; }
        int dev = 0, cus = 0, per_cu = 0;
        if (hipGetDevice(&dev) != hipSuccess || hipDeviceGetAttribute(&cus, hipDeviceAttributeMultiprocessorCount, dev) != hipSuccess) { grid = -1; return; }
        if (hipFuncSetAttribute((const void*)hyb_fwd, hipFuncAttributeMaxDynamicSharedMemorySize, LDS_BYTES) != hipSuccess) { fprintf(stderr, "kernel_launch: hipFuncSetAttribute failed\n"); grid = -1; return; }
        if (hipOccupancyMaxActiveBlocksPerMultiprocessor(&per_cu, (const void*)hyb_fwd, NWAVES * 64, LDS_BYTES) != hipSuccess || per_cu < 1) { fprintf(stderr, "kernel_launch: occupancy query says %d\n", per_cu); per_cu = 1; }
        (void)hipGetLastError();
        grid = cus;
    }
    if (grid < 0) return;
    (void)hipMemsetAsync((char*)d_ws + WS_CTL, 0, CTL_ZERO_BYTES, stream);
    Ptrs p{};
    p.x = (const float*)d_in[0]; p.norm_mix = (const float*)d_in[1]; p.w_in = (const float*)d_in[2]; p.conv_w = (const float*)d_in[3];
    p.w_conv_out = (const float*)d_in[4]; p.w_attn_out = (const float*)d_in[5]; p.w_out = (const float*)d_in[6]; p.norm_ffn = (const float*)d_in[7];
    p.peer_wq = (const float*)d_in[8]; p.peer_sk = (const float*)d_in[9]; p.peer_u = (const float*)d_in[10]; p.peer_v = (const float*)d_in[11]; p.norm_final = (const float*)d_in[12];
    p.out = (float*)d_out; p.ws = (unsigned char*)d_ws;
    void* args[] = {&p};
    hipError_t e = hipLaunchCooperativeKernel((const void*)hyb_fwd, dim3(grid), dim3(NWAVES * 64), args, LDS_BYTES, stream);
    if (e != hipSuccess) fprintf(stderr, "kernel_launch: cooperative launch failed: %s (grid %d)\n", hipGetErrorString(e), grid);
}
```
